# Optimizing an MI355X kernel written in HIP

```python
import math
import jax, jax.numpy as jnp
from jax import lax
import numpy as np

D_MODEL = 1024
BATCH = 4
SEQ = 4096
DEPTH = 1
DEC_BATCH = 128
DEC_SEQ = 4
PAST_LEN = 8192
PAGE_SIZE = 128

N_META = 16
D_MIX = D_MODEL
HEAD_DIM = 64
ATT_WIDTH = D_MIX // 2
N_HEADS = ATT_WIDTH // HEAD_DIM
N_KV_HEADS = 2
Q_PER_KV = N_HEADS // N_KV_HEADS
WINDOW = 128
BLOCK = 128
ROPE_DIM = HEAD_DIM // 4
ROPE_THETA = 500000.0
SSM_WIDTH = D_MIX - ATT_WIDTH
SSM_GROUP = 16
SSM_GROUPS = SSM_WIDTH // SSM_GROUP
SSM_STATE = 64
KV_WIDTH = N_KV_HEADS * HEAD_DIM
D_IN = ATT_WIDTH + 2 * KV_WIDTH + SSM_WIDTH
D_FF = 4 * D_MODEL
EPS = 1e-6
NEG = -1e30

kernel_name = "hymba_s5_swa_sink_decode_step"


def rmsnorm(x, g):
    xf = x.astype(jnp.float32)
    y = xf * lax.rsqrt(jnp.mean(xf * xf, axis=-1, keepdims=True) + EPS)
    return (y * g.astype(jnp.float32)).astype(x.dtype)


def partial_rope(x, pos):
    half = ROPE_DIM // 2
    inv = ROPE_THETA ** (-jnp.arange(half, dtype=jnp.float32) / half)
    ang = pos.astype(jnp.float32)[:, None] * inv[None, :]
    cos = jnp.cos(ang)[:, None, :]
    sin = jnp.sin(ang)[:, None, :]
    xr = x[..., :ROPE_DIM].astype(jnp.float32)
    x1, x2 = xr[..., :half], xr[..., half:]
    rot = jnp.concatenate([x1 * cos - x2 * sin, x2 * cos + x1 * sin], axis=-1).astype(x.dtype)
    return jnp.concatenate([rot, x[..., ROPE_DIM:]], axis=-1)


def in_project(h, g_pre, w_in):
    hn = rmsnorm(h, g_pre)
    proj = jnp.einsum('bsd,de->bse', hn, w_in)
    B, S = h.shape[:2]
    q = proj[..., :ATT_WIDTH].reshape(B, S, N_HEADS, HEAD_DIM)
    k = proj[..., ATT_WIDTH:ATT_WIDTH + KV_WIDTH].reshape(B, S, N_KV_HEADS, HEAD_DIM)
    v = proj[..., ATT_WIDTH + KV_WIDTH:ATT_WIDTH + 2 * KV_WIDTH].reshape(B, S, N_KV_HEADS, HEAD_DIM)
    u = proj[..., ATT_WIDTH + 2 * KV_WIDTH:]
    return q, k, v, u


def sink_softmax(logits, mask, sink):
    logits = jnp.where(mask, logits, NEG)
    m = jnp.maximum(jnp.max(logits, axis=-1, keepdims=True), sink)
    e = jnp.exp(logits - m)
    return e / (jnp.sum(e, axis=-1, keepdims=True) + jnp.exp(sink - m))


def swa_prompt(q, k, v, sinks):
    B, L = q.shape[:2]
    front = (BLOCK - N_META % BLOCK) % BLOCK
    back = (-(front + L)) % BLOCK
    pad = ((0, 0), (front, back), (0, 0), (0, 0))
    qp, kp, vp = jnp.pad(q, pad), jnp.pad(k, pad), jnp.pad(v, pad)
    nb = qp.shape[1] // BLOCK
    qb = qp.reshape(B, nb, BLOCK, N_KV_HEADS, Q_PER_KV, HEAD_DIM)
    kb = kp.reshape(B, nb, BLOCK, N_KV_HEADS, HEAD_DIM)
    vb = vp.reshape(B, nb, BLOCK, N_KV_HEADS, HEAD_DIM)
    zblk = jnp.zeros_like(kb[:, :1])
    kk = jnp.concatenate([jnp.concatenate([zblk, kb[:, :-1]], axis=1), kb], axis=2)
    vv = jnp.concatenate([jnp.concatenate([zblk, vb[:, :-1]], axis=1), vb], axis=2)
    pq = (jnp.arange(nb * BLOCK, dtype=jnp.int32) - front).reshape(nb, BLOCK)
    pk = jnp.concatenate([pq - BLOCK, pq], axis=1)
    diff = pq[:, :, None] - pk[:, None, :]
    mask = (diff >= 0) & (diff < WINDOW) & (pk[:, None, :] >= 0)
    logits = jnp.einsum('bnqkgd,bnskd->bnkgqs', qb, kk).astype(jnp.float32) * (HEAD_DIM ** -0.5)
    sink = sinks.astype(jnp.float32).reshape(1, 1, N_KV_HEADS, Q_PER_KV, 1, 1)
    p = sink_softmax(logits, mask[None, :, None, None], sink)
    o = jnp.einsum('bnkgqs,bnskd->bnqkgd', p.astype(v.dtype), vv)
    o = o.reshape(B, nb * BLOCK, ATT_WIDTH)[:, front:front + L]
    return o


def swa_sample(q, k, v, cache_k, cache_v, pos_q, sinks):
    w = cache_k.shape[1]
    keys = jnp.concatenate([cache_k.astype(k.dtype), k], axis=1)
    vals = jnp.concatenate([cache_v.astype(v.dtype), v], axis=1)
    pos_k = jnp.concatenate([pos_q[0] - w + jnp.arange(w, dtype=jnp.int32), pos_q])
    diff = pos_q[:, None] - pos_k[None, :]
    mask = (diff >= 0) & (diff < WINDOW)
    B, T = q.shape[:2]
    qg = q.reshape(B, T, N_KV_HEADS, Q_PER_KV, HEAD_DIM)
    logits = jnp.einsum('btkgd,bskd->bkgts', qg, keys).astype(jnp.float32) * (HEAD_DIM ** -0.5)
    sink = sinks.astype(jnp.float32).reshape(1, N_KV_HEADS, Q_PER_KV, 1, 1)
    p = sink_softmax(logits, mask[None, None, None], sink)
    o = jnp.einsum('bkgts,bskd->btkgd', p.astype(v.dtype), vals).reshape(B, T, ATT_WIDTH)
    return o, keys[:, -WINDOW:], vals[:, -WINDOW:]


def zoh(a_re, a_im, log_dt, b_re, b_im):
    dt = jnp.exp(log_dt.astype(jnp.float32))[:, None]
    ar, ai = a_re.astype(jnp.float32), a_im.astype(jnp.float32)
    mag = jnp.exp(ar * dt)
    abar_re, abar_im = mag * jnp.cos(ai * dt), mag * jnp.sin(ai * dt)
    nr, ni = abar_re - 1.0, abar_im
    den = ar * ar + ai * ai
    coef_re = (nr * ar + ni * ai) / den
    coef_im = (ni * ar - nr * ai) / den
    br, bi = b_re.astype(jnp.float32), b_im.astype(jnp.float32)
    bbar_re = coef_re[..., None] * br - coef_im[..., None] * bi
    bbar_im = coef_re[..., None] * bi + coef_im[..., None] * br
    return abar_re, abar_im, bbar_re, bbar_im


def cplx_combine(e1, e2):
    ar1, ai1, br1, bi1 = e1
    ar2, ai2, br2, bi2 = e2
    return (ar2 * ar1 - ai2 * ai1,
            ar2 * ai1 + ai2 * ar1,
            ar2 * br1 - ai2 * bi1 + br2,
            ar2 * bi1 + ai2 * br1 + bi2)


def ssm_mixer(u, h0_re, h0_im, a_re, a_im, log_dt, b_re, b_im, c_re, c_im, d, w_glu):
    B, S = u.shape[:2]
    abar_re, abar_im, bbar_re, bbar_im = zoh(a_re, a_im, log_dt, b_re, b_im)
    ug = u.astype(jnp.float32).reshape(B, S, SSM_GROUPS, SSM_GROUP)
    bu_re = jnp.einsum('bsgh,gph->bsgp', ug, bbar_re)
    bu_im = jnp.einsum('bsgh,gph->bsgp', ug, bbar_im)
    if h0_re is not None:
        hr0, hi0 = h0_re.astype(jnp.float32), h0_im.astype(jnp.float32)
        bu_re = bu_re.at[:, 0].add(abar_re * hr0 - abar_im * hi0)
        bu_im = bu_im.at[:, 0].add(abar_re * hi0 + abar_im * hr0)
    ar = jnp.broadcast_to(abar_re, bu_re.shape)
    ai = jnp.broadcast_to(abar_im, bu_re.shape)
    _, _, hr, hi = lax.associative_scan(cplx_combine, (ar, ai, bu_re, bu_im), axis=1)
    y = (jnp.einsum('bsgp,ghp->bsgh', hr, c_re.astype(jnp.float32))
         - jnp.einsum('bsgp,ghp->bsgh', hi, c_im.astype(jnp.float32))
         + d.astype(jnp.float32) * ug).reshape(B, S, SSM_WIDTH)
    z = jax.nn.gelu(y)
    out = z * jax.nn.sigmoid(jnp.einsum('bsc,ce->bse', z, w_glu.astype(jnp.float32)))
    return out.astype(u.dtype), hr[:, -1], hi[:, -1]


def merge_out(att_o, ssm_o, g_att, g_ssm, w_out, g_post):
    cat = jnp.concatenate([rmsnorm(att_o, g_att), rmsnorm(ssm_o, g_ssm)], axis=-1)
    return rmsnorm(jnp.einsum('bse,ed->bsd', cat, w_out), g_post)


def sqrelu_mlp(h, g_pre, w_up, w_down, g_post):
    hn = rmsnorm(h, g_pre)
    a = jnp.square(jax.nn.relu(jnp.einsum('bsd,df->bsf', hn, w_up)))
    return rmsnorm(jnp.einsum('bsf,fd->bsd', a, w_down), g_post)


def setup_inputs(seed: int = 0) -> dict:
    key = jax.random.key(seed)
    ks = jax.random.split(key, 32)
    f32 = jnp.float32

    def nrm(k, shape, scale):
        return jax.random.normal(k, shape, f32) * scale

    def gain(k, shape):
        return 1.0 + 0.05 * jax.random.normal(k, shape, f32)

    w_cache = min(WINDOW, PAST_LEN)
    n_idx = jnp.arange(SSM_STATE, dtype=f32)
    return {
        'x_prompt': nrm(ks[0], (BATCH, SEQ, D_MODEL), 1.0),
        'x_sample': nrm(ks[1], (DEC_BATCH, DEC_SEQ, D_MODEL), 1.0),
        'cache_k_win': nrm(ks[2], (DEPTH, DEC_BATCH, w_cache, N_KV_HEADS, HEAD_DIM), 1.0),
        'cache_v_win': nrm(ks[3], (DEPTH, DEC_BATCH, w_cache, N_KV_HEADS, HEAD_DIM), 1.0),
        'state_ssm_re': nrm(ks[4], (DEPTH, DEC_BATCH, SSM_GROUPS, SSM_STATE), 0.5),
        'state_ssm_im': nrm(ks[5], (DEPTH, DEC_BATCH, SSM_GROUPS, SSM_STATE), 0.5),
        'meta_tokens': nrm(ks[6], (N_META, D_MODEL), 1.0),
        'norm_mix_pre': gain(ks[7], (DEPTH, D_MODEL)),
        'w_in': nrm(ks[8], (DEPTH, D_MODEL, D_IN), D_MODEL ** -0.5),
        'attn_sinks': nrm(ks[9], (DEPTH, N_HEADS), 0.5),
        'ssm_a_re': -0.5 + 0.01 * jax.random.normal(ks[10], (DEPTH, SSM_GROUPS, SSM_STATE), f32),
        'ssm_a_im': math.pi * n_idx + 0.01 * jax.random.normal(ks[11], (DEPTH, SSM_GROUPS, SSM_STATE), f32),
        'ssm_log_dt': jax.random.uniform(ks[12], (DEPTH, SSM_GROUPS), f32, math.log(0.001), math.log(0.1)),
        'ssm_b_re': nrm(ks[13], (DEPTH, SSM_GROUPS, SSM_STATE, SSM_GROUP), (2 * SSM_GROUP) ** -0.5),
        'ssm_b_im': nrm(ks[14], (DEPTH, SSM_GROUPS, SSM_STATE, SSM_GROUP), (2 * SSM_GROUP) ** -0.5),
        'ssm_c_re': nrm(ks[15], (DEPTH, SSM_GROUPS, SSM_GROUP, SSM_STATE), (2 * SSM_STATE) ** -0.5),
        'ssm_c_im': nrm(ks[16], (DEPTH, SSM_GROUPS, SSM_GROUP, SSM_STATE), (2 * SSM_STATE) ** -0.5),
        'ssm_d': nrm(ks[17], (DEPTH, SSM_GROUPS, SSM_GROUP), 1.0),
        'w_glu': nrm(ks[18], (DEPTH, SSM_WIDTH, SSM_WIDTH), SSM_WIDTH ** -0.5),
        'norm_att_out': gain(ks[19], (DEPTH, ATT_WIDTH)),
        'norm_ssm_out': gain(ks[20], (DEPTH, SSM_WIDTH)),
        'w_out': nrm(ks[21], (DEPTH, D_MIX, D_MODEL), D_MIX ** -0.5),
        'norm_mix_post': gain(ks[22], (DEPTH, D_MODEL)),
        'norm_mlp_pre': gain(ks[23], (DEPTH, D_MODEL)),
        'w_up': nrm(ks[24], (DEPTH, D_MODEL, D_FF), D_MODEL ** -0.5),
        'w_down': nrm(ks[25], (DEPTH, D_FF, D_MODEL), D_FF ** -0.5),
        'norm_mlp_post': gain(ks[26], (DEPTH, D_MODEL)),
    }


def reference(x_prompt, x_sample, cache_k_win, cache_v_win, state_ssm_re, state_ssm_im,
              meta_tokens, norm_mix_pre, w_in, attn_sinks, ssm_a_re, ssm_a_im, ssm_log_dt,
              ssm_b_re, ssm_b_im, ssm_c_re, ssm_c_im, ssm_d, w_glu, norm_att_out, norm_ssm_out,
              w_out, norm_mix_post, norm_mlp_pre, w_up, w_down, norm_mlp_post):
    B = x_prompt.shape[0]
    meta = jnp.broadcast_to(meta_tokens[None].astype(x_prompt.dtype), (B, N_META, D_MODEL))
    hp = jnp.concatenate([meta, x_prompt], axis=1)
    hs = x_sample
    pos_p = jnp.arange(hp.shape[1], dtype=jnp.int32)
    pos_s = PAST_LEN + jnp.arange(hs.shape[1], dtype=jnp.int32)

    kp_l, vp_l, srp_l, sip_l = [], [], [], []
    ks_l, vs_l, srs_l, sis_l = [], [], [], []
    for l in range(DEPTH):
        ssm_p = (ssm_a_re[l], ssm_a_im[l], ssm_log_dt[l], ssm_b_re[l], ssm_b_im[l],
                 ssm_c_re[l], ssm_c_im[l], ssm_d[l], w_glu[l])
        q, k, v, u = in_project(hp, norm_mix_pre[l], w_in[l])
        q, k = partial_rope(q, pos_p), partial_rope(k, pos_p)
        att_o = swa_prompt(q, k, v, attn_sinks[l])
        ssm_o, hr, hi = ssm_mixer(u, None, None, *ssm_p)
        hp = hp + merge_out(att_o, ssm_o, norm_att_out[l], norm_ssm_out[l], w_out[l], norm_mix_post[l])
        hp = hp + sqrelu_mlp(hp, norm_mlp_pre[l], w_up[l], w_down[l], norm_mlp_post[l])
        kp_l.append(k[:, -WINDOW:])
        vp_l.append(v[:, -WINDOW:])
        srp_l.append(hr.astype(x_prompt.dtype))
        sip_l.append(hi.astype(x_prompt.dtype))
        q, k, v, u = in_project(hs, norm_mix_pre[l], w_in[l])
        q, k = partial_rope(q, pos_s), partial_rope(k, pos_s)
        att_o, nk, nv = swa_sample(q, k, v, cache_k_win[l], cache_v_win[l], pos_s, attn_sinks[l])
        ssm_o, hr, hi = ssm_mixer(u, state_ssm_re[l], state_ssm_im[l], *ssm_p)
        hs = hs + merge_out(att_o, ssm_o, norm_att_out[l], norm_ssm_out[l], w_out[l], norm_mix_post[l])
        hs = hs + sqrelu_mlp(hs, norm_mlp_pre[l], w_up[l], w_down[l], norm_mlp_post[l])
        ks_l.append(nk)
        vs_l.append(nv)
        srs_l.append(hr.astype(state_ssm_re.dtype))
        sis_l.append(hi.astype(state_ssm_im.dtype))

    y_prompt = hp[:, N_META:]
    y_sample = hs
    return (y_prompt, y_sample,
            jnp.stack(kp_l), jnp.stack(vp_l), jnp.stack(srp_l), jnp.stack(sip_l),
            jnp.stack(ks_l), jnp.stack(vs_l), jnp.stack(srs_l), jnp.stack(sis_l))
```

```cpp
#include <hip/hip_runtime.h>
#include <cstdio>
#include <cstdint>
namespace pg8 {
#define PG8_LAS __attribute__((address_space(3)))
typedef unsigned short bf16_t;
typedef short bf16x8 __attribute__((ext_vector_type(8)));
typedef float f32x4 __attribute__((ext_vector_type(4)));
typedef unsigned u32x4 __attribute__((ext_vector_type(4)));
constexpr int BM = 256, BK = 64, HALF = 128, HTB = HALF * BK * 2  , STAGE_BYTES = 8 * HTB, NXCD = 8, WGM = 8;

__host__ __device__ __forceinline__ int lds_byte(int r, int c) { const int st = (r >> 4) * 2 + (c >> 5), rr = r & 15, cc = c & 31, ob = rr * 64 + cc * 2; return st * 1024 + (ob ^ (((ob >> 9) & 1) << 5)); }
__host__ __device__ __forceinline__ void stage_rc(int b, int& R, int& C) { const int st = b / 1024, sb = b % 1024, swz = sb ^ (((sb >> 9) & 1) << 5); R = (st >> 1) * 16 + swz / 64; C = (st & 1) * 32 + (swz % 64) / 2; }
__host__ __device__ __forceinline__ int perm32(int rho) { const int n = rho >> 4, i = rho & 15; return 8 * (i >> 2) + 4 * n + (i & 3); }

struct Unit { int pm, pn; };
struct Gemm { const bf16_t* A; const bf16_t* Bt; int M, N, K; };

struct StaticOrder {
    int nM, nN, nwg, G, c;
    __host__ __device__ void init(int M, int N, int G_, int c_) { nM = M / BM; nN = N / BM; nwg = nM * nN; G = G_; c = c_; }
    __host__ __device__ bool next(int i, Unit& u) const {
        const long L = (long)i * G + c; if (L >= nwg) return false;
        int wgid = (int)L; { const int q = nwg / NXCD, r = nwg % NXCD, xcd = wgid % NXCD, off = wgid / NXCD; wgid = (xcd < r ? xcd * (q + 1) : r * (q + 1) + (xcd - r) * q) + off; }
        const int nig = WGM * nN, gid = wgid / nig, fm = gid * WGM, gsz = (nM - fm) < WGM ? (nM - fm) : WGM;
        u.pm = fm + ((wgid % nig) % gsz); u.pn = (wgid % nig) / gsz; return true;
    }
    __device__ __forceinline__ void a_ready(const Unit&) const {}
    __device__ __forceinline__ void done(const Unit&) const {}
};
__device__ __forceinline__ unsigned cvt_pk_bf16(float lo, float hi) { unsigned r; asm volatile("v_cvt_pk_bf16_f32 %0, %1, %2" : "=v"(r) : "v"(lo), "v"(hi)); return r; }
template <int ACT> struct EpiBf16 {
    static constexpr bool PERM = true, AFTER_DRAIN = false;
    bf16_t* O; int ldc;
    __device__ __forceinline__ void operator()(const f32x4 (&acc)[2][2][4][2], const Unit& u, int wr, int wc, int fr, int fq) const {
        const int row0 = u.pm * BM + wr * 64 + fr; const int col0 = u.pn * BM + wc * 32 + 8 * fq;
#pragma unroll
        for (int ai = 0; ai < 2; ++ai)
#pragma unroll
            for (int m = 0; m < 4; ++m) { bf16_t* rowp = O + (size_t)(row0 + ai * HALF + m * 16) * ldc + col0;
#pragma unroll
                for (int bj = 0; bj < 2; ++bj) { f32x4 v0 = acc[ai][bj][m][0], v1 = acc[ai][bj][m][1];
                    if (ACT == 2) {
#pragma unroll
                        for (int e = 0; e < 4; ++e) { const float a = fmaxf(v0[e], 0.f), b = fmaxf(v1[e], 0.f); v0[e] = a * a; v1[e] = b * b; } }
                    u32x4 w; w.x = cvt_pk_bf16(v0[0], v0[1]); w.y = cvt_pk_bf16(v0[2], v0[3]); w.z = cvt_pk_bf16(v1[0], v1[1]); w.w = cvt_pk_bf16(v1[2], v1[3]);
                    *(u32x4*)(rowp + bj * HALF) = w; } }
    }
};
template <class Epi, class Sched, bool ALIGN_EPI = false, bool SP2 = false>
__device__ __forceinline__ void gemm_phase(PG8_LAS unsigned char* lds, const Gemm g, const Sched& S, const Epi& E) {
    const int tid = threadIdx.x, wid = __builtin_amdgcn_readfirstlane(tid >> 6), lane = tid & 63, wr = wid >> 2, wc = wid & 3, fr = lane & 15, fq = lane >> 4;
    const int K = g.K, nt = K / BK;
    unsigned voffA[2], voffB[2];
#pragma unroll
    for (int i = 0; i < 2; ++i) { int R, C; stage_rc(tid * 16 + i * 8192, R, C); const int Rb = Epi::PERM ? ((R & ~31) + perm32(R & 31)) : R;
        voffA[i] = (unsigned)(R * K + C) * 2u; voffB[i] = (unsigned)(Rb * K + C) * 2u; }
    const size_t kstep = (size_t)(BK * 2);
    const size_t hstep = (size_t)HALF * K * 2;
    const size_t tstep = 2 * hstep;
    const unsigned ldsw = (unsigned)wid * 1024u;
    const int aoff = lds_byte(wr * 64 + fr, fq * 8), boff = lds_byte(wc * 32 + fr, fq * 8);
#define PG8_SA(b, h) (((b) * 2 + (h)) * HTB)
#define PG8_SB(b, h) ((4 + (b) * 2 + (h)) * HTB)
#define PG8_STAGE(bufoff, gbase, voff) do { _Pragma("unroll") for (int _i = 0; _i < 2; ++_i) \
        __builtin_amdgcn_global_load_lds((const unsigned*)((const char*)(gbase) + (voff)[_i]), (PG8_LAS unsigned*)(lds + (bufoff) + ldsw + _i * 8192), 16, 0, 0); } while (0)
#define PG8_LDA(dst, b, h) do { _Pragma("unroll") for (int m = 0; m < 4; ++m) _Pragma("unroll") for (int k = 0; k < 2; ++k) dst[m][k] = *(const PG8_LAS bf16x8*)(lds + PG8_SA(b, h) + aoff + m * 2048 + k * 1024); } while (0)
#define PG8_LDB(dst, b, h) do { _Pragma("unroll") for (int n = 0; n < 2; ++n) _Pragma("unroll") for (int k = 0; k < 2; ++k) dst[n][k] = *(const PG8_LAS bf16x8*)(lds + PG8_SB(b, h) + boff + n * 2048 + k * 1024); } while (0)
#define PG8_MMA(ai, bj, At, Bt) do { __builtin_amdgcn_s_setprio(1); _Pragma("unroll") for (int m = 0; m < 4; ++m) _Pragma("unroll") for (int n = 0; n < 2; ++n) _Pragma("unroll") for (int k = 0; k < 2; ++k) \
        acc[ai][bj][m][n] = __builtin_amdgcn_mfma_f32_16x16x32_bf16(Bt[n][k], At[m][k], acc[ai][bj][m][n], 0, 0, 0); __builtin_amdgcn_s_setprio(0); } while (0)
#define PG8_WAIT_V(n) asm volatile("s_waitcnt vmcnt(" #n ")" ::: "memory")
#define PG8_WAIT_L(n) asm volatile("s_waitcnt lgkmcnt(" #n ")" ::: "memory")
#define PG8_BAR __builtin_amdgcn_s_barrier()
#define PG8_SCHED __builtin_amdgcn_sched_barrier(0)
    Unit cur, nxt; int ui = 0;
    if (!S.next(0, cur)) return;
    f32x4 acc[2][2][4][2];
#pragma unroll
    for (int a = 0; a < 2; ++a)
#pragma unroll
        for (int b = 0; b < 2; ++b)
#pragma unroll
            for (int m = 0; m < 4; ++m)
#pragma unroll
                for (int n = 0; n < 2; ++n) acc[a][b][m][n] = (f32x4){0.f, 0.f, 0.f, 0.f};
    bf16x8 At[4][2], B0[2][2], B1[2][2];
    const char* cA = (const char*)g.A + (size_t)cur.pm * tstep; const char* cB = (const char*)g.Bt + (size_t)cur.pn * tstep;
    S.a_ready(cur);
    if constexpr (SP2) {
        PG8_STAGE(PG8_SB(0, 0), cB, voffB); PG8_STAGE(PG8_SB(0, 1), cB + hstep, voffB); PG8_STAGE(PG8_SA(0, 0), cA, voffA); PG8_STAGE(PG8_SA(0, 1), cA + hstep, voffA);
        if (wr == 1) PG8_BAR;
        PG8_WAIT_V(2); PG8_BAR;
        PG8_STAGE(PG8_SB(1, 0), cB + kstep, voffB); PG8_STAGE(PG8_SA(1, 0), cA + kstep, voffA); PG8_STAGE(PG8_SB(1, 1), cB + hstep + kstep, voffB);
        PG8_WAIT_V(6); PG8_BAR;
    } else {
        PG8_STAGE(PG8_SB(0, 0), cB, voffB); PG8_STAGE(PG8_SA(0, 0), cA, voffA); PG8_STAGE(PG8_SB(0, 1), cB + hstep, voffB); PG8_STAGE(PG8_SA(0, 1), cA + hstep, voffA);
        if (wr == 1) PG8_BAR;
        PG8_WAIT_V(4); PG8_BAR;
        PG8_STAGE(PG8_SB(1, 0), cB + kstep, voffB); PG8_STAGE(PG8_SA(1, 0), cA + kstep, voffA); PG8_STAGE(PG8_SB(1, 1), cB + hstep + kstep, voffB);
        PG8_WAIT_V(6); PG8_BAR;
    }
    for (;;) {
        const bool has_next = S.next(ui + 1, nxt);
        const char* nA = has_next ? (const char*)g.A + (size_t)nxt.pm * tstep : cA; const char* nB = has_next ? (const char*)g.Bt + (size_t)nxt.pn * tstep : cB;
        for (int t = 0; t < nt; t += 2) {
            const bool last = (t == nt - 2);
            const char* a1 = cA + (size_t)(t + 1) * kstep;
            const char* a2 = last ? nA : cA + (size_t)(t + 2) * kstep; const char* b2 = last ? nB : cB + (size_t)(t + 2) * kstep;
            const char* a3 = a2 + kstep; const char* b3 = b2 + kstep;
            if (last && has_next) S.a_ready(nxt);
            if constexpr (SP2) {
            PG8_LDB(B0, 0, 0); PG8_LDB(B1, 0, 1); PG8_SCHED; PG8_LDA(At, 0, 0); PG8_STAGE(PG8_SA(1, 1), a1 + hstep, voffA);
            PG8_WAIT_V(8); PG8_WAIT_L(0); PG8_BAR; PG8_MMA(0, 0, At, B0); PG8_MMA(0, 1, At, B1); PG8_BAR; PG8_SCHED;
            PG8_LDA(At, 0, 1); PG8_STAGE(PG8_SB(0, 0), b2, voffB); PG8_STAGE(PG8_SB(0, 1), b2 + hstep, voffB); PG8_STAGE(PG8_SA(0, 0), a2, voffA);
            PG8_WAIT_V(8); PG8_WAIT_L(0); PG8_BAR; PG8_MMA(1, 0, At, B0); PG8_MMA(1, 1, At, B1); PG8_BAR; PG8_SCHED;
            PG8_LDB(B0, 1, 0); PG8_LDB(B1, 1, 1); PG8_SCHED; PG8_LDA(At, 1, 0); PG8_STAGE(PG8_SA(0, 1), a2 + hstep, voffA);
            PG8_WAIT_V(8); PG8_WAIT_L(0); PG8_BAR; PG8_MMA(0, 0, At, B0); PG8_MMA(0, 1, At, B1); PG8_BAR; PG8_SCHED;
            PG8_LDA(At, 1, 1); PG8_STAGE(PG8_SB(1, 0), b3, voffB); PG8_STAGE(PG8_SB(1, 1), b3 + hstep, voffB); PG8_STAGE(PG8_SA(1, 0), a3, voffA);
            PG8_WAIT_V(8); PG8_WAIT_L(0); PG8_BAR; PG8_MMA(1, 0, At, B0); PG8_MMA(1, 1, At, B1); PG8_BAR; PG8_SCHED;
            } else {
            PG8_LDB(B0, 0, 0); PG8_SCHED; PG8_LDA(At, 0, 0); PG8_STAGE(PG8_SA(1, 1), a1 + hstep, voffA);
            PG8_WAIT_L(8); PG8_BAR; PG8_WAIT_L(0); PG8_MMA(0, 0, At, B0); PG8_BAR; PG8_SCHED;
            PG8_LDB(B1, 0, 1); PG8_STAGE(PG8_SB(0, 0), b2, voffB);
            PG8_BAR; PG8_WAIT_L(0); PG8_MMA(0, 1, At, B1); PG8_BAR;
            PG8_LDA(At, 0, 1); PG8_STAGE(PG8_SA(0, 0), a2, voffA);
            PG8_BAR; PG8_WAIT_L(0); PG8_MMA(1, 0, At, B0); PG8_BAR; PG8_SCHED;
            PG8_STAGE(PG8_SB(0, 1), b2 + hstep, voffB);
            PG8_WAIT_V(6); PG8_BAR; PG8_MMA(1, 1, At, B1); PG8_BAR;
            PG8_LDB(B0, 1, 0); PG8_SCHED; PG8_LDA(At, 1, 0); PG8_STAGE(PG8_SA(0, 1), a2 + hstep, voffA);
            PG8_WAIT_L(8); PG8_BAR; PG8_WAIT_L(0); PG8_MMA(0, 0, At, B0); PG8_BAR; PG8_SCHED;
            PG8_LDB(B1, 1, 1); PG8_STAGE(PG8_SB(1, 0), b3, voffB);
            PG8_BAR; PG8_WAIT_L(0); PG8_MMA(0, 1, At, B1); PG8_BAR;
            PG8_LDA(At, 1, 1); PG8_STAGE(PG8_SA(1, 0), a3, voffA);
            PG8_BAR; PG8_WAIT_L(0); PG8_MMA(1, 0, At, B0); PG8_BAR; PG8_SCHED;
            PG8_STAGE(PG8_SB(1, 1), b3 + hstep, voffB);
            PG8_WAIT_V(6); PG8_BAR; PG8_MMA(1, 1, At, B1); PG8_BAR;
            }
        }
        if constexpr (ALIGN_EPI) { if (wr == 0) PG8_BAR; }
        if constexpr (!Epi::AFTER_DRAIN) { E(acc, cur, wr, wc, fr, fq); S.done(cur); }
        if (!has_next) break;
#pragma unroll
        for (int a = 0; a < 2; ++a)
#pragma unroll
            for (int b = 0; b < 2; ++b)
#pragma unroll
                for (int m = 0; m < 4; ++m)
#pragma unroll
                    for (int n = 0; n < 2; ++n) acc[a][b][m][n] = (f32x4){0.f, 0.f, 0.f, 0.f};
        cur = nxt; cA = nA; cB = nB; ++ui;
        if constexpr (ALIGN_EPI) { if (wr == 1) PG8_BAR; }
    }
    PG8_WAIT_V(0);
    if constexpr (!ALIGN_EPI) { if (wr == 0) PG8_BAR; }
    PG8_BAR;
    if constexpr (Epi::AFTER_DRAIN) { E.fused(acc, cur, wr, wc, fr, fq, lds, wid, lane); S.done(cur); }
#undef PG8_SA
#undef PG8_SB
#undef PG8_STAGE
#undef PG8_LDA
#undef PG8_LDB
#undef PG8_MMA
#undef PG8_WAIT_V
#undef PG8_WAIT_L
#undef PG8_BAR
#undef PG8_SCHED
}
}

constexpr int NWAVES = 8;
constexpr int D = 1024, DIN = 1280, DFF = 4096, AW = 512, SW = 512;
constexpr int MP = 16384, MS = 512, MR = MP + MS;
constexpr int MMETA = MR, NMETA = 16, MIN_ROWS = 17152;
constexpr int NPOS = 4112 + 4;
constexpr float EPS = 1e-6f;
constexpr size_t O_YP = 0, O_YS = 16777216, O_KP = 17301504, O_VP = 17367040, O_SRP = 17432576, O_SIP = 17440768, O_KS = 17448960, O_VS = 19546112, O_SRS = 21643264, O_SIS = 21905408;
constexpr size_t MiB = 1u << 20;
constexpr size_t WS_CTL = 0, CTL_ZERO_BYTES = 1 * MiB;
constexpr size_t WS_ROPEC = 1 * MiB, WS_ROPES = WS_ROPEC + 160 * 1024, WS_ABR = WS_ROPES + 160 * 1024, WS_ABI = WS_ABR + 8192, WS_BBR = WS_ABI + 8192, WS_BBI = WS_BBR + 131072;
static_assert(WS_BBI + 131072 <= 2 * MiB && NPOS * 8 * 4 <= 160 * 1024, "tables");
constexpr size_t WS_WIN = 2 * MiB, WS_WGLU = 5 * MiB, WS_WOUT = 6 * MiB, WS_WUP = 8 * MiB, WS_WDN = 16 * MiB;
constexpr size_t WS_XN = 24 * MiB, WS_O = 58 * MiB, WS_P = 92 * MiB, WS_ATT = 134 * MiB, WS_Z = 151 * MiB, WS_GL = 168 * MiB, WS_CAT = 185 * MiB, WS_H = 92 * MiB, WS_END = 224 * MiB;
static_assert(WS_XN + (size_t)MIN_ROWS * D * 2 <= WS_O && WS_O + (size_t)MR * D * 2 <= WS_P && WS_P + (size_t)MIN_ROWS * DIN * 2 <= WS_ATT && WS_ATT + (size_t)MR * AW * 2 <= WS_Z && WS_Z + (size_t)MR * SW * 2 <= WS_GL &&
              WS_GL + (size_t)MR * SW * 2 <= WS_CAT && WS_CAT + (size_t)MR * D * 2 <= WS_END && WS_H + (size_t)MR * DFF * 2 <= WS_END, "d_ws map");
constexpr int CW_BAR = 4096;
constexpr int RING_BYTES = 131072, LDSCTL_OFF = RING_BYTES, MISC_OFF = LDSCTL_OFF + 320, LDS_BYTES = 147456;

#define GAS __attribute__((address_space(1)))
#define LAS __attribute__((address_space(3)))
typedef unsigned short bf16;
typedef unsigned v4u __attribute__((ext_vector_type(4)));
typedef unsigned v2u __attribute__((ext_vector_type(2)));
typedef float f32x4 __attribute__((ext_vector_type(4)));
typedef GAS unsigned gu32;
#define RLX_AGENT __ATOMIC_RELAXED, __HIP_MEMORY_SCOPE_AGENT
#define LDS_WAIT() asm volatile("s_waitcnt lgkmcnt(0)" ::: "memory")
#define VM_WAIT() asm volatile("s_waitcnt vmcnt(0)" ::: "memory")
__device__ __forceinline__ unsigned f2bf(float f) { unsigned u = __builtin_bit_cast(unsigned, f); return (u + 0x7fffu + ((u >> 16) & 1u)) >> 16; }
__device__ __forceinline__ unsigned pk2(float lo, float hi) { return f2bf(lo) | (f2bf(hi) << 16); }
__device__ __forceinline__ float bflo(unsigned w) { return __uint_as_float(w << 16); }
__device__ __forceinline__ float bfhi(unsigned w) { return __uint_as_float(w & 0xffff0000u); }
__device__ __forceinline__ float bf1(bf16 b) { return __uint_as_float((unsigned)b << 16); }

#define XB_TMO      128
#define XB_XCNT(j)  (256  + 64 * (j))
#define XB_XSUB(j)  (1280 + 64 * (j))
#define XB_XGEN(j)  (2304 + 64 * (j))
#define XB_TOP      3328
#define XB_TOPGEN   3392
#define XCD_BAR_WORDS 3456
#define XB_SPIN_CAP (1u << 18)
__device__ __forceinline__ unsigned xb_ld(unsigned* p)              { return __hip_atomic_load(p, __ATOMIC_RELAXED, __HIP_MEMORY_SCOPE_AGENT); }
__device__ __forceinline__ unsigned xb_add(unsigned* p, unsigned v) { return __hip_atomic_fetch_add(p, v, __ATOMIC_RELAXED, __HIP_MEMORY_SCOPE_AGENT); }
__device__ __forceinline__ unsigned xb_xcc_id() { return (unsigned)__builtin_amdgcn_s_getreg((3 << 11) | 20) & 0xFu; }
#define XB_SPIN(cond, bar) do { unsigned _sp = 0; while (cond) { __builtin_amdgcn_s_sleep(1); \
    if ((++_sp & 255u) == 0u) { if (xb_ld(&(bar)[XB_TMO])) break; if (_sp > XB_SPIN_CAP) { atomicAdd(&(bar)[XB_TMO], 1u); break; } } } } while (0)
struct XcdBarrier { unsigned* bar; unsigned x; volatile LAS unsigned* st; };
__device__ __forceinline__ XcdBarrier xcd_barrier_post(unsigned* bar, volatile LAS unsigned* st) {
    XcdBarrier b; b.bar = bar; b.x = xb_xcc_id(); b.st = st;
    if (threadIdx.x == 0) (void)xb_add(&bar[XB_XCNT(b.x)], 1u);
    return b;
}
__device__ __forceinline__ void xcd_barrier_complete(unsigned* bar, unsigned x, unsigned& nloc, unsigned& nx) {
    const unsigned G = gridDim.x * gridDim.y * gridDim.z;
    unsigned sum, cnt, mine, sp = 0u;
    for (;;) {
        sum = 0u; cnt = 0u; mine = 0u;
#pragma unroll
        for (unsigned j = 0; j < 16; ++j) { const unsigned c = xb_ld(&bar[XB_XCNT(j)]); sum += c; cnt += (c > 0u) ? 1u : 0u; mine = (j == x) ? c : mine; }
        if (sum == G) break;
        __builtin_amdgcn_s_sleep(1);
        if ((++sp & 255u) == 0u) { if (xb_ld(&bar[XB_TMO])) break; if (sp > XB_SPIN_CAP) { atomicAdd(&bar[XB_TMO], 1u); break; } }
    }
    nloc = mine > 0u ? mine : 1u; nx = cnt > 0u ? cnt : 1u;
}
__device__ __forceinline__ void xcd_barrier(const XcdBarrier& b) {
    asm volatile("s_waitcnt vmcnt(0)" ::: "memory");
    __syncthreads();
    if (threadIdx.x == 0) {
        unsigned* bar = b.bar;
        __builtin_amdgcn_s_waitcnt(0);
        unsigned nloc = b.st[0], nx = b.st[1];
        if (nloc == 0u) { xcd_barrier_complete(bar, b.x, nloc, nx); b.st[0] = nloc; b.st[1] = nx; }
        const unsigned old = xb_add(&bar[XB_XSUB(b.x)], 1u);
        const unsigned gen = old / nloc;
        if (old + 1u == (gen + 1u) * nloc) {
            __builtin_amdgcn_fence(__ATOMIC_RELEASE, "agent");
            asm volatile("s_waitcnt vmcnt(0)" ::: "memory");
            const unsigned og = xb_add(&bar[XB_TOP], 1u);
            const unsigned tg = og / nx;
            if (og + 1u == (tg + 1u) * nx) xb_add(&bar[XB_TOPGEN], 1u);
            else XB_SPIN(xb_ld(&bar[XB_TOPGEN]) == tg, bar);
            __builtin_amdgcn_fence(__ATOMIC_ACQUIRE, "agent");
            xb_add(&bar[XB_XGEN(b.x)], 1u);
            asm volatile("s_waitcnt vmcnt(0)" ::: "memory");
        } else {
            XB_SPIN(xb_ld(&bar[XB_XGEN(b.x)]) == gen, bar);
            __builtin_amdgcn_fence(__ATOMIC_ACQUIRE, "agent");
            asm volatile("s_waitcnt vmcnt(0)" ::: "memory");
        }
    }
    __syncthreads();
}

struct Frame {
    LAS unsigned char* lds;
    volatile LAS unsigned* MISC;
    gu32* ctl;
    int tid, lane, wave;
    int vcu, G;
    const float* in[27]; float* out; unsigned char* ws;
};
enum { I_XP = 0, I_XS, I_CK, I_CV, I_SRE, I_SIM, I_META, I_GPRE, I_WIN, I_SINK, I_ARE, I_AIM, I_LDT, I_BRE, I_BIM, I_CRE, I_CIM, I_DD, I_WGLU, I_GATT, I_GSSM, I_WOUT, I_GPOST, I_GMLP, I_WUP, I_WDN, I_GMLPP };

__device__ __forceinline__ float wave_sum(float v) {
#pragma unroll
    for (int o = 1; o < 64; o <<= 1) v += __shfl_xor(v, o);
    return v;
}
__device__ __forceinline__ float wave_max(float v) {
#pragma unroll
    for (int o = 1; o < 64; o <<= 1) v = fmaxf(v, __shfl_xor(v, o));
    return v;
}
__device__ __forceinline__ void sincos_d(double a, double& s, double& c) {
    const double k = __builtin_rint(a * 0.63661977236758134308);
    double r = __builtin_fma(-k, 1.57079632679489655800e+00, a);
    r = __builtin_fma(-k, 6.12323399573676603587e-17, r);
    const double r2 = r * r;
    double sp = 1.0 / 6227020800.0; sp = sp * r2 - 1.0 / 39916800.0; sp = sp * r2 + 1.0 / 362880.0; sp = sp * r2 - 1.0 / 5040.0; sp = sp * r2 + 1.0 / 120.0; sp = sp * r2 - 1.0 / 6.0; sp = sp * r2 + 1.0; sp = sp * r;
    double cp = -1.0 / 87178291200.0; cp = cp * r2 + 1.0 / 479001600.0; cp = cp * r2 - 1.0 / 3628800.0; cp = cp * r2 + 1.0 / 40320.0; cp = cp * r2 - 1.0 / 720.0; cp = cp * r2 + 1.0 / 24.0; cp = cp * r2 - 0.5; cp = cp * r2 + 1.0;
    const int q = ((int)k) & 3;
    s = (q == 0) ? sp : (q == 1) ? cp : (q == 2) ? -sp : -cp;
    c = (q == 0) ? cp : (q == 1) ? -sp : (q == 2) ? -cp : sp;
}
__device__ __forceinline__ double exp_d(double x) {
    const double k = __builtin_rint(x * 1.44269504088896340736);
    double r = __builtin_fma(-k, 6.93147180369123816490e-01, x); r = __builtin_fma(-k, 1.90821492927058770002e-10, r);
    double p = 1.0 / 6227020800.0; p = p * r + 1.0 / 479001600.0; p = p * r + 1.0 / 39916800.0; p = p * r + 1.0 / 3628800.0; p = p * r + 1.0 / 362880.0; p = p * r + 1.0 / 40320.0; p = p * r + 1.0 / 5040.0;
    p = p * r + 1.0 / 720.0; p = p * r + 1.0 / 120.0; p = p * r + 1.0 / 24.0; p = p * r + 1.0 / 6.0; p = p * r + 0.5; p = p * r + 1.0; p = p * r + 1.0;
    const long long bits = ((long long)(1023 + (int)k)) << 52;
    return p * __builtin_bit_cast(double, bits);
}
__device__ __forceinline__ float gelu_tanh(float x) {
    const float a = 0.7978845608028654f * (x + 0.044715f * x * x * x);
    const float e = __expf(2.0f * a);
    const float t = 1.0f - 2.0f / (e + 1.0f);
    return 0.5f * x * (1.0f + t);
}
__device__ __forceinline__ float sigmoidf_(float x) { return 1.0f / (1.0f + __expf(-x)); }

__device__ __forceinline__ void p0_transpose_item(const float* W, int K, int N, bf16* WT, LAS float* scr, int item, int lane) {
    const int nblk = N / 32, kb = item / nblk, nb = item % nblk, k0 = 64 * kb, n0 = 32 * nb;
#pragma unroll 8
    for (int i = 0; i < 32; ++i) { const int kk = 2 * i + (lane >> 5); scr[kk * 33 + (lane & 31)] = W[(size_t)(k0 + kk) * N + n0 + (lane & 31)]; }
    LDS_WAIT(); asm volatile("" ::: "memory");
    const int c = lane & 7;
#pragma unroll
    for (int j = 0; j < 4; ++j) { const int n = (lane >> 3) + 8 * j; const LAS float* s = scr + (8 * c) * 33 + n;
        v4u o; o.x = pk2(s[0 * 33], s[1 * 33]); o.y = pk2(s[2 * 33], s[3 * 33]); o.z = pk2(s[4 * 33], s[5 * 33]); o.w = pk2(s[6 * 33], s[7 * 33]);
        *(GAS v4u*)(WT + (size_t)(n0 + n) * K + k0 + 8 * c) = o; }
    LDS_WAIT(); asm volatile("" ::: "memory");
}
__device__ __forceinline__ void rms_row_to_bf16(const float* xrow, const float* g, bf16* orow, int lane) {
    const GAS f32x4* xr = (const GAS f32x4*)xrow + lane;
    f32x4 v[4]; float s = 0.f;
#pragma unroll
    for (int j = 0; j < 4; ++j) { v[j] = xr[64 * j]; s += (v[j].x * v[j].x + v[j].y * v[j].y) + (v[j].z * v[j].z + v[j].w * v[j].w); }
    const float rs = 1.0f / sqrtf(wave_sum(s) * (1.f / 1024.f) + EPS);
    GAS unsigned long long* o8 = (GAS unsigned long long*)orow + lane;
#pragma unroll
    for (int j = 0; j < 4; ++j) { const f32x4 gg = ((const GAS f32x4*)g)[lane + 64 * j];
        o8[64 * j] = (unsigned long long)pk2(v[j].x * rs * gg.x, v[j].y * rs * gg.y) | ((unsigned long long)pk2(v[j].z * rs * gg.z, v[j].w * rs * gg.w) << 32); }
}
__device__ __forceinline__ const float* x_row_ptr(const Frame& F, int r) {
    return r < MP ? F.in[I_XP] + (size_t)r * D : (r < MR ? F.in[I_XS] + (size_t)(r - MP) * D : F.in[I_META] + (size_t)(r - MR) * D);
}
__device__ __forceinline__ void p0_prologue(Frame& F) {
    LAS float* scr = (LAS float*)(F.lds + F.wave * 16384);
    const int gw = F.vcu * NWAVES + F.wave, NGW = F.G * NWAVES;
    constexpr int I_IN = (D / 64) * (DIN / 32), I_GL = (SW / 64) * (SW / 32), I_OU = (D / 64) * (D / 32), I_UP = (D / 64) * (DFF / 32), I_DN = (DFF / 64) * (D / 32);
    constexpr int NITEMS = I_IN + I_GL + I_OU + I_UP + I_DN;
    for (int it = gw; it < NITEMS; it += NGW) {
        int r = it;
        if (r < I_IN) { p0_transpose_item(F.in[I_WIN], D, DIN, (bf16*)(F.ws + WS_WIN), scr, r, F.lane); continue; } r -= I_IN;
        if (r < I_GL) { p0_transpose_item(F.in[I_WGLU], SW, SW, (bf16*)(F.ws + WS_WGLU), scr, r, F.lane); continue; } r -= I_GL;
        if (r < I_OU) { p0_transpose_item(F.in[I_WOUT], D, D, (bf16*)(F.ws + WS_WOUT), scr, r, F.lane); continue; } r -= I_OU;
        if (r < I_UP) { p0_transpose_item(F.in[I_WUP], D, DFF, (bf16*)(F.ws + WS_WUP), scr, r, F.lane); continue; } r -= I_UP;
        p0_transpose_item(F.in[I_WDN], DFF, D, (bf16*)(F.ws + WS_WDN), scr, r, F.lane);
    }
    bf16* XN = (bf16*)(F.ws + WS_XN);
    for (int m = gw; m < MIN_ROWS; m += NGW) {
        if (m < MR + NMETA) rms_row_to_bf16(x_row_ptr(F, m), F.in[I_GPRE], XN + (size_t)m * D, F.lane);
        else { GAS unsigned long long* o8 = (GAS unsigned long long*)(XN + (size_t)m * D) + F.lane;
#pragma unroll
            for (int j = 0; j < 4; ++j) o8[64 * j] = 0ull; }
    }
    const int gt = F.vcu * (NWAVES * 64) + F.tid, NT = F.G * NWAVES * 64;
    float* ropeC = (float*)(F.ws + WS_ROPEC); float* ropeS = (float*)(F.ws + WS_ROPES);
    for (int i = gt; i < NPOS * 8; i += NT) {
        const int idx = i >> 3, fi = i & 7; const int pos = idx < 4112 ? idx : 8192 + (idx - 4112);
        const float inv = (float)exp_d(-(double)fi * 1.640295422175541);
        const float ang = (float)pos * inv;
        double s, c; sincos_d((double)ang, s, c);
        ropeC[i] = (float)c; ropeS[i] = (float)s;
    }
    float* abr = (float*)(F.ws + WS_ABR); float* abi = (float*)(F.ws + WS_ABI); float* bbr = (float*)(F.ws + WS_BBR); float* bbi = (float*)(F.ws + WS_BBI);
    for (int i = gt; i < 2048; i += NT) {
        const int g = i >> 6;
        const double dt = exp_d((double)F.in[I_LDT][g]); const double ar = (double)F.in[I_ARE][i], ai = (double)F.in[I_AIM][i];
        const double mag = exp_d(ar * dt); double s, c; sincos_d(ai * dt, s, c);
        const double are = mag * c, aim = mag * s;
        const double nr = are - 1.0, ni = aim, den = ar * ar + ai * ai;
        const double cr = (nr * ar + ni * ai) / den, ci = (ni * ar - nr * ai) / den;
        abr[i] = (float)are; abi[i] = (float)aim;
        for (int h = 0; h < 16; ++h) { const double br = (double)F.in[I_BRE][i * 16 + h], bi = (double)F.in[I_BIM][i * 16 + h];
            bbr[i * 16 + h] = (float)(cr * br - ci * bi); bbi[i * 16 + h] = (float)(cr * bi + ci * br); }
    }
}
__device__ __forceinline__ int pos_index(int r) { return r < MP ? (r & 4095) + 16 : (r < MR ? 4112 + ((r - MP) & 3) : r - MR); }
__device__ __forceinline__ void p2_rope(Frame& F) {
    const int gt = F.vcu * (NWAVES * 64) + F.tid, NT = F.G * NWAVES * 64;
    bf16* P = (bf16*)(F.ws + WS_P); const float* ropeC = (const float*)(F.ws + WS_ROPEC); const float* ropeS = (const float*)(F.ws + WS_ROPES);
    for (int it = gt; it < (MR + NMETA) * 80; it += NT) {
        const int r = it / 80, rem = it - r * 80, hh = rem >> 3, fi = rem & 7;
        bf16* p = P + (size_t)r * DIN + hh * 64 + fi;
        const float x1 = bf1(p[0]), x2 = bf1(p[8]);
        const int pi = pos_index(r) * 8 + fi; const float c = ropeC[pi], s = ropeS[pi];
        p[0] = (bf16)f2bf(x1 * c - x2 * s); p[8] = (bf16)f2bf(x2 * c + x1 * s);
    }
}
__device__ __forceinline__ void p3_ssm_naive(Frame& F) {
    LAS float* hs = (LAS float*)(F.lds + F.wave * 16384);
    const int gw = F.vcu * NWAVES + F.wave, NGW = F.G * NWAVES, lane = F.lane;
    const bf16* P = (const bf16*)(F.ws + WS_P); bf16* Z = (bf16*)(F.ws + WS_Z);
    const float* abr = (const float*)(F.ws + WS_ABR); const float* abi = (const float*)(F.ws + WS_ABI); const float* bbr = (const float*)(F.ws + WS_BBR); const float* bbi = (const float*)(F.ws + WS_BBI);
    for (int task = gw; task < (4 + 128) * 32; task += NGW) {
        const int seq = task >> 5, g = task & 31, gp = g * 64 + lane;
        const float are = abr[gp], aim = abi[gp];
        float br[16], bi[16];
#pragma unroll
        for (int h = 0; h < 16; ++h) { br[h] = bbr[gp * 16 + h]; bi[h] = bbi[gp * 16 + h]; }
        const int ho = lane & 15, qq = lane >> 4;
        float cr[16], ci[16];
#pragma unroll
        for (int j = 0; j < 16; ++j) { cr[j] = F.in[I_CRE][(g * 16 + ho) * 64 + qq * 16 + j]; ci[j] = F.in[I_CIM][(g * 16 + ho) * 64 + qq * 16 + j]; }
        const float dd = F.in[I_DD][g * 16 + ho];
        float hr, hi; int nsteps;
        if (seq < 4) { hr = 0.f; hi = 0.f; nsteps = 4112; }
        else { const int db = seq - 4; hr = F.in[I_SRE][(db * 32 + g) * 64 + lane]; hi = F.in[I_SIM][(db * 32 + g) * 64 + lane]; nsteps = 4; }
        for (int st = 0; st < nsteps; ++st) {
            int row; bool wr_out;
            if (seq < 4) { if (st < 16) { row = MR + st; wr_out = false; } else { row = seq * 4096 + st - 16; wr_out = true; } }
            else { row = MP + (seq - 4) * 4 + st; wr_out = true; }
            const v4u* up = (const v4u*)(P + (size_t)row * DIN + 768 + g * 16);
            const v4u u0 = up[0], u1 = up[1];
            float u[16];
            u[0] = bflo(u0.x); u[1] = bfhi(u0.x); u[2] = bflo(u0.y); u[3] = bfhi(u0.y); u[4] = bflo(u0.z); u[5] = bfhi(u0.z); u[6] = bflo(u0.w); u[7] = bfhi(u0.w);
            u[8] = bflo(u1.x); u[9] = bfhi(u1.x); u[10] = bflo(u1.y); u[11] = bfhi(u1.y); u[12] = bflo(u1.z); u[13] = bfhi(u1.z); u[14] = bflo(u1.w); u[15] = bfhi(u1.w);
            float bur = 0.f, bui = 0.f;
#pragma unroll
            for (int h = 0; h < 16; ++h) { bur += br[h] * u[h]; bui += bi[h] * u[h]; }
            const float nhr = are * hr - aim * hi + bur, nhi = are * hi + aim * hr + bui;
            hr = nhr; hi = nhi;
            if (wr_out) {
                hs[lane] = hr; hs[64 + lane] = hi;
                LDS_WAIT(); asm volatile("" ::: "memory");
                float y = 0.f;
#pragma unroll
                for (int j = 0; j < 16; ++j) y += cr[j] * hs[qq * 16 + j] - ci[j] * hs[64 + qq * 16 + j];
                y += __shfl_xor(y, 16); y += __shfl_xor(y, 32);
                float uo = u[0];
#pragma unroll
                for (int h = 1; h < 16; ++h) uo = (ho == h) ? u[h] : uo;
                y += dd * uo;
                const float z = gelu_tanh(y);
                if (lane < 16) Z[(size_t)row * SW + g * 16 + ho] = (bf16)f2bf(z);
                LDS_WAIT(); asm volatile("" ::: "memory");
            }
        }
        if (seq < 4) { F.out[O_SRP + (seq * 32 + g) * 64 + lane] = hr; F.out[O_SIP + (seq * 32 + g) * 64 + lane] = hi; }
        else { F.out[O_SRS + ((seq - 4) * 32 + g) * 64 + lane] = hr; F.out[O_SIS + ((seq - 4) * 32 + g) * 64 + lane] = hi; }
    }
}
__device__ __forceinline__ float dot64_bf16(const LAS float* qf, const bf16* kp) {
    float s = 0.f;
#pragma unroll 2
    for (int i = 0; i < 8; ++i) { const v4u k = ((const v4u*)kp)[i]; const f32x4 a = ((const LAS f32x4*)qf)[2 * i], b = ((const LAS f32x4*)qf)[2 * i + 1];
        s += a.x * bflo(k.x) + a.y * bfhi(k.x) + a.z * bflo(k.y) + a.w * bfhi(k.y) + b.x * bflo(k.z) + b.y * bfhi(k.z) + b.z * bflo(k.w) + b.w * bfhi(k.w); }
    return s;
}
__device__ __forceinline__ float dot64_f32(const LAS float* qf, const float* kp) {
    float s = 0.f;
#pragma unroll 2
    for (int i = 0; i < 16; ++i) { const f32x4 k = ((const f32x4*)kp)[i]; const f32x4 a = ((const LAS f32x4*)qf)[i];
        s += a.x * k.x + a.y * k.y + a.z * k.z + a.w * k.w; }
    return s;
}
__device__ __forceinline__ void p3_attn_naive(Frame& F) {
    LAS float* pw = (LAS float*)(F.lds + F.wave * 16384 + 1024);
    LAS float* qf = (LAS float*)(F.lds + F.wave * 16384 + 2048);
    const int gw = F.vcu * NWAVES + F.wave, NGW = F.G * NWAVES, lane = F.lane;
    const bf16* P = (const bf16*)(F.ws + WS_P); bf16* ATT = (bf16*)(F.ws + WS_ATT);
    const float NEG = -1e30f;
#pragma unroll 1
    for (int task = gw; task < MR * 8; task += NGW) {
        const int r = task >> 3, h = task & 7, kvh = h >> 2;
        qf[lane] = bf1(P[(size_t)r * DIN + h * 64 + lane]);
        LDS_WAIT(); asm volatile("" ::: "memory");
        const float sink = F.in[I_SINK][h];
        float l0, l1, l2 = NEG; bool v0, v1, v2 = false;
        if (r < MP) {
            const int b = r >> 12, s = r & 4095, pos = s + 16;
            const int kp0 = pos - 127 + lane, kp1 = kp0 + 64;
            v0 = kp0 >= 0; v1 = kp1 >= 0;
            const int kr0 = kp0 >= 16 ? b * 4096 + kp0 - 16 : MR + (kp0 < 0 ? 0 : kp0);
            const int kr1 = kp1 >= 16 ? b * 4096 + kp1 - 16 : MR + (kp1 < 0 ? 0 : kp1);
            l0 = dot64_bf16(qf, P + (size_t)kr0 * DIN + 512 + kvh * 64) * 0.125f;
            l1 = dot64_bf16(qf, P + (size_t)kr1 * DIN + 512 + kvh * 64) * 0.125f;
        } else {
            const int db = (r - MP) >> 2, t = (r - MP) & 3;
            v0 = lane >= t + 1; v1 = true;
            l0 = dot64_f32(qf, F.in[I_CK] + ((size_t)(db * 128 + lane) * 2 + kvh) * 64) * 0.125f;
            l1 = dot64_f32(qf, F.in[I_CK] + ((size_t)(db * 128 + lane + 64) * 2 + kvh) * 64) * 0.125f;
            v2 = lane <= t;
            const int tr = lane < 4 ? lane : 0;
            l2 = dot64_bf16(qf, P + (size_t)(MP + db * 4 + tr) * DIN + 512 + kvh * 64) * 0.125f;
        }
        l0 = v0 ? l0 : NEG; l1 = v1 ? l1 : NEG; l2 = v2 ? l2 : NEG;
        float m = wave_max(fmaxf(fmaxf(l0, l1), l2)); m = fmaxf(m, sink);
        const float e0 = v0 ? __expf(l0 - m) : 0.f, e1 = v1 ? __expf(l1 - m) : 0.f, e2 = v2 ? __expf(l2 - m) : 0.f;
        const float den = wave_sum(e0 + e1 + e2) + __expf(sink - m);
        const float inv = 1.0f / den;
        pw[lane] = e0 * inv; pw[64 + lane] = e1 * inv; pw[128 + lane] = e2 * inv;
        LDS_WAIT(); asm volatile("" ::: "memory");
        float o = 0.f;
        if (r < MP) {
            const int b = r >> 12, s = r & 4095, pos = s + 16;
#pragma unroll 1
            for (int j = 0; j < 128; ++j) { const int kp = pos - 127 + j; if (kp < 0) continue;
                const int kr = kp >= 16 ? b * 4096 + kp - 16 : MR + kp;
                o += pw[j] * bf1(P[(size_t)kr * DIN + 640 + kvh * 64 + lane]); }
        } else {
            const int db = (r - MP) >> 2, t = (r - MP) & 3;
#pragma unroll 1
            for (int j = t + 1; j < 128; ++j) o += pw[j] * F.in[I_CV][((size_t)(db * 128 + j) * 2 + kvh) * 64 + lane];
#pragma unroll 1
            for (int j = 0; j <= t; ++j) o += pw[128 + j] * bf1(P[(size_t)(MP + db * 4 + j) * DIN + 640 + kvh * 64 + lane]);
        }
        ATT[(size_t)r * AW + h * 64 + lane] = (bf16)f2bf(o);
        LDS_WAIT(); asm volatile("" ::: "memory");
    }
}
__device__ __forceinline__ void p3_windows(Frame& F) {
    const int gt = F.vcu * (NWAVES * 64) + F.tid, NT = F.G * NWAVES * 64;
    const bf16* P = (const bf16*)(F.ws + WS_P);
    for (int e = gt; e < 65536; e += NT) { const int b = e >> 14, j = (e >> 7) & 127, c = e & 127; const size_t base = (size_t)(b * 4096 + 3968 + j) * DIN;
        F.out[O_KP + e] = bf1(P[base + 512 + c]); F.out[O_VP + e] = bf1(P[base + 640 + c]); }
    for (int e = gt; e < 2097152; e += NT) { const int db = e >> 14, j = (e >> 7) & 127, c = e & 127;
        float kv, vv;
        if (j < 124) { kv = F.in[I_CK][(size_t)(db * 128 + j + 4) * 128 + c]; vv = F.in[I_CV][(size_t)(db * 128 + j + 4) * 128 + c]; }
        else { const size_t base = (size_t)(MP + db * 4 + j - 124) * DIN; kv = bf1(P[base + 512 + c]); vv = bf1(P[base + 640 + c]); }
        F.out[O_KS + e] = kv; F.out[O_VS + e] = vv; }
}
__device__ __forceinline__ void unpack8(const v4u w, float (&f)[8]) { f[0] = bflo(w.x); f[1] = bfhi(w.x); f[2] = bflo(w.y); f[3] = bfhi(w.y); f[4] = bflo(w.z); f[5] = bfhi(w.z); f[6] = bflo(w.w); f[7] = bfhi(w.w); }
__device__ __forceinline__ v4u pack8(const float (&f)[8]) { v4u w; w.x = pk2(f[0], f[1]); w.y = pk2(f[2], f[3]); w.z = pk2(f[4], f[5]); w.w = pk2(f[6], f[7]); return w; }
__device__ __forceinline__ void p5_mixnorm(Frame& F) {
    const int gw = F.vcu * NWAVES + F.wave, NGW = F.G * NWAVES, lane = F.lane;
    const bf16* ATT = (const bf16*)(F.ws + WS_ATT); const bf16* Z = (const bf16*)(F.ws + WS_Z); const bf16* GL = (const bf16*)(F.ws + WS_GL); bf16* CAT = (bf16*)(F.ws + WS_CAT);
    for (int r = gw; r < MR; r += NGW) {
        float a[8], z[8], gt[8], o[8];
        unpack8(*(const v4u*)(ATT + (size_t)r * AW + lane * 8), a); unpack8(*(const v4u*)(Z + (size_t)r * SW + lane * 8), z); unpack8(*(const v4u*)(GL + (size_t)r * SW + lane * 8), gt);
        float sa = 0.f, so = 0.f;
#pragma unroll
        for (int i = 0; i < 8; ++i) { o[i] = z[i] * sigmoidf_(gt[i]); sa += a[i] * a[i]; so += o[i] * o[i]; }
        const float ra = 1.0f / sqrtf(wave_sum(sa) * (1.f / 512.f) + EPS), ro = 1.0f / sqrtf(wave_sum(so) * (1.f / 512.f) + EPS);
#pragma unroll
        for (int i = 0; i < 8; ++i) { a[i] = a[i] * ra * F.in[I_GATT][lane * 8 + i]; o[i] = o[i] * ro * F.in[I_GSSM][lane * 8 + i]; }
        *(v4u*)(CAT + (size_t)r * D + lane * 8) = pack8(a); *(v4u*)(CAT + (size_t)r * D + 512 + lane * 8) = pack8(o);
    }
}
__device__ __forceinline__ void p7_mid(Frame& F) {
    const int gw = F.vcu * NWAVES + F.wave, NGW = F.G * NWAVES, lane = F.lane;
    const bf16* O1 = (const bf16*)(F.ws + WS_O); bf16* XN2 = (bf16*)(F.ws + WS_XN);
    for (int r = gw; r < MR; r += NGW) {
        float o[16], x[16];
        { float t[8]; unpack8(*(const v4u*)(O1 + (size_t)r * D + lane * 8), t);
#pragma unroll
          for (int i = 0; i < 8; ++i) o[i] = t[i];
          unpack8(*(const v4u*)(O1 + (size_t)r * D + 512 + lane * 8), t);
#pragma unroll
          for (int i = 0; i < 8; ++i) o[8 + i] = t[i]; }
        const float* xr = x_row_ptr(F, r);
#pragma unroll
        for (int hf = 0; hf < 2; ++hf) { const f32x4 a = *(const f32x4*)(xr + hf * 512 + lane * 8), b = *(const f32x4*)(xr + hf * 512 + lane * 8 + 4);
            x[hf * 8 + 0] = a.x; x[hf * 8 + 1] = a.y; x[hf * 8 + 2] = a.z; x[hf * 8 + 3] = a.w; x[hf * 8 + 4] = b.x; x[hf * 8 + 5] = b.y; x[hf * 8 + 6] = b.z; x[hf * 8 + 7] = b.w; }
        float ss = 0.f;
#pragma unroll
        for (int i = 0; i < 16; ++i) ss += o[i] * o[i];
        const float r1 = 1.0f / sqrtf(wave_sum(ss) * (1.f / 1024.f) + EPS);
        float s2 = 0.f;
#pragma unroll
        for (int i = 0; i < 16; ++i) { const int col = (i >> 3) * 512 + lane * 8 + (i & 7); x[i] = x[i] + o[i] * r1 * F.in[I_GPOST][col]; s2 += x[i] * x[i]; }
        const float r2 = 1.0f / sqrtf(wave_sum(s2) * (1.f / 1024.f) + EPS);
        float* yo = F.out + (size_t)r * D;
#pragma unroll
        for (int hf = 0; hf < 2; ++hf) {
            *(f32x4*)(yo + hf * 512 + lane * 8) = (f32x4){x[hf * 8 + 0], x[hf * 8 + 1], x[hf * 8 + 2], x[hf * 8 + 3]};
            *(f32x4*)(yo + hf * 512 + lane * 8 + 4) = (f32x4){x[hf * 8 + 4], x[hf * 8 + 5], x[hf * 8 + 6], x[hf * 8 + 7]};
            float n[8];
#pragma unroll
            for (int i = 0; i < 8; ++i) n[i] = x[hf * 8 + i] * r2 * F.in[I_GMLP][hf * 512 + lane * 8 + i];
            *(v4u*)(XN2 + (size_t)r * D + hf * 512 + lane * 8) = pack8(n);
        }
    }
}
__device__ __forceinline__ void p10_final(Frame& F) {
    const int gw = F.vcu * NWAVES + F.wave, NGW = F.G * NWAVES, lane = F.lane;
    const bf16* O2 = (const bf16*)(F.ws + WS_O);
    for (int r = gw; r < MR; r += NGW) {
        float o[16];
        { float t[8]; unpack8(*(const v4u*)(O2 + (size_t)r * D + lane * 8), t);
#pragma unroll
          for (int i = 0; i < 8; ++i) o[i] = t[i];
          unpack8(*(const v4u*)(O2 + (size_t)r * D + 512 + lane * 8), t);
#pragma unroll
          for (int i = 0; i < 8; ++i) o[8 + i] = t[i]; }
        float ss = 0.f;
#pragma unroll
        for (int i = 0; i < 16; ++i) ss += o[i] * o[i];
        const float r1 = 1.0f / sqrtf(wave_sum(ss) * (1.f / 1024.f) + EPS);
        float* yo = F.out + (size_t)r * D;
#pragma unroll
        for (int hf = 0; hf < 2; ++hf) {
            f32x4 a = *(const f32x4*)(yo + hf * 512 + lane * 8), b = *(const f32x4*)(yo + hf * 512 + lane * 8 + 4);
            const float* g = F.in[I_GMLPP] + hf * 512 + lane * 8;
            a.x += o[hf * 8 + 0] * r1 * g[0]; a.y += o[hf * 8 + 1] * r1 * g[1]; a.z += o[hf * 8 + 2] * r1 * g[2]; a.w += o[hf * 8 + 3] * r1 * g[3];
            b.x += o[hf * 8 + 4] * r1 * g[4]; b.y += o[hf * 8 + 5] * r1 * g[5]; b.z += o[hf * 8 + 6] * r1 * g[6]; b.w += o[hf * 8 + 7] * r1 * g[7];
            *(f32x4*)(yo + hf * 512 + lane * 8) = a; *(f32x4*)(yo + hf * 512 + lane * 8 + 4) = b;
        }
    }
}

#ifndef MK_N_LAUNCHES
#define MK_N_LAUNCHES 0
#endif
constexpr int N_PHASES = 11;
struct Args { const float* in[27]; float* out; unsigned char* ws; int ph_lo, ph_hi; };
__global__ void __launch_bounds__(NWAVES * 64, 2) hymba_fwd(Args args) {
    extern __shared__ __attribute__((aligned(16))) unsigned char lds[];
    Frame F;
    F.lds = (LAS unsigned char*)lds;
    F.MISC = (volatile LAS unsigned*)(F.lds + MISC_OFF);
    F.tid = threadIdx.x; F.lane = F.tid & 63; F.wave = __builtin_amdgcn_readfirstlane(F.tid >> 6);
    F.G = gridDim.x; { const int bx = blockIdx.x; F.vcu = (F.G % 8 == 0) ? (bx % 8) * (F.G / 8) + bx / 8 : bx; }
#pragma unroll
    for (int i = 0; i < 27; ++i) F.in[i] = args.in[i];
    F.out = args.out; F.ws = args.ws; F.ctl = (gu32*)(args.ws + WS_CTL);
    for (int u = F.tid; u < (LDS_BYTES - LDSCTL_OFF) / 4; u += NWAVES * 64) ((LAS unsigned*)(F.lds + LDSCTL_OFF))[u] = 0u;
    __syncthreads();
    const int lo = args.ph_lo, hi = args.ph_hi;
    const bool one = (hi - lo) > 1;
    XcdBarrier bar; bar.bar = (unsigned*)(F.ctl + CW_BAR); bar.x = 0; bar.st = nullptr;
    if (one) bar = xcd_barrier_post((unsigned*)(F.ctl + CW_BAR), F.MISC + 8);
#define IN(k) (lo <= (k) && (k) < hi)
#define SEAM(k) do { if (IN(k) && IN((k) + 1)) xcd_barrier(bar); } while (0)
    bf16* const XN = (bf16*)(F.ws + WS_XN); bf16* const OB = (bf16*)(F.ws + WS_O); bf16* const PB = (bf16*)(F.ws + WS_P);
    if (IN(0)) { p0_prologue(F); } SEAM(0);
    if (IN(1)) { pg8::Gemm g{XN, (const bf16*)(F.ws + WS_WIN), MIN_ROWS, DIN, D}; pg8::StaticOrder S; S.init(MIN_ROWS, DIN, F.G, (int)blockIdx.x);
        pg8::EpiBf16<0> E{PB, DIN}; pg8::gemm_phase<pg8::EpiBf16<0>, pg8::StaticOrder, true, true>(F.lds, g, S, E); } SEAM(1);
    if (IN(2)) { p2_rope(F); } SEAM(2);
    if (IN(3)) { p3_ssm_naive(F); p3_attn_naive(F); p3_windows(F); } SEAM(3);
    if (IN(4)) { pg8::Gemm g{(const bf16*)(F.ws + WS_Z), (const bf16*)(F.ws + WS_WGLU), MR, SW, SW}; pg8::StaticOrder S; S.init(MR, SW, F.G, (int)blockIdx.x);
        pg8::EpiBf16<0> E{(bf16*)(F.ws + WS_GL), SW}; pg8::gemm_phase<pg8::EpiBf16<0>, pg8::StaticOrder, true, true>(F.lds, g, S, E); } SEAM(4);
    if (IN(5)) { p5_mixnorm(F); } SEAM(5);
    if (IN(6)) { pg8::Gemm g{(const bf16*)(F.ws + WS_CAT), (const bf16*)(F.ws + WS_WOUT), MR, D, D}; pg8::StaticOrder S; S.init(MR, D, F.G, (int)blockIdx.x);
        pg8::EpiBf16<0> E{OB, D}; pg8::gemm_phase<pg8::EpiBf16<0>, pg8::StaticOrder, true, true>(F.lds, g, S, E); } SEAM(6);
    if (IN(7)) { p7_mid(F); } SEAM(7);
    if (IN(8)) { pg8::Gemm g{XN, (const bf16*)(F.ws + WS_WUP), MR, DFF, D}; pg8::StaticOrder S; S.init(MR, DFF, F.G, (int)blockIdx.x);
        pg8::EpiBf16<2> E{(bf16*)(F.ws + WS_H), DFF}; pg8::gemm_phase<pg8::EpiBf16<2>, pg8::StaticOrder, true, true>(F.lds, g, S, E); } SEAM(8);
    if (IN(9)) { pg8::Gemm g{(const bf16*)(F.ws + WS_H), (const bf16*)(F.ws + WS_WDN), MR, D, DFF}; pg8::StaticOrder S; S.init(MR, D, F.G, (int)blockIdx.x);
        pg8::EpiBf16<0> E{OB, D}; pg8::gemm_phase<pg8::EpiBf16<0>, pg8::StaticOrder, true, true>(F.lds, g, S, E); } SEAM(9);
    if (IN(10)) { p10_final(F); }
#undef IN
#undef SEAM
}

extern "C" void kernel_launch(void* const* d_in, const int* in_sizes, int n_in, void* d_out, int out_size, void* d_ws, size_t ws_size, hipStream_t stream) {
    static int grid = 0;
    if (grid == 0) {
        if (n_in != 27 || ws_size < WS_END) { fprintf(stderr, "kernel_launch: unexpected n_in %d / ws %zu\n", n_in, ws_size); grid = -1; return; }
        int dev = 0, cus = 0, per_cu = 0;
        if (hipGetDevice(&dev) != hipSuccess || hipDeviceGetAttribute(&cus, hipDeviceAttributeMultiprocessorCount, dev) != hipSuccess) { grid = -1; return; }
        if (hipFuncSetAttribute((const void*)hymba_fwd, hipFuncAttributeMaxDynamicSharedMemorySize, LDS_BYTES) != hipSuccess) { fprintf(stderr, "kernel_launch: hipFuncSetAttribute failed\n"); grid = -1; return; }
        if (hipOccupancyMaxActiveBlocksPerMultiprocessor(&per_cu, (const void*)hymba_fwd, NWAVES * 64, LDS_BYTES) != hipSuccess || per_cu < 1) { fprintf(stderr, "kernel_launch: occupancy query says %d\n", per_cu); per_cu = 1; }
        (void)hipGetLastError();
        grid = cus;
    }
    if (grid < 0) return;
    (void)hipMemsetAsync((char*)d_ws + WS_CTL, 0, CTL_ZERO_BYTES, stream);
    Args a{};
    for (int i = 0; i < 27; ++i) a.in[i] = (const float*)d_in[i];
    a.out = (float*)d_out; a.ws = (unsigned char*)d_ws;
#if MK_N_LAUNCHES == 1
    a.ph_lo = 0; a.ph_hi = N_PHASES;
    void* kargs[] = {&a};
    hipError_t e = hipLaunchCooperativeKernel((const void*)hymba_fwd, dim3(grid), dim3(NWAVES * 64), kargs, LDS_BYTES, stream);
    if (e != hipSuccess) fprintf(stderr, "kernel_launch: cooperative launch failed: %s (grid %d)\n", hipGetErrorString(e), grid);
#else
    for (int p = 0; p < N_PHASES; ++p) { a.ph_lo = p; a.ph_hi = p + 1; hipLaunchKernelGGL(hymba_fwd, dim3(grid), dim3(NWAVES * 64), LDS_BYTES, stream, a); }
#endif
}
```

```cpp
#include <hip/hip_runtime.h>
#include <cstdio>
#include <cstdint>
namespace pg8 {
#define PG8_LAS __attribute__((address_space(3)))
typedef unsigned short bf16_t;
typedef short bf16x8 __attribute__((ext_vector_type(8)));
typedef float f32x4 __attribute__((ext_vector_type(4)));
typedef unsigned u32x4 __attribute__((ext_vector_type(4)));
constexpr int BM = 256, BK = 64, HALF = 128, HTB = HALF * BK * 2  , STAGE_BYTES = 8 * HTB, NXCD = 8, WGM = 8;

__host__ __device__ __forceinline__ int lds_byte(int r, int c) { const int st = (r >> 4) * 2 + (c >> 5), rr = r & 15, cc = c & 31, ob = rr * 64 + cc * 2; return st * 1024 + (ob ^ (((ob >> 9) & 1) << 5)); }
__host__ __device__ __forceinline__ void stage_rc(int b, int& R, int& C) { const int st = b / 1024, sb = b % 1024, swz = sb ^ (((sb >> 9) & 1) << 5); R = (st >> 1) * 16 + swz / 64; C = (st & 1) * 32 + (swz % 64) / 2; }
__host__ __device__ __forceinline__ int perm32(int rho) { const int n = rho >> 4, i = rho & 15; return 8 * (i >> 2) + 4 * n + (i & 3); }

struct Unit { int pm, pn; };
struct Gemm { const bf16_t* A; const bf16_t* Bt; int M, N, K; };

struct StaticOrder {
    int nM, nN, nwg, G, c;
    __host__ __device__ void init(int M, int N, int G_, int c_) { nM = M / BM; nN = N / BM; nwg = nM * nN; G = G_; c = c_; }
    __host__ __device__ bool next(int i, Unit& u) const {
        const long L = (long)i * G + c; if (L >= nwg) return false;
        int wgid = (int)L; { const int q = nwg / NXCD, r = nwg % NXCD, xcd = wgid % NXCD, off = wgid / NXCD; wgid = (xcd < r ? xcd * (q + 1) : r * (q + 1) + (xcd - r) * q) + off; }
        const int nig = WGM * nN, gid = wgid / nig, fm = gid * WGM, gsz = (nM - fm) < WGM ? (nM - fm) : WGM;
        u.pm = fm + ((wgid % nig) % gsz); u.pn = (wgid % nig) / gsz; return true;
    }
    __device__ __forceinline__ void a_ready(const Unit&) const {}
    __device__ __forceinline__ void done(const Unit&) const {}
};
__device__ __forceinline__ unsigned cvt_pk_bf16(float lo, float hi) { unsigned r; asm volatile("v_cvt_pk_bf16_f32 %0, %1, %2" : "=v"(r) : "v"(lo), "v"(hi)); return r; }
template <int ACT> struct EpiBf16 {
    static constexpr bool PERM = true, AFTER_DRAIN = false;
    bf16_t* O; int ldc;
    __device__ __forceinline__ void operator()(const f32x4 (&acc)[2][2][4][2], const Unit& u, int wr, int wc, int fr, int fq) const {
        const int row0 = u.pm * BM + wr * 64 + fr; const int col0 = u.pn * BM + wc * 32 + 8 * fq;
#pragma unroll
        for (int ai = 0; ai < 2; ++ai)
#pragma unroll
            for (int m = 0; m < 4; ++m) { bf16_t* rowp = O + (size_t)(row0 + ai * HALF + m * 16) * ldc + col0;
#pragma unroll
                for (int bj = 0; bj < 2; ++bj) { f32x4 v0 = acc[ai][bj][m][0], v1 = acc[ai][bj][m][1];
                    if (ACT == 2) {
#pragma unroll
                        for (int e = 0; e < 4; ++e) { const float a = fmaxf(v0[e], 0.f), b = fmaxf(v1[e], 0.f); v0[e] = a * a; v1[e] = b * b; } }
                    u32x4 w; w.x = cvt_pk_bf16(v0[0], v0[1]); w.y = cvt_pk_bf16(v0[2], v0[3]); w.z = cvt_pk_bf16(v1[0], v1[1]); w.w = cvt_pk_bf16(v1[2], v1[3]);
                    *(u32x4*)(rowp + bj * HALF) = w; } }
    }
};
template <class Epi, class Sched, bool ALIGN_EPI = false, bool SP2 = false>
__device__ __forceinline__ void gemm_phase(PG8_LAS unsigned char* lds, const Gemm g, const Sched& S, const Epi& E) {
    const int tid = threadIdx.x, wid = __builtin_amdgcn_readfirstlane(tid >> 6), lane = tid & 63, wr = wid >> 2, wc = wid & 3, fr = lane & 15, fq = lane >> 4;
    const int K = g.K, nt = K / BK;
    unsigned voffA[2], voffB[2];
#pragma unroll
    for (int i = 0; i < 2; ++i) { int R, C; stage_rc(tid * 16 + i * 8192, R, C); const int Rb = Epi::PERM ? ((R & ~31) + perm32(R & 31)) : R;
        voffA[i] = (unsigned)(R * K + C) * 2u; voffB[i] = (unsigned)(Rb * K + C) * 2u; }
    const size_t kstep = (size_t)(BK * 2);
    const size_t hstep = (size_t)HALF * K * 2;
    const size_t tstep = 2 * hstep;
    const unsigned ldsw = (unsigned)wid * 1024u;
    const int aoff = lds_byte(wr * 64 + fr, fq * 8), boff = lds_byte(wc * 32 + fr, fq * 8);
#define PG8_SA(b, h) (((b) * 2 + (h)) * HTB)
#define PG8_SB(b, h) ((4 + (b) * 2 + (h)) * HTB)
#define PG8_STAGE(bufoff, gbase, voff) do { _Pragma("unroll") for (int _i = 0; _i < 2; ++_i) \
        __builtin_amdgcn_global_load_lds((const unsigned*)((const char*)(gbase) + (voff)[_i]), (PG8_LAS unsigned*)(lds + (bufoff) + ldsw + _i * 8192), 16, 0, 0); } while (0)
#define PG8_LDA(dst, b, h) do { _Pragma("unroll") for (int m = 0; m < 4; ++m) _Pragma("unroll") for (int k = 0; k < 2; ++k) dst[m][k] = *(const PG8_LAS bf16x8*)(lds + PG8_SA(b, h) + aoff + m * 2048 + k * 1024); } while (0)
#define PG8_LDB(dst, b, h) do { _Pragma("unroll") for (int n = 0; n < 2; ++n) _Pragma("unroll") for (int k = 0; k < 2; ++k) dst[n][k] = *(const PG8_LAS bf16x8*)(lds + PG8_SB(b, h) + boff + n * 2048 + k * 1024); } while (0)
#define PG8_MMA(ai, bj, At, Bt) do { __builtin_amdgcn_s_setprio(1); _Pragma("unroll") for (int m = 0; m < 4; ++m) _Pragma("unroll") for (int n = 0; n < 2; ++n) _Pragma("unroll") for (int k = 0; k < 2; ++k) \
        acc[ai][bj][m][n] = __builtin_amdgcn_mfma_f32_16x16x32_bf16(Bt[n][k], At[m][k], acc[ai][bj][m][n], 0, 0, 0); __builtin_amdgcn_s_setprio(0); } while (0)
#define PG8_WAIT_V(n) asm volatile("s_waitcnt vmcnt(" #n ")" ::: "memory")
#define PG8_WAIT_L(n) asm volatile("s_waitcnt lgkmcnt(" #n ")" ::: "memory")
#define PG8_BAR __builtin_amdgcn_s_barrier()
#define PG8_SCHED __builtin_amdgcn_sched_barrier(0)
    Unit cur, nxt; int ui = 0;
    if (!S.next(0, cur)) return;
    f32x4 acc[2][2][4][2];
#pragma unroll
    for (int a = 0; a < 2; ++a)
#pragma unroll
        for (int b = 0; b < 2; ++b)
#pragma unroll
            for (int m = 0; m < 4; ++m)
#pragma unroll
                for (int n = 0; n < 2; ++n) acc[a][b][m][n] = (f32x4){0.f, 0.f, 0.f, 0.f};
    bf16x8 At[4][2], B0[2][2], B1[2][2];
    const char* cA = (const char*)g.A + (size_t)cur.pm * tstep; const char* cB = (const char*)g.Bt + (size_t)cur.pn * tstep;
    S.a_ready(cur);
    if constexpr (SP2) {
        PG8_STAGE(PG8_SB(0, 0), cB, voffB); PG8_STAGE(PG8_SB(0, 1), cB + hstep, voffB); PG8_STAGE(PG8_SA(0, 0), cA, voffA); PG8_STAGE(PG8_SA(0, 1), cA + hstep, voffA);
        if (wr == 1) PG8_BAR;
        PG8_WAIT_V(2); PG8_BAR;
        PG8_STAGE(PG8_SB(1, 0), cB + kstep, voffB); PG8_STAGE(PG8_SA(1, 0), cA + kstep, voffA); PG8_STAGE(PG8_SB(1, 1), cB + hstep + kstep, voffB);
        PG8_WAIT_V(6); PG8_BAR;
    } else {
        PG8_STAGE(PG8_SB(0, 0), cB, voffB); PG8_STAGE(PG8_SA(0, 0), cA, voffA); PG8_STAGE(PG8_SB(0, 1), cB + hstep, voffB); PG8_STAGE(PG8_SA(0, 1), cA + hstep, voffA);
        if (wr == 1) PG8_BAR;
        PG8_WAIT_V(4); PG8_BAR;
        PG8_STAGE(PG8_SB(1, 0), cB + kstep, voffB); PG8_STAGE(PG8_SA(1, 0), cA + kstep, voffA); PG8_STAGE(PG8_SB(1, 1), cB + hstep + kstep, voffB);
        PG8_WAIT_V(6); PG8_BAR;
    }
    for (;;) {
        const bool has_next = S.next(ui + 1, nxt);
        const char* nA = has_next ? (const char*)g.A + (size_t)nxt.pm * tstep : cA; const char* nB = has_next ? (const char*)g.Bt + (size_t)nxt.pn * tstep : cB;
        for (int t = 0; t < nt; t += 2) {
            const bool last = (t == nt - 2);
            const char* a1 = cA + (size_t)(t + 1) * kstep;
            const char* a2 = last ? nA : cA + (size_t)(t + 2) * kstep; const char* b2 = last ? nB : cB + (size_t)(t + 2) * kstep;
            const char* a3 = a2 + kstep; const char* b3 = b2 + kstep;
            if (last && has_next) S.a_ready(nxt);
            if constexpr (SP2) {
            PG8_LDB(B0, 0, 0); PG8_LDB(B1, 0, 1); PG8_SCHED; PG8_LDA(At, 0, 0); PG8_STAGE(PG8_SA(1, 1), a1 + hstep, voffA);
            PG8_WAIT_V(8); PG8_WAIT_L(0); PG8_BAR; PG8_MMA(0, 0, At, B0); PG8_MMA(0, 1, At, B1); PG8_BAR; PG8_SCHED;
            PG8_LDA(At, 0, 1); PG8_STAGE(PG8_SB(0, 0), b2, voffB); PG8_STAGE(PG8_SB(0, 1), b2 + hstep, voffB); PG8_STAGE(PG8_SA(0, 0), a2, voffA);
            PG8_WAIT_V(8); PG8_WAIT_L(0); PG8_BAR; PG8_MMA(1, 0, At, B0); PG8_MMA(1, 1, At, B1); PG8_BAR; PG8_SCHED;
            PG8_LDB(B0, 1, 0); PG8_LDB(B1, 1, 1); PG8_SCHED; PG8_LDA(At, 1, 0); PG8_STAGE(PG8_SA(0, 1), a2 + hstep, voffA);
            PG8_WAIT_V(8); PG8_WAIT_L(0); PG8_BAR; PG8_MMA(0, 0, At, B0); PG8_MMA(0, 1, At, B1); PG8_BAR; PG8_SCHED;
            PG8_LDA(At, 1, 1); PG8_STAGE(PG8_SB(1, 0), b3, voffB); PG8_STAGE(PG8_SB(1, 1), b3 + hstep, voffB); PG8_STAGE(PG8_SA(1, 0), a3, voffA);
            PG8_WAIT_V(8); PG8_WAIT_L(0); PG8_BAR; PG8_MMA(1, 0, At, B0); PG8_MMA(1, 1, At, B1); PG8_BAR; PG8_SCHED;
            } else {
            PG8_LDB(B0, 0, 0); PG8_SCHED; PG8_LDA(At, 0, 0); PG8_STAGE(PG8_SA(1, 1), a1 + hstep, voffA);
            PG8_WAIT_L(8); PG8_BAR; PG8_WAIT_L(0); PG8_MMA(0, 0, At, B0); PG8_BAR; PG8_SCHED;
            PG8_LDB(B1, 0, 1); PG8_STAGE(PG8_SB(0, 0), b2, voffB);
            PG8_BAR; PG8_WAIT_L(0); PG8_MMA(0, 1, At, B1); PG8_BAR;
            PG8_LDA(At, 0, 1); PG8_STAGE(PG8_SA(0, 0), a2, voffA);
            PG8_BAR; PG8_WAIT_L(0); PG8_MMA(1, 0, At, B0); PG8_BAR; PG8_SCHED;
            PG8_STAGE(PG8_SB(0, 1), b2 + hstep, voffB);
            PG8_WAIT_V(6); PG8_BAR; PG8_MMA(1, 1, At, B1); PG8_BAR;
            PG8_LDB(B0, 1, 0); PG8_SCHED; PG8_LDA(At, 1, 0); PG8_STAGE(PG8_SA(0, 1), a2 + hstep, voffA);
            PG8_WAIT_L(8); PG8_BAR; PG8_WAIT_L(0); PG8_MMA(0, 0, At, B0); PG8_BAR; PG8_SCHED;
            PG8_LDB(B1, 1, 1); PG8_STAGE(PG8_SB(1, 0), b3, voffB);
            PG8_BAR; PG8_WAIT_L(0); PG8_MMA(0, 1, At, B1); PG8_BAR;
            PG8_LDA(At, 1, 1); PG8_STAGE(PG8_SA(1, 0), a3, voffA);
            PG8_BAR; PG8_WAIT_L(0); PG8_MMA(1, 0, At, B0); PG8_BAR; PG8_SCHED;
            PG8_STAGE(PG8_SB(1, 1), b3 + hstep, voffB);
            PG8_WAIT_V(6); PG8_BAR; PG8_MMA(1, 1, At, B1); PG8_BAR;
            }
        }
        if constexpr (ALIGN_EPI) { if (wr == 0) PG8_BAR; }
        if constexpr (!Epi::AFTER_DRAIN) { E(acc, cur, wr, wc, fr, fq); S.done(cur); }
        if (!has_next) break;
#pragma unroll
        for (int a = 0; a < 2; ++a)
#pragma unroll
            for (int b = 0; b < 2; ++b)
#pragma unroll
                for (int m = 0; m < 4; ++m)
#pragma unroll
                    for (int n = 0; n < 2; ++n) acc[a][b][m][n] = (f32x4){0.f, 0.f, 0.f, 0.f};
        cur = nxt; cA = nA; cB = nB; ++ui;
        if constexpr (ALIGN_EPI) { if (wr == 1) PG8_BAR; }
    }
    PG8_WAIT_V(0);
    if constexpr (!ALIGN_EPI) { if (wr == 0) PG8_BAR; }
    PG8_BAR;
    if constexpr (Epi::AFTER_DRAIN) { E.fused(acc, cur, wr, wc, fr, fq, lds, wid, lane); S.done(cur); }
#undef PG8_SA
#undef PG8_SB
#undef PG8_STAGE
#undef PG8_LDA
#undef PG8_LDB
#undef PG8_MMA
#undef PG8_WAIT_V
#undef PG8_WAIT_L
#undef PG8_BAR
#undef PG8_SCHED
}
}

constexpr int NWAVES = 8;
constexpr int D = 1024, DIN = 1280, DFF = 4096, AW = 512, SW = 512;
constexpr int MP = 16384, MS = 512, MR = MP + MS;
constexpr int MMETA = MR, NMETA = 16, MIN_ROWS = 17152;
constexpr int NPOS = 4112 + 4;
constexpr float EPS = 1e-6f;
constexpr size_t O_YP = 0, O_YS = 16777216, O_KP = 17301504, O_VP = 17367040, O_SRP = 17432576, O_SIP = 17440768, O_KS = 17448960, O_VS = 19546112, O_SRS = 21643264, O_SIS = 21905408;
constexpr size_t MiB = 1u << 20;
constexpr size_t WS_CTL = 0, CTL_ZERO_BYTES = 1 * MiB;
constexpr size_t WS_ROPEC = 1 * MiB, WS_ROPES = WS_ROPEC + 160 * 1024, WS_ABR = WS_ROPES + 160 * 1024, WS_ABI = WS_ABR + 8192, WS_BBR = WS_ABI + 8192, WS_BBI = WS_BBR + 131072;
static_assert(WS_BBI + 131072 <= 2 * MiB && NPOS * 8 * 4 <= 160 * 1024, "tables");
constexpr size_t WS_WIN = 2 * MiB, WS_WGLU = 5 * MiB, WS_WOUT = 6 * MiB, WS_WUP = 8 * MiB, WS_WDN = 16 * MiB;
constexpr size_t WS_XN = 24 * MiB, WS_O = 58 * MiB, WS_P = 92 * MiB, WS_ATT = 134 * MiB, WS_Z = 151 * MiB, WS_GL = 168 * MiB, WS_CAT = 185 * MiB, WS_H = 92 * MiB, WS_END = 224 * MiB;
static_assert(WS_XN + (size_t)MIN_ROWS * D * 2 <= WS_O && WS_O + (size_t)MR * D * 2 <= WS_P && WS_P + (size_t)MIN_ROWS * DIN * 2 <= WS_ATT && WS_ATT + (size_t)MR * AW * 2 <= WS_Z && WS_Z + (size_t)MR * SW * 2 <= WS_GL &&
              WS_GL + (size_t)MR * SW * 2 <= WS_CAT && WS_CAT + (size_t)MR * D * 2 <= WS_END && WS_H + (size_t)MR * DFF * 2 <= WS_END, "d_ws map");
constexpr int CW_BAR = 4096;
constexpr int RING_BYTES = 131072, LDSCTL_OFF = RING_BYTES, MISC_OFF = LDSCTL_OFF + 320, LDS_BYTES = 147456;

#define GAS __attribute__((address_space(1)))
#define LAS __attribute__((address_space(3)))
typedef unsigned short bf16;
typedef unsigned v4u __attribute__((ext_vector_type(4)));
typedef unsigned v2u __attribute__((ext_vector_type(2)));
typedef float f32x4 __attribute__((ext_vector_type(4)));
typedef GAS unsigned gu32;
#define RLX_AGENT __ATOMIC_RELAXED, __HIP_MEMORY_SCOPE_AGENT
#define LDS_WAIT() asm volatile("s_waitcnt lgkmcnt(0)" ::: "memory")
#define VM_WAIT() asm volatile("s_waitcnt vmcnt(0)" ::: "memory")
__device__ __forceinline__ unsigned f2bf(float f) { unsigned u = __builtin_bit_cast(unsigned, f); return (u + 0x7fffu + ((u >> 16) & 1u)) >> 16; }
__device__ __forceinline__ unsigned pk2(float lo, float hi) { return f2bf(lo) | (f2bf(hi) << 16); }
__device__ __forceinline__ float bflo(unsigned w) { return __uint_as_float(w << 16); }
__device__ __forceinline__ float bfhi(unsigned w) { return __uint_as_float(w & 0xffff0000u); }
__device__ __forceinline__ float bf1(bf16 b) { return __uint_as_float((unsigned)b << 16); }

#define XB_TMO      128
#define XB_XCNT(j)  (256  + 64 * (j))
#define XB_XSUB(j)  (1280 + 64 * (j))
#define XB_XGEN(j)  (2304 + 64 * (j))
#define XB_TOP      3328
#define XB_TOPGEN   3392
#define XCD_BAR_WORDS 3456
#define XB_SPIN_CAP (1u << 18)
__device__ __forceinline__ unsigned xb_ld(unsigned* p)              { return __hip_atomic_load(p, __ATOMIC_RELAXED, __HIP_MEMORY_SCOPE_AGENT); }
__device__ __forceinline__ unsigned xb_add(unsigned* p, unsigned v) { return __hip_atomic_fetch_add(p, v, __ATOMIC_RELAXED, __HIP_MEMORY_SCOPE_AGENT); }
__device__ __forceinline__ unsigned xb_xcc_id() { return (unsigned)__builtin_amdgcn_s_getreg((3 << 11) | 20) & 0xFu; }
#define XB_SPIN(cond, bar) do { unsigned _sp = 0; while (cond) { __builtin_amdgcn_s_sleep(1); \
    if ((++_sp & 255u) == 0u) { if (xb_ld(&(bar)[XB_TMO])) break; if (_sp > XB_SPIN_CAP) { atomicAdd(&(bar)[XB_TMO], 1u); break; } } } } while (0)
struct XcdBarrier { unsigned* bar; unsigned x; volatile LAS unsigned* st; };
__device__ __forceinline__ XcdBarrier xcd_barrier_post(unsigned* bar, volatile LAS unsigned* st) {
    XcdBarrier b; b.bar = bar; b.x = xb_xcc_id(); b.st = st;
    if (threadIdx.x == 0) (void)xb_add(&bar[XB_XCNT(b.x)], 1u);
    return b;
}
__device__ __forceinline__ void xcd_barrier_complete(unsigned* bar, unsigned x, unsigned& nloc, unsigned& nx) {
    const unsigned G = gridDim.x * gridDim.y * gridDim.z;
    unsigned sum, cnt, mine, sp = 0u;
    for (;;) {
        sum = 0u; cnt = 0u; mine = 0u;
#pragma unroll
        for (unsigned j = 0; j < 16; ++j) { const unsigned c = xb_ld(&bar[XB_XCNT(j)]); sum += c; cnt += (c > 0u) ? 1u : 0u; mine = (j == x) ? c : mine; }
        if (sum == G) break;
        __builtin_amdgcn_s_sleep(1);
        if ((++sp & 255u) == 0u) { if (xb_ld(&bar[XB_TMO])) break; if (sp > XB_SPIN_CAP) { atomicAdd(&bar[XB_TMO], 1u); break; } }
    }
    nloc = mine > 0u ? mine : 1u; nx = cnt > 0u ? cnt : 1u;
}
__device__ __forceinline__ void xcd_barrier(const XcdBarrier& b) {
    asm volatile("s_waitcnt vmcnt(0)" ::: "memory");
    __syncthreads();
    if (threadIdx.x == 0) {
        unsigned* bar = b.bar;
        __builtin_amdgcn_s_waitcnt(0);
        unsigned nloc = b.st[0], nx = b.st[1];
        if (nloc == 0u) { xcd_barrier_complete(bar, b.x, nloc, nx); b.st[0] = nloc; b.st[1] = nx; }
        const unsigned old = xb_add(&bar[XB_XSUB(b.x)], 1u);
        const unsigned gen = old / nloc;
        if (old + 1u == (gen + 1u) * nloc) {
            __builtin_amdgcn_fence(__ATOMIC_RELEASE, "agent");
            asm volatile("s_waitcnt vmcnt(0)" ::: "memory");
            const unsigned og = xb_add(&bar[XB_TOP], 1u);
            const unsigned tg = og / nx;
            if (og + 1u == (tg + 1u) * nx) xb_add(&bar[XB_TOPGEN], 1u);
            else XB_SPIN(xb_ld(&bar[XB_TOPGEN]) == tg, bar);
            __builtin_amdgcn_fence(__ATOMIC_ACQUIRE, "agent");
            xb_add(&bar[XB_XGEN(b.x)], 1u);
            asm volatile("s_waitcnt vmcnt(0)" ::: "memory");
        } else {
            XB_SPIN(xb_ld(&bar[XB_XGEN(b.x)]) == gen, bar);
            __builtin_amdgcn_fence(__ATOMIC_ACQUIRE, "agent");
            asm volatile("s_waitcnt vmcnt(0)" ::: "memory");
        }
    }
    __syncthreads();
}

struct Frame {
    LAS unsigned char* lds;
    volatile LAS unsigned* MISC;
    gu32* ctl;
    int tid, lane, wave;
    int vcu, G;
    const float* in[27]; float* out; unsigned char* ws;
};
enum { I_XP = 0, I_XS, I_CK, I_CV, I_SRE, I_SIM, I_META, I_GPRE, I_WIN, I_SINK, I_ARE, I_AIM, I_LDT, I_BRE, I_BIM, I_CRE, I_CIM, I_DD, I_WGLU, I_GATT, I_GSSM, I_WOUT, I_GPOST, I_GMLP, I_WUP, I_WDN, I_GMLPP };

__device__ __forceinline__ float wave_sum(float v) {
#pragma unroll
    for (int o = 1; o < 64; o <<= 1) v += __shfl_xor(v, o);
    return v;
}
__device__ __forceinline__ float wave_max(float v) {
#pragma unroll
    for (int o = 1; o < 64; o <<= 1) v = fmaxf(v, __shfl_xor(v, o));
    return v;
}
__device__ __forceinline__ void sincos_d(double a, double& s, double& c) {
    const double k = __builtin_rint(a * 0.63661977236758134308);
    double r = __builtin_fma(-k, 1.57079632679489655800e+00, a);
    r = __builtin_fma(-k, 6.12323399573676603587e-17, r);
    const double r2 = r * r;
    double sp = 1.0 / 6227020800.0; sp = sp * r2 - 1.0 / 39916800.0; sp = sp * r2 + 1.0 / 362880.0; sp = sp * r2 - 1.0 / 5040.0; sp = sp * r2 + 1.0 / 120.0; sp = sp * r2 - 1.0 / 6.0; sp = sp * r2 + 1.0; sp = sp * r;
    double cp = -1.0 / 87178291200.0; cp = cp * r2 + 1.0 / 479001600.0; cp = cp * r2 - 1.0 / 3628800.0; cp = cp * r2 + 1.0 / 40320.0; cp = cp * r2 - 1.0 / 720.0; cp = cp * r2 + 1.0 / 24.0; cp = cp * r2 - 0.5; cp = cp * r2 + 1.0;
    const int q = ((int)k) & 3;
    s = (q == 0) ? sp : (q == 1) ? cp : (q == 2) ? -sp : -cp;
    c = (q == 0) ? cp : (q == 1) ? -sp : (q == 2) ? -cp : sp;
}
__device__ __forceinline__ double exp_d(double x) {
    const double k = __builtin_rint(x * 1.44269504088896340736);
    double r = __builtin_fma(-k, 6.93147180369123816490e-01, x); r = __builtin_fma(-k, 1.90821492927058770002e-10, r);
    double p = 1.0 / 6227020800.0; p = p * r + 1.0 / 479001600.0; p = p * r + 1.0 / 39916800.0; p = p * r + 1.0 / 3628800.0; p = p * r + 1.0 / 362880.0; p = p * r + 1.0 / 40320.0; p = p * r + 1.0 / 5040.0;
    p = p * r + 1.0 / 720.0; p = p * r + 1.0 / 120.0; p = p * r + 1.0 / 24.0; p = p * r + 1.0 / 6.0; p = p * r + 0.5; p = p * r + 1.0; p = p * r + 1.0;
    const long long bits = ((long long)(1023 + (int)k)) << 52;
    return p * __builtin_bit_cast(double, bits);
}
__device__ __forceinline__ float gelu_tanh(float x) {
    const float a = 0.7978845608028654f * (x + 0.044715f * x * x * x);
    const float e = __expf(2.0f * a);
    const float t = 1.0f - 2.0f / (e + 1.0f);
    return 0.5f * x * (1.0f + t);
}
__device__ __forceinline__ float sigmoidf_(float x) { return 1.0f / (1.0f + __expf(-x)); }

__device__ __forceinline__ void p0_transpose_item(const float* W, int K, int N, bf16* WT, LAS float* scr, int item, int lane) {
    const int nblk = N / 32, kb = item / nblk, nb = item % nblk, k0 = 64 * kb, n0 = 32 * nb;
#pragma unroll 8
    for (int i = 0; i < 32; ++i) { const int kk = 2 * i + (lane >> 5); scr[kk * 33 + (lane & 31)] = W[(size_t)(k0 + kk) * N + n0 + (lane & 31)]; }
    LDS_WAIT(); asm volatile("" ::: "memory");
    const int c = lane & 7;
#pragma unroll
    for (int j = 0; j < 4; ++j) { const int n = (lane >> 3) + 8 * j; const LAS float* s = scr + (8 * c) * 33 + n;
        v4u o; o.x = pk2(s[0 * 33], s[1 * 33]); o.y = pk2(s[2 * 33], s[3 * 33]); o.z = pk2(s[4 * 33], s[5 * 33]); o.w = pk2(s[6 * 33], s[7 * 33]);
        *(GAS v4u*)(WT + (size_t)(n0 + n) * K + k0 + 8 * c) = o; }
    LDS_WAIT(); asm volatile("" ::: "memory");
}
__device__ __forceinline__ void rms_row_to_bf16(const float* xrow, const float* g, bf16* orow, int lane) {
    const GAS f32x4* xr = (const GAS f32x4*)xrow + lane;
    f32x4 v[4]; float s = 0.f;
#pragma unroll
    for (int j = 0; j < 4; ++j) { v[j] = xr[64 * j]; s += (v[j].x * v[j].x + v[j].y * v[j].y) + (v[j].z * v[j].z + v[j].w * v[j].w); }
    const float rs = 1.0f / sqrtf(wave_sum(s) * (1.f / 1024.f) + EPS);
    GAS unsigned long long* o8 = (GAS unsigned long long*)orow + lane;
#pragma unroll
    for (int j = 0; j < 4; ++j) { const f32x4 gg = ((const GAS f32x4*)g)[lane + 64 * j];
        o8[64 * j] = (unsigned long long)pk2(v[j].x * rs * gg.x, v[j].y * rs * gg.y) | ((unsigned long long)pk2(v[j].z * rs * gg.z, v[j].w * rs * gg.w) << 32); }
}
__device__ __forceinline__ const float* x_row_ptr(const Frame& F, int r) {
    return r < MP ? F.in[I_XP] + (size_t)r * D : (r < MR ? F.in[I_XS] + (size_t)(r - MP) * D : F.in[I_META] + (size_t)(r - MR) * D);
}
__device__ __forceinline__ void p0_prologue(Frame& F) {
    LAS float* scr = (LAS float*)(F.lds + F.wave * 16384);
    const int gw = F.vcu * NWAVES + F.wave, NGW = F.G * NWAVES;
    constexpr int I_IN = (D / 64) * (DIN / 32), I_GL = (SW / 64) * (SW / 32), I_OU = (D / 64) * (D / 32), I_UP = (D / 64) * (DFF / 32), I_DN = (DFF / 64) * (D / 32);
    constexpr int NITEMS = I_IN + I_GL + I_OU + I_UP + I_DN;
    for (int it = gw; it < NITEMS; it += NGW) {
        int r = it;
        if (r < I_IN) { p0_transpose_item(F.in[I_WIN], D, DIN, (bf16*)(F.ws + WS_WIN), scr, r, F.lane); continue; } r -= I_IN;
        if (r < I_GL) { p0_transpose_item(F.in[I_WGLU], SW, SW, (bf16*)(F.ws + WS_WGLU), scr, r, F.lane); continue; } r -= I_GL;
        if (r < I_OU) { p0_transpose_item(F.in[I_WOUT], D, D, (bf16*)(F.ws + WS_WOUT), scr, r, F.lane); continue; } r -= I_OU;
        if (r < I_UP) { p0_transpose_item(F.in[I_WUP], D, DFF, (bf16*)(F.ws + WS_WUP), scr, r, F.lane); continue; } r -= I_UP;
        p0_transpose_item(F.in[I_WDN], DFF, D, (bf16*)(F.ws + WS_WDN), scr, r, F.lane);
    }
    bf16* XN = (bf16*)(F.ws + WS_XN);
    for (int m = gw; m < MIN_ROWS; m += NGW) {
        if (m < MR + NMETA) rms_row_to_bf16(x_row_ptr(F, m), F.in[I_GPRE], XN + (size_t)m * D, F.lane);
        else { GAS unsigned long long* o8 = (GAS unsigned long long*)(XN + (size_t)m * D) + F.lane;
#pragma unroll
            for (int j = 0; j < 4; ++j) o8[64 * j] = 0ull; }
    }
    const int gt = F.vcu * (NWAVES * 64) + F.tid, NT = F.G * NWAVES * 64;
    float* ropeC = (float*)(F.ws + WS_ROPEC); float* ropeS = (float*)(F.ws + WS_ROPES);
    for (int i = gt; i < NPOS * 8; i += NT) {
        const int idx = i >> 3, fi = i & 7; const int pos = idx < 4112 ? idx : 8192 + (idx - 4112);
        const float inv = (float)exp_d(-(double)fi * 1.640295422175541);
        const float ang = (float)pos * inv;
        double s, c; sincos_d((double)ang, s, c);
        ropeC[i] = (float)c; ropeS[i] = (float)s;
    }
    float* abr = (float*)(F.ws + WS_ABR); float* abi = (float*)(F.ws + WS_ABI); float* bbr = (float*)(F.ws + WS_BBR); float* bbi = (float*)(F.ws + WS_BBI);
    for (int i = gt; i < 2048; i += NT) {
        const int g = i >> 6;
        const double dt = exp_d((double)F.in[I_LDT][g]); const double ar = (double)F.in[I_ARE][i], ai = (double)F.in[I_AIM][i];
        const double mag = exp_d(ar * dt); double s, c; sincos_d(ai * dt, s, c);
        const double are = mag * c, aim = mag * s;
        const double nr = are - 1.0, ni = aim, den = ar * ar + ai * ai;
        const double cr = (nr * ar + ni * ai) / den, ci = (ni * ar - nr * ai) / den;
        abr[i] = (float)are; abi[i] = (float)aim;
        for (int h = 0; h < 16; ++h) { const double br = (double)F.in[I_BRE][i * 16 + h], bi = (double)F.in[I_BIM][i * 16 + h];
            bbr[i * 16 + h] = (float)(cr * br - ci * bi); bbi[i * 16 + h] = (float)(cr * bi + ci * br); }
    }
}
__device__ __forceinline__ int pos_index(int r) { return r < MP ? (r & 4095) + 16 : (r < MR ? 4112 + ((r - MP) & 3) : r - MR); }
__device__ __forceinline__ void p2_rope(Frame& F) {
    const int gt = F.vcu * (NWAVES * 64) + F.tid, NT = F.G * NWAVES * 64;
    bf16* P = (bf16*)(F.ws + WS_P); const float* ropeC = (const float*)(F.ws + WS_ROPEC); const float* ropeS = (const float*)(F.ws + WS_ROPES);
    for (int it = gt; it < (MR + NMETA) * 80; it += NT) {
        const int r = it / 80, rem = it - r * 80, hh = rem >> 3, fi = rem & 7;
        bf16* p = P + (size_t)r * DIN + hh * 64 + fi;
        const float x1 = bf1(p[0]), x2 = bf1(p[8]);
        const int pi = pos_index(r) * 8 + fi; const float c = ropeC[pi], s = ropeS[pi];
        p[0] = (bf16)f2bf(x1 * c - x2 * s); p[8] = (bf16)f2bf(x2 * c + x1 * s);
    }
}
__device__ __forceinline__ void p3_ssm_naive(Frame& F) {
    LAS float* hs = (LAS float*)(F.lds + F.wave * 16384);
    const int gw = F.vcu * NWAVES + F.wave, NGW = F.G * NWAVES, lane = F.lane;
    const bf16* P = (const bf16*)(F.ws + WS_P); bf16* Z = (bf16*)(F.ws + WS_Z);
    const float* abr = (const float*)(F.ws + WS_ABR); const float* abi = (const float*)(F.ws + WS_ABI); const float* bbr = (const float*)(F.ws + WS_BBR); const float* bbi = (const float*)(F.ws + WS_BBI);
    for (int task = gw; task < (4 + 128) * 32; task += NGW) {
        const int seq = task >> 5, g = task & 31, gp = g * 64 + lane;
        const float are = abr[gp], aim = abi[gp];
        float br[16], bi[16];
#pragma unroll
        for (int h = 0; h < 16; ++h) { br[h] = bbr[gp * 16 + h]; bi[h] = bbi[gp * 16 + h]; }
        const int ho = lane & 15, qq = lane >> 4;
        float cr[16], ci[16];
#pragma unroll
        for (int j = 0; j < 16; ++j) { cr[j] = F.in[I_CRE][(g * 16 + ho) * 64 + qq * 16 + j]; ci[j] = F.in[I_CIM][(g * 16 + ho) * 64 + qq * 16 + j]; }
        const float dd = F.in[I_DD][g * 16 + ho];
        float hr, hi; int nsteps;
        if (seq < 4) { hr = 0.f; hi = 0.f; nsteps = 4112; }
        else { const int db = seq - 4; hr = F.in[I_SRE][(db * 32 + g) * 64 + lane]; hi = F.in[I_SIM][(db * 32 + g) * 64 + lane]; nsteps = 4; }
        for (int st = 0; st < nsteps; ++st) {
            int row; bool wr_out;
            if (seq < 4) { if (st < 16) { row = MR + st; wr_out = false; } else { row = seq * 4096 + st - 16; wr_out = true; } }
            else { row = MP + (seq - 4) * 4 + st; wr_out = true; }
            const v4u* up = (const v4u*)(P + (size_t)row * DIN + 768 + g * 16);
            const v4u u0 = up[0], u1 = up[1];
            float u[16];
            u[0] = bflo(u0.x); u[1] = bfhi(u0.x); u[2] = bflo(u0.y); u[3] = bfhi(u0.y); u[4] = bflo(u0.z); u[5] = bfhi(u0.z); u[6] = bflo(u0.w); u[7] = bfhi(u0.w);
            u[8] = bflo(u1.x); u[9] = bfhi(u1.x); u[10] = bflo(u1.y); u[11] = bfhi(u1.y); u[12] = bflo(u1.z); u[13] = bfhi(u1.z); u[14] = bflo(u1.w); u[15] = bfhi(u1.w);
            float bur = 0.f, bui = 0.f;
#pragma unroll
            for (int h = 0; h < 16; ++h) { bur += br[h] * u[h]; bui += bi[h] * u[h]; }
            const float nhr = are * hr - aim * hi + bur, nhi = are * hi + aim * hr + bui;
            hr = nhr; hi = nhi;
            if (wr_out) {
                hs[lane] = hr; hs[64 + lane] = hi;
                LDS_WAIT(); asm volatile("" ::: "memory");
                float y = 0.f;
#pragma unroll
                for (int j = 0; j < 16; ++j) y += cr[j] * hs[qq * 16 + j] - ci[j] * hs[64 + qq * 16 + j];
                y += __shfl_xor(y, 16); y += __shfl_xor(y, 32);
                float uo = u[0];
#pragma unroll
                for (int h = 1; h < 16; ++h) uo = (ho == h) ? u[h] : uo;
                y += dd * uo;
                const float z = gelu_tanh(y);
                if (lane < 16) Z[(size_t)row * SW + g * 16 + ho] = (bf16)f2bf(z);
                LDS_WAIT(); asm volatile("" ::: "memory");
            }
        }
        if (seq < 4) { F.out[O_SRP + (seq * 32 + g) * 64 + lane] = hr; F.out[O_SIP + (seq * 32 + g) * 64 + lane] = hi; }
        else { F.out[O_SRS + ((seq - 4) * 32 + g) * 64 + lane] = hr; F.out[O_SIS + ((seq - 4) * 32 + g) * 64 + lane] = hi; }
    }
}
__device__ __forceinline__ float dot64_bf16(const LAS float* qf, const bf16* kp) {
    float s = 0.f;
#pragma unroll 2
    for (int i = 0; i < 8; ++i) { const v4u k = ((const v4u*)kp)[i]; const f32x4 a = ((const LAS f32x4*)qf)[2 * i], b = ((const LAS f32x4*)qf)[2 * i + 1];
        s += a.x * bflo(k.x) + a.y * bfhi(k.x) + a.z * bflo(k.y) + a.w * bfhi(k.y) + b.x * bflo(k.z) + b.y * bfhi(k.z) + b.z * bflo(k.w) + b.w * bfhi(k.w); }
    return s;
}
__device__ __forceinline__ float dot64_f32(const LAS float* qf, const float* kp) {
    float s = 0.f;
#pragma unroll 2
    for (int i = 0; i < 16; ++i) { const f32x4 k = ((const f32x4*)kp)[i]; const f32x4 a = ((const LAS f32x4*)qf)[i];
        s += a.x * k.x + a.y * k.y + a.z * k.z + a.w * k.w; }
    return s;
}
__device__ __forceinline__ void p3_attn_naive(Frame& F) {
    LAS float* pw = (LAS float*)(F.lds + F.wave * 16384 + 1024);
    LAS float* qf = (LAS float*)(F.lds + F.wave * 16384 + 2048);
    const int gw = F.vcu * NWAVES + F.wave, NGW = F.G * NWAVES, lane = F.lane;
    const bf16* P = (const bf16*)(F.ws + WS_P); bf16* ATT = (bf16*)(F.ws + WS_ATT);
    const float NEG = -1e30f;
#pragma unroll 1
    for (int task = gw; task < MR * 8; task += NGW) {
        const int r = task >> 3, h = task & 7, kvh = h >> 2;
        qf[lane] = bf1(P[(size_t)r * DIN + h * 64 + lane]);
        LDS_WAIT(); asm volatile("" ::: "memory");
        const float sink = F.in[I_SINK][h];
        float l0, l1, l2 = NEG; bool v0, v1, v2 = false;
        if (r < MP) {
            const int b = r >> 12, s = r & 4095, pos = s + 16;
            const int kp0 = pos - 127 + lane, kp1 = kp0 + 64;
            v0 = kp0 >= 0; v1 = kp1 >= 0;
            const int kr0 = kp0 >= 16 ? b * 4096 + kp0 - 16 : MR + (kp0 < 0 ? 0 : kp0);
            const int kr1 = kp1 >= 16 ? b * 4096 + kp1 - 16 : MR + (kp1 < 0 ? 0 : kp1);
            l0 = dot64_bf16(qf, P + (size_t)kr0 * DIN + 512 + kvh * 64) * 0.125f;
            l1 = dot64_bf16(qf, P + (size_t)kr1 * DIN + 512 + kvh * 64) * 0.125f;
        } else {
            const int db = (r - MP) >> 2, t = (r - MP) & 3;
            v0 = lane >= t + 1; v1 = true;
            l0 = dot64_f32(qf, F.in[I_CK] + ((size_t)(db * 128 + lane) * 2 + kvh) * 64) * 0.125f;
            l1 = dot64_f32(qf, F.in[I_CK] + ((size_t)(db * 128 + lane + 64) * 2 + kvh) * 64) * 0.125f;
            v2 = lane <= t;
            const int tr = lane < 4 ? lane : 0;
            l2 = dot64_bf16(qf, P + (size_t)(MP + db * 4 + tr) * DIN + 512 + kvh * 64) * 0.125f;
        }
        l0 = v0 ? l0 : NEG; l1 = v1 ? l1 : NEG; l2 = v2 ? l2 : NEG;
        float m = wave_max(fmaxf(fmaxf(l0, l1), l2)); m = fmaxf(m, sink);
        const float e0 = v0 ? __expf(l0 - m) : 0.f, e1 = v1 ? __expf(l1 - m) : 0.f, e2 = v2 ? __expf(l2 - m) : 0.f;
        const float den = wave_sum(e0 + e1 + e2) + __expf(sink - m);
        const float inv = 1.0f / den;
        pw[lane] = e0 * inv; pw[64 + lane] = e1 * inv; pw[128 + lane] = e2 * inv;
        LDS_WAIT(); asm volatile("" ::: "memory");
        float o = 0.f;
        if (r < MP) {
            const int b = r >> 12, s = r & 4095, pos = s + 16;
#pragma unroll 1
            for (int j = 0; j < 128; ++j) { const int kp = pos - 127 + j; if (kp < 0) continue;
                const int kr = kp >= 16 ? b * 4096 + kp - 16 : MR + kp;
                o += pw[j] * bf1(P[(size_t)kr * DIN + 640 + kvh * 64 + lane]); }
        } else {
            const int db = (r - MP) >> 2, t = (r - MP) & 3;
#pragma unroll 1
            for (int j = t + 1; j < 128; ++j) o += pw[j] * F.in[I_CV][((size_t)(db * 128 + j) * 2 + kvh) * 64 + lane];
#pragma unroll 1
            for (int j = 0; j <= t; ++j) o += pw[128 + j] * bf1(P[(size_t)(MP + db * 4 + j) * DIN + 640 + kvh * 64 + lane]);
        }
        ATT[(size_t)r * AW + h * 64 + lane] = (bf16)f2bf(o);
        LDS_WAIT(); asm volatile("" ::: "memory");
    }
}
__device__ __forceinline__ void p3_windows(Frame& F) {
    const int gt = F.vcu * (NWAVES * 64) + F.tid, NT = F.G * NWAVES * 64;
    const bf16* P = (const bf16*)(F.ws + WS_P);
    for (int e = gt; e < 65536; e += NT) { const int b = e >> 14, j = (e >> 7) & 127, c = e & 127; const size_t base = (size_t)(b * 4096 + 3968 + j) * DIN;
        F.out[O_KP + e] = bf1(P[base + 512 + c]); F.out[O_VP + e] = bf1(P[base + 640 + c]); }
    for (int e = gt; e < 2097152; e += NT) { const int db = e >> 14, j = (e >> 7) & 127, c = e & 127;
        float kv, vv;
        if (j < 124) { kv = F.in[I_CK][(size_t)(db * 128 + j + 4) * 128 + c]; vv = F.in[I_CV][(size_t)(db * 128 + j + 4) * 128 + c]; }
        else { const size_t base = (size_t)(MP + db * 4 + j - 124) * DIN; kv = bf1(P[base + 512 + c]); vv = bf1(P[base + 640 + c]); }
        F.out[O_KS + e] = kv; F.out[O_VS + e] = vv; }
}
__device__ __forceinline__ void unpack8(const v4u w, float (&f)[8]) { f[0] = bflo(w.x); f[1] = bfhi(w.x); f[2] = bflo(w.y); f[3] = bfhi(w.y); f[4] = bflo(w.z); f[5] = bfhi(w.z); f[6] = bflo(w.w); f[7] = bfhi(w.w); }
__device__ __forceinline__ v4u pack8(const float (&f)[8]) { v4u w; w.x = pk2(f[0], f[1]); w.y = pk2(f[2], f[3]); w.z = pk2(f[4], f[5]); w.w = pk2(f[6], f[7]); return w; }
__device__ __forceinline__ void p5_mixnorm(Frame& F) {
    const int gw = F.vcu * NWAVES + F.wave, NGW = F.G * NWAVES, lane = F.lane;
    const bf16* ATT = (const bf16*)(F.ws + WS_ATT); const bf16* Z = (const bf16*)(F.ws + WS_Z); const bf16* GL = (const bf16*)(F.ws + WS_GL); bf16* CAT = (bf16*)(F.ws + WS_CAT);
    for (int r = gw; r < MR; r += NGW) {
        float a[8], z[8], gt[8], o[8];
        unpack8(*(const v4u*)(ATT + (size_t)r * AW + lane * 8), a); unpack8(*(const v4u*)(Z + (size_t)r * SW + lane * 8), z); unpack8(*(const v4u*)(GL + (size_t)r * SW + lane * 8), gt);
        float sa = 0.f, so = 0.f;
#pragma unroll
        for (int i = 0; i < 8; ++i) { o[i] = z[i] * sigmoidf_(gt[i]); sa += a[i] * a[i]; so += o[i] * o[i]; }
        const float ra = 1.0f / sqrtf(wave_sum(sa) * (1.f / 512.f) + EPS), ro = 1.0f / sqrtf(wave_sum(so) * (1.f / 512.f) + EPS);
#pragma unroll
        for (int i = 0; i < 8; ++i) { a[i] = a[i] * ra * F.in[I_GATT][lane * 8 + i]; o[i] = o[i] * ro * F.in[I_GSSM][lane * 8 + i]; }
        *(v4u*)(CAT + (size_t)r * D + lane * 8) = pack8(a); *(v4u*)(CAT + (size_t)r * D + 512 + lane * 8) = pack8(o);
    }
}
__device__ __forceinline__ void p7_mid(Frame& F) {
    const int gw = F.vcu * NWAVES + F.wave, NGW = F.G * NWAVES, lane = F.lane;
    const bf16* O1 = (const bf16*)(F.ws + WS_O); bf16* XN2 = (bf16*)(F.ws + WS_XN);
    for (int r = gw; r < MR; r += NGW) {
        float o[16], x[16];
        { float t[8]; unpack8(*(const v4u*)(O1 + (size_t)r * D + lane * 8), t);
#pragma unroll
          for (int i = 0; i < 8; ++i) o[i] = t[i];
          unpack8(*(const v4u*)(O1 + (size_t)r * D + 512 + lane * 8), t);
#pragma unroll
          for (int i = 0; i < 8; ++i) o[8 + i] = t[i]; }
        const float* xr = x_row_ptr(F, r);
#pragma unroll
        for (int hf = 0; hf < 2; ++hf) { const f32x4 a = *(const f32x4*)(xr + hf * 512 + lane * 8), b = *(const f32x4*)(xr + hf * 512 + lane * 8 + 4);
            x[hf * 8 + 0] = a.x; x[hf * 8 + 1] = a.y; x[hf * 8 + 2] = a.z; x[hf * 8 + 3] = a.w; x[hf * 8 + 4] = b.x; x[hf * 8 + 5] = b.y; x[hf * 8 + 6] = b.z; x[hf * 8 + 7] = b.w; }
        float ss = 0.f;
#pragma unroll
        for (int i = 0; i < 16; ++i) ss += o[i] * o[i];
        const float r1 = 1.0f / sqrtf(wave_sum(ss) * (1.f / 1024.f) + EPS);
        float s2 = 0.f;
#pragma unroll
        for (int i = 0; i < 16; ++i) { const int col = (i >> 3) * 512 + lane * 8 + (i & 7); x[i] = x[i] + o[i] * r1 * F.in[I_GPOST][col]; s2 += x[i] * x[i]; }
        const float r2 = 1.0f / sqrtf(wave_sum(s2) * (1.f / 1024.f) + EPS);
        float* yo = F.out + (size_t)r * D;
#pragma unroll
        for (int hf = 0; hf < 2; ++hf) {
            *(f32x4*)(yo + hf * 512 + lane * 8) = (f32x4){x[hf * 8 + 0], x[hf * 8 + 1], x[hf * 8 + 2], x[hf * 8 + 3]};
            *(f32x4*)(yo + hf * 512 + lane * 8 + 4) = (f32x4){x[hf * 8 + 4], x[hf * 8 + 5], x[hf * 8 + 6], x[hf * 8 + 7]};
            float n[8];
#pragma unroll
            for (int i = 0; i < 8; ++i) n[i] = x[hf * 8 + i] * r2 * F.in[I_GMLP][hf * 512 + lane * 8 + i];
            *(v4u*)(XN2 + (size_t)r * D + hf * 512 + lane * 8) = pack8(n);
        }
    }
}
__device__ __forceinline__ void p10_final(Frame& F) {
    const int gw = F.vcu * NWAVES + F.wave, NGW = F.G * NWAVES, lane = F.lane;
    const bf16* O2 = (const bf16*)(F.ws + WS_O);
    for (int r = gw; r < MR; r += NGW) {
        float o[16];
        { float t[8]; unpack8(*(const v4u*)(O2 + (size_t)r * D + lane * 8), t);
#pragma unroll
          for (int i = 0; i < 8; ++i) o[i] = t[i];
          unpack8(*(const v4u*)(O2 + (size_t)r * D + 512 + lane * 8), t);
#pragma unroll
          for (int i = 0; i < 8; ++i) o[8 + i] = t[i]; }
        float ss = 0.f;
#pragma unroll
        for (int i = 0; i < 16; ++i) ss += o[i] * o[i];
        const float r1 = 1.0f / sqrtf(wave_sum(ss) * (1.f / 1024.f) + EPS);
        float* yo = F.out + (size_t)r * D;
#pragma unroll
        for (int hf = 0; hf < 2; ++hf) {
            f32x4 a = *(const f32x4*)(yo + hf * 512 + lane * 8), b = *(const f32x4*)(yo + hf * 512 + lane * 8 + 4);
            const float* g = F.in[I_GMLPP] + hf * 512 + lane * 8;
            a.x += o[hf * 8 + 0] * r1 * g[0]; a.y += o[hf * 8 + 1] * r1 * g[1]; a.z += o[hf * 8 + 2] * r1 * g[2]; a.w += o[hf * 8 + 3] * r1 * g[3];
            b.x += o[hf * 8 + 4] * r1 * g[4]; b.y += o[hf * 8 + 5] * r1 * g[5]; b.z += o[hf * 8 + 6] * r1 * g[6]; b.w += o[hf * 8 + 7] * r1 * g[7];
            *(f32x4*)(yo + hf * 512 + lane * 8) = a; *(f32x4*)(yo + hf * 512 + lane * 8 + 4) = b;
        }
    }
}

#ifndef MK_N_LAUNCHES
#define MK_N_LAUNCHES 1
#endif
constexpr int N_PHASES = 11;
struct Args { const float* in[27]; float* out; unsigned char* ws; int ph_lo, ph_hi; };
__global__ void __launch_bounds__(NWAVES * 64, 2) hymba_fwd(Args args) {
    extern __shared__ __attribute__((aligned(16))) unsigned char lds[];
    Frame F;
    F.lds = (LAS unsigned char*)lds;
    F.MISC = (volatile LAS unsigned*)(F.lds + MISC_OFF);
    F.tid = threadIdx.x; F.lane = F.tid & 63; F.wave = __builtin_amdgcn_readfirstlane(F.tid >> 6);
    F.G = gridDim.x; { const int bx = blockIdx.x; F.vcu = (F.G % 8 == 0) ? (bx % 8) * (F.G / 8) + bx / 8 : bx; }
#pragma unroll
    for (int i = 0; i < 27; ++i) F.in[i] = args.in[i];
    F.out = args.out; F.ws = args.ws; F.ctl = (gu32*)(args.ws + WS_CTL);
    for (int u = F.tid; u < (LDS_BYTES - LDSCTL_OFF) / 4; u += NWAVES * 64) ((LAS unsigned*)(F.lds + LDSCTL_OFF))[u] = 0u;
    __syncthreads();
    const int lo = args.ph_lo, hi = args.ph_hi;
    const bool one = (hi - lo) > 1;
    XcdBarrier bar; bar.bar = (unsigned*)(F.ctl + CW_BAR); bar.x = 0; bar.st = nullptr;
    if (one) bar = xcd_barrier_post((unsigned*)(F.ctl + CW_BAR), F.MISC + 8);
#define IN(k) (lo <= (k) && (k) < hi)
#define SEAM(k) do { if (IN(k) && IN((k) + 1)) xcd_barrier(bar); } while (0)
    bf16* const XN = (bf16*)(F.ws + WS_XN); bf16* const OB = (bf16*)(F.ws + WS_O); bf16* const PB = (bf16*)(F.ws + WS_P);
    if (IN(0)) { p0_prologue(F); } SEAM(0);
    if (IN(1)) { pg8::Gemm g{XN, (const bf16*)(F.ws + WS_WIN), MIN_ROWS, DIN, D}; pg8::StaticOrder S; S.init(MIN_ROWS, DIN, F.G, (int)blockIdx.x);
        pg8::EpiBf16<0> E{PB, DIN}; pg8::gemm_phase<pg8::EpiBf16<0>, pg8::StaticOrder, true, true>(F.lds, g, S, E); } SEAM(1);
    if (IN(2)) { p2_rope(F); } SEAM(2);
    if (IN(3)) { p3_ssm_naive(F); p3_attn_naive(F); p3_windows(F); } SEAM(3);
    if (IN(4)) { pg8::Gemm g{(const bf16*)(F.ws + WS_Z), (const bf16*)(F.ws + WS_WGLU), MR, SW, SW}; pg8::StaticOrder S; S.init(MR, SW, F.G, (int)blockIdx.x);
        pg8::EpiBf16<0> E{(bf16*)(F.ws + WS_GL), SW}; pg8::gemm_phase<pg8::EpiBf16<0>, pg8::StaticOrder, true, true>(F.lds, g, S, E); } SEAM(4);
    if (IN(5)) { p5_mixnorm(F); } SEAM(5);
    if (IN(6)) { pg8::Gemm g{(const bf16*)(F.ws + WS_CAT), (const bf16*)(F.ws + WS_WOUT), MR, D, D}; pg8::StaticOrder S; S.init(MR, D, F.G, (int)blockIdx.x);
        pg8::EpiBf16<0> E{OB, D}; pg8::gemm_phase<pg8::EpiBf16<0>, pg8::StaticOrder, true, true>(F.lds, g, S, E); } SEAM(6);
    if (IN(7)) { p7_mid(F); } SEAM(7);
    if (IN(8)) { pg8::Gemm g{XN, (const bf16*)(F.ws + WS_WUP), MR, DFF, D}; pg8::StaticOrder S; S.init(MR, DFF, F.G, (int)blockIdx.x);
        pg8::EpiBf16<2> E{(bf16*)(F.ws + WS_H), DFF}; pg8::gemm_phase<pg8::EpiBf16<2>, pg8::StaticOrder, true, true>(F.lds, g, S, E); } SEAM(8);
    if (IN(9)) { pg8::Gemm g{(const bf16*)(F.ws + WS_H), (const bf16*)(F.ws + WS_WDN), MR, D, DFF}; pg8::StaticOrder S; S.init(MR, D, F.G, (int)blockIdx.x);
        pg8::EpiBf16<0> E{OB, D}; pg8::gemm_phase<pg8::EpiBf16<0>, pg8::StaticOrder, true, true>(F.lds, g, S, E); } SEAM(9);
    if (IN(10)) { p10_final(F); }
#undef IN
#undef SEAM
}

extern "C" void kernel_launch(void* const* d_in, const int* in_sizes, int n_in, void* d_out, int out_size, void* d_ws, size_t ws_size, hipStream_t stream) {
    static int grid = 0;
    if (grid == 0) {
        if (n_in != 27 || ws_size < WS_END) { fprintf(stderr, "kernel_launch: unexpected n_in %d / ws %zu\n", n_in, ws_size); grid = -1; return; }
        int dev = 0, cus = 0, per_cu = 0;
        if (hipGetDevice(&dev) != hipSuccess || hipDeviceGetAttribute(&cus, hipDeviceAttributeMultiprocessorCount, dev) != hipSuccess) { grid = -1; return; }
        if (hipFuncSetAttribute((const void*)hymba_fwd, hipFuncAttributeMaxDynamicSharedMemorySize, LDS_BYTES) != hipSuccess) { fprintf(stderr, "kernel_launch: hipFuncSetAttribute failed\n"); grid = -1; return; }
        if (hipOccupancyMaxActiveBlocksPerMultiprocessor(&per_cu, (const void*)hymba_fwd, NWAVES * 64, LDS_BYTES) != hipSuccess || per_cu < 1) { fprintf(stderr, "kernel_launch: occupancy query says %d\n", per_cu); per_cu = 1; }
        (void)hipGetLastError();
        grid = cus;
    }
    if (grid < 0) return;
    (void)hipMemsetAsync((char*)d_ws + WS_CTL, 0, CTL_ZERO_BYTES, stream);
    Args a{};
    for (int i = 0; i < 27; ++i) a.in[i] = (const float*)d_in[i];
    a.out = (float*)d_out; a.ws = (unsigned char*)d_ws;
#if MK_N_LAUNCHES == 1
    a.ph_lo = 0; a.ph_hi = N_PHASES;
    void* kargs[] = {&a};
    hipError_t e = hipLaunchCooperativeKernel((const void*)hymba_fwd, dim3(grid), dim3(NWAVES * 64), kargs, LDS_BYTES, stream);
    if (e != hipSuccess) fprintf(stderr, "kernel_launch: cooperative launch failed: %s (grid %d)\n", hipGetErrorString(e), grid);
#else
    for (int p = 0; p < N_PHASES; ++p) { a.ph_lo = p; a.ph_hi = p + 1; hipLaunchKernelGGL(hymba_fwd, dim3(grid), dim3(NWAVES * 64), LDS_BYTES, stream, a); }
#endif
}
```

```cpp
#include <hip/hip_runtime.h>
#include <cstdio>
#include <cstdint>
namespace pg8 {
#define PG8_LAS __attribute__((address_space(3)))
typedef unsigned short bf16_t;
typedef short bf16x8 __attribute__((ext_vector_type(8)));
typedef float f32x4 __attribute__((ext_vector_type(4)));
typedef unsigned u32x4 __attribute__((ext_vector_type(4)));
constexpr int BM = 256, BK = 64, HALF = 128, HTB = HALF * BK * 2  , STAGE_BYTES = 8 * HTB, NXCD = 8, WGM = 8;

__host__ __device__ __forceinline__ int lds_byte(int r, int c) { const int st = (r >> 4) * 2 + (c >> 5), rr = r & 15, cc = c & 31, ob = rr * 64 + cc * 2; return st * 1024 + (ob ^ (((ob >> 9) & 1) << 5)); }
__host__ __device__ __forceinline__ void stage_rc(int b, int& R, int& C) { const int st = b / 1024, sb = b % 1024, swz = sb ^ (((sb >> 9) & 1) << 5); R = (st >> 1) * 16 + swz / 64; C = (st & 1) * 32 + (swz % 64) / 2; }
__host__ __device__ __forceinline__ int perm32(int rho) { const int n = rho >> 4, i = rho & 15; return 8 * (i >> 2) + 4 * n + (i & 3); }

struct Unit { int pm, pn; };
struct Gemm { const bf16_t* A; const bf16_t* Bt; int M, N, K; };

struct StaticOrder {
    int nM, nN, nwg, G, c;
    __host__ __device__ void init(int M, int N, int G_, int c_) { nM = M / BM; nN = N / BM; nwg = nM * nN; G = G_; c = c_; }
    __host__ __device__ bool next(int i, Unit& u) const {
        const long L = (long)i * G + c; if (L >= nwg) return false;
        int wgid = (int)L; { const int q = nwg / NXCD, r = nwg % NXCD, xcd = wgid % NXCD, off = wgid / NXCD; wgid = (xcd < r ? xcd * (q + 1) : r * (q + 1) + (xcd - r) * q) + off; }
        const int nig = WGM * nN, gid = wgid / nig, fm = gid * WGM, gsz = (nM - fm) < WGM ? (nM - fm) : WGM;
        u.pm = fm + ((wgid % nig) % gsz); u.pn = (wgid % nig) / gsz; return true;
    }
    __device__ __forceinline__ void a_ready(const Unit&) const {}
    __device__ __forceinline__ void done(const Unit&) const {}
};
__device__ __forceinline__ unsigned cvt_pk_bf16(float lo, float hi) { unsigned r; asm volatile("v_cvt_pk_bf16_f32 %0, %1, %2" : "=v"(r) : "v"(lo), "v"(hi)); return r; }
template <int ACT> struct EpiBf16 {
    static constexpr bool PERM = true, AFTER_DRAIN = false;
    bf16_t* O; int ldc;
    __device__ __forceinline__ void operator()(const f32x4 (&acc)[2][2][4][2], const Unit& u, int wr, int wc, int fr, int fq) const {
        const int row0 = u.pm * BM + wr * 64 + fr; const int col0 = u.pn * BM + wc * 32 + 8 * fq;
#pragma unroll
        for (int ai = 0; ai < 2; ++ai)
#pragma unroll
            for (int m = 0; m < 4; ++m) { bf16_t* rowp = O + (size_t)(row0 + ai * HALF + m * 16) * ldc + col0;
#pragma unroll
                for (int bj = 0; bj < 2; ++bj) { f32x4 v0 = acc[ai][bj][m][0], v1 = acc[ai][bj][m][1];
                    if (ACT == 2) {
#pragma unroll
                        for (int e = 0; e < 4; ++e) { const float a = fmaxf(v0[e], 0.f), b = fmaxf(v1[e], 0.f); v0[e] = a * a; v1[e] = b * b; } }
                    u32x4 w; w.x = cvt_pk_bf16(v0[0], v0[1]); w.y = cvt_pk_bf16(v0[2], v0[3]); w.z = cvt_pk_bf16(v1[0], v1[1]); w.w = cvt_pk_bf16(v1[2], v1[3]);
                    *(u32x4*)(rowp + bj * HALF) = w; } }
    }
};
template <class Epi, class Sched, bool ALIGN_EPI = false, bool SP2 = false>
__device__ __forceinline__ void gemm_phase(PG8_LAS unsigned char* lds, const Gemm g, const Sched& S, const Epi& E) {
    const int tid = threadIdx.x, wid = __builtin_amdgcn_readfirstlane(tid >> 6), lane = tid & 63, wr = wid >> 2, wc = wid & 3, fr = lane & 15, fq = lane >> 4;
    const int K = g.K, nt = K / BK;
    unsigned voffA[2], voffB[2];
#pragma unroll
    for (int i = 0; i < 2; ++i) { int R, C; stage_rc(tid * 16 + i * 8192, R, C); const int Rb = Epi::PERM ? ((R & ~31) + perm32(R & 31)) : R;
        voffA[i] = (unsigned)(R * K + C) * 2u; voffB[i] = (unsigned)(Rb * K + C) * 2u; }
    const size_t kstep = (size_t)(BK * 2);
    const size_t hstep = (size_t)HALF * K * 2;
    const size_t tstep = 2 * hstep;
    const unsigned ldsw = (unsigned)wid * 1024u;
    const int aoff = lds_byte(wr * 64 + fr, fq * 8), boff = lds_byte(wc * 32 + fr, fq * 8);
#define PG8_SA(b, h) (((b) * 2 + (h)) * HTB)
#define PG8_SB(b, h) ((4 + (b) * 2 + (h)) * HTB)
#define PG8_STAGE(bufoff, gbase, voff) do { _Pragma("unroll") for (int _i = 0; _i < 2; ++_i) \
        __builtin_amdgcn_global_load_lds((const unsigned*)((const char*)(gbase) + (voff)[_i]), (PG8_LAS unsigned*)(lds + (bufoff) + ldsw + _i * 8192), 16, 0, 0); } while (0)
#define PG8_LDA(dst, b, h) do { _Pragma("unroll") for (int m = 0; m < 4; ++m) _Pragma("unroll") for (int k = 0; k < 2; ++k) dst[m][k] = *(const PG8_LAS bf16x8*)(lds + PG8_SA(b, h) + aoff + m * 2048 + k * 1024); } while (0)
#define PG8_LDB(dst, b, h) do { _Pragma("unroll") for (int n = 0; n < 2; ++n) _Pragma("unroll") for (int k = 0; k < 2; ++k) dst[n][k] = *(const PG8_LAS bf16x8*)(lds + PG8_SB(b, h) + boff + n * 2048 + k * 1024); } while (0)
#define PG8_MMA(ai, bj, At, Bt) do { __builtin_amdgcn_s_setprio(1); _Pragma("unroll") for (int m = 0; m < 4; ++m) _Pragma("unroll") for (int n = 0; n < 2; ++n) _Pragma("unroll") for (int k = 0; k < 2; ++k) \
        acc[ai][bj][m][n] = __builtin_amdgcn_mfma_f32_16x16x32_bf16(Bt[n][k], At[m][k], acc[ai][bj][m][n], 0, 0, 0); __builtin_amdgcn_s_setprio(0); } while (0)
#define PG8_WAIT_V(n) asm volatile("s_waitcnt vmcnt(" #n ")" ::: "memory")
#define PG8_WAIT_L(n) asm volatile("s_waitcnt lgkmcnt(" #n ")" ::: "memory")
#define PG8_BAR __builtin_amdgcn_s_barrier()
#define PG8_SCHED __builtin_amdgcn_sched_barrier(0)
    Unit cur, nxt; int ui = 0;
    if (!S.next(0, cur)) return;
    f32x4 acc[2][2][4][2];
#pragma unroll
    for (int a = 0; a < 2; ++a)
#pragma unroll
        for (int b = 0; b < 2; ++b)
#pragma unroll
            for (int m = 0; m < 4; ++m)
#pragma unroll
                for (int n = 0; n < 2; ++n) acc[a][b][m][n] = (f32x4){0.f, 0.f, 0.f, 0.f};
    bf16x8 At[4][2], B0[2][2], B1[2][2];
    const char* cA = (const char*)g.A + (size_t)cur.pm * tstep; const char* cB = (const char*)g.Bt + (size_t)cur.pn * tstep;
    S.a_ready(cur);
    if constexpr (SP2) {
        PG8_STAGE(PG8_SB(0, 0), cB, voffB); PG8_STAGE(PG8_SB(0, 1), cB + hstep, voffB); PG8_STAGE(PG8_SA(0, 0), cA, voffA); PG8_STAGE(PG8_SA(0, 1), cA + hstep, voffA);
        if (wr == 1) PG8_BAR;
        PG8_WAIT_V(2); PG8_BAR;
        PG8_STAGE(PG8_SB(1, 0), cB + kstep, voffB); PG8_STAGE(PG8_SA(1, 0), cA + kstep, voffA); PG8_STAGE(PG8_SB(1, 1), cB + hstep + kstep, voffB);
        PG8_WAIT_V(6); PG8_BAR;
    } else {
        PG8_STAGE(PG8_SB(0, 0), cB, voffB); PG8_STAGE(PG8_SA(0, 0), cA, voffA); PG8_STAGE(PG8_SB(0, 1), cB + hstep, voffB); PG8_STAGE(PG8_SA(0, 1), cA + hstep, voffA);
        if (wr == 1) PG8_BAR;
        PG8_WAIT_V(4); PG8_BAR;
        PG8_STAGE(PG8_SB(1, 0), cB + kstep, voffB); PG8_STAGE(PG8_SA(1, 0), cA + kstep, voffA); PG8_STAGE(PG8_SB(1, 1), cB + hstep + kstep, voffB);
        PG8_WAIT_V(6); PG8_BAR;
    }
    for (;;) {
        const bool has_next = S.next(ui + 1, nxt);
        const char* nA = has_next ? (const char*)g.A + (size_t)nxt.pm * tstep : cA; const char* nB = has_next ? (const char*)g.Bt + (size_t)nxt.pn * tstep : cB;
        for (int t = 0; t < nt; t += 2) {
            const bool last = (t == nt - 2);
            const char* a1 = cA + (size_t)(t + 1) * kstep;
            const char* a2 = last ? nA : cA + (size_t)(t + 2) * kstep; const char* b2 = last ? nB : cB + (size_t)(t + 2) * kstep;
            const char* a3 = a2 + kstep; const char* b3 = b2 + kstep;
            if (last && has_next) S.a_ready(nxt);
            if constexpr (SP2) {
            PG8_LDB(B0, 0, 0); PG8_LDB(B1, 0, 1); PG8_SCHED; PG8_LDA(At, 0, 0); PG8_STAGE(PG8_SA(1, 1), a1 + hstep, voffA);
            PG8_WAIT_V(8); PG8_WAIT_L(0); PG8_BAR; PG8_MMA(0, 0, At, B0); PG8_MMA(0, 1, At, B1); PG8_BAR; PG8_SCHED;
            PG8_LDA(At, 0, 1); PG8_STAGE(PG8_SB(0, 0), b2, voffB); PG8_STAGE(PG8_SB(0, 1), b2 + hstep, voffB); PG8_STAGE(PG8_SA(0, 0), a2, voffA);
            PG8_WAIT_V(8); PG8_WAIT_L(0); PG8_BAR; PG8_MMA(1, 0, At, B0); PG8_MMA(1, 1, At, B1); PG8_BAR; PG8_SCHED;
            PG8_LDB(B0, 1, 0); PG8_LDB(B1, 1, 1); PG8_SCHED; PG8_LDA(At, 1, 0); PG8_STAGE(PG8_SA(0, 1), a2 + hstep, voffA);
            PG8_WAIT_V(8); PG8_WAIT_L(0); PG8_BAR; PG8_MMA(0, 0, At, B0); PG8_MMA(0, 1, At, B1); PG8_BAR; PG8_SCHED;
            PG8_LDA(At, 1, 1); PG8_STAGE(PG8_SB(1, 0), b3, voffB); PG8_STAGE(PG8_SB(1, 1), b3 + hstep, voffB); PG8_STAGE(PG8_SA(1, 0), a3, voffA);
            PG8_WAIT_V(8); PG8_WAIT_L(0); PG8_BAR; PG8_MMA(1, 0, At, B0); PG8_MMA(1, 1, At, B1); PG8_BAR; PG8_SCHED;
            } else {
            PG8_LDB(B0, 0, 0); PG8_SCHED; PG8_LDA(At, 0, 0); PG8_STAGE(PG8_SA(1, 1), a1 + hstep, voffA);
            PG8_WAIT_L(8); PG8_BAR; PG8_WAIT_L(0); PG8_MMA(0, 0, At, B0); PG8_BAR; PG8_SCHED;
            PG8_LDB(B1, 0, 1); PG8_STAGE(PG8_SB(0, 0), b2, voffB);
            PG8_BAR; PG8_WAIT_L(0); PG8_MMA(0, 1, At, B1); PG8_BAR;
            PG8_LDA(At, 0, 1); PG8_STAGE(PG8_SA(0, 0), a2, voffA);
            PG8_BAR; PG8_WAIT_L(0); PG8_MMA(1, 0, At, B0); PG8_BAR; PG8_SCHED;
            PG8_STAGE(PG8_SB(0, 1), b2 + hstep, voffB);
            PG8_WAIT_V(6); PG8_BAR; PG8_MMA(1, 1, At, B1); PG8_BAR;
            PG8_LDB(B0, 1, 0); PG8_SCHED; PG8_LDA(At, 1, 0); PG8_STAGE(PG8_SA(0, 1), a2 + hstep, voffA);
            PG8_WAIT_L(8); PG8_BAR; PG8_WAIT_L(0); PG8_MMA(0, 0, At, B0); PG8_BAR; PG8_SCHED;
            PG8_LDB(B1, 1, 1); PG8_STAGE(PG8_SB(1, 0), b3, voffB);
            PG8_BAR; PG8_WAIT_L(0); PG8_MMA(0, 1, At, B1); PG8_BAR;
            PG8_LDA(At, 1, 1); PG8_STAGE(PG8_SA(1, 0), a3, voffA);
            PG8_BAR; PG8_WAIT_L(0); PG8_MMA(1, 0, At, B0); PG8_BAR; PG8_SCHED;
            PG8_STAGE(PG8_SB(1, 1), b3 + hstep, voffB);
            PG8_WAIT_V(6); PG8_BAR; PG8_MMA(1, 1, At, B1); PG8_BAR;
            }
        }
        if constexpr (ALIGN_EPI) { if (wr == 0) PG8_BAR; }
        if constexpr (!Epi::AFTER_DRAIN) { E(acc, cur, wr, wc, fr, fq); S.done(cur); }
        if (!has_next) break;
#pragma unroll
        for (int a = 0; a < 2; ++a)
#pragma unroll
            for (int b = 0; b < 2; ++b)
#pragma unroll
                for (int m = 0; m < 4; ++m)
#pragma unroll
                    for (int n = 0; n < 2; ++n) acc[a][b][m][n] = (f32x4){0.f, 0.f, 0.f, 0.f};
        cur = nxt; cA = nA; cB = nB; ++ui;
        if constexpr (ALIGN_EPI) { if (wr == 1) PG8_BAR; }
    }
    PG8_WAIT_V(0);
    if constexpr (!ALIGN_EPI) { if (wr == 0) PG8_BAR; }
    PG8_BAR;
    if constexpr (Epi::AFTER_DRAIN) { E.fused(acc, cur, wr, wc, fr, fq, lds, wid, lane); S.done(cur); }
#undef PG8_SA
#undef PG8_SB
#undef PG8_STAGE
#undef PG8_LDA
#undef PG8_LDB
#undef PG8_MMA
#undef PG8_WAIT_V
#undef PG8_WAIT_L
#undef PG8_BAR
#undef PG8_SCHED
}
}

constexpr int NWAVES = 8;
constexpr int D = 1024, DIN = 1280, DFF = 4096, AW = 512, SW = 512;
constexpr int MP = 16384, MS = 512, MR = MP + MS;
constexpr int MMETA = MR, NMETA = 16, MIN_ROWS = 17152;
constexpr int NPOS = 4112 + 4;
constexpr float EPS = 1e-6f;
constexpr size_t O_YP = 0, O_YS = 16777216, O_KP = 17301504, O_VP = 17367040, O_SRP = 17432576, O_SIP = 17440768, O_KS = 17448960, O_VS = 19546112, O_SRS = 21643264, O_SIS = 21905408;
constexpr size_t MiB = 1u << 20;
constexpr size_t WS_CTL = 0, CTL_ZERO_BYTES = 1 * MiB;
constexpr size_t WS_ROPEC = 1 * MiB, WS_ROPES = WS_ROPEC + 160 * 1024, WS_ABR = WS_ROPES + 160 * 1024, WS_ABI = WS_ABR + 8192, WS_BBR = WS_ABI + 8192, WS_BBI = WS_BBR + 131072;
static_assert(WS_BBI + 131072 <= 2 * MiB && NPOS * 8 * 4 <= 160 * 1024, "tables");
constexpr size_t WS_WIN = 2 * MiB, WS_WGLU = 5 * MiB, WS_WOUT = 6 * MiB, WS_WUP = 8 * MiB, WS_WDN = 16 * MiB;
constexpr size_t WS_XN = 24 * MiB, WS_O = 58 * MiB, WS_P = 92 * MiB, WS_ATT = 134 * MiB, WS_Z = 151 * MiB, WS_GL = 168 * MiB, WS_CAT = 185 * MiB, WS_H = 92 * MiB, WS_END = 224 * MiB;
constexpr size_t WS_VT = 224 * MiB, WS_QT = 228 * MiB, WS_KC = 232 * MiB, WS_HL = 233 * MiB, WS_HIN = 241 * MiB, WS_HM = 245 * MiB, WS_A32 = WS_HM + 16384, WS_TOP = 246 * MiB;
static_assert(WS_XN + (size_t)MIN_ROWS * D * 2 <= WS_O && WS_O + (size_t)MR * D * 2 <= WS_P && WS_P + (size_t)MIN_ROWS * DIN * 2 <= WS_ATT && WS_ATT + (size_t)MR * AW * 2 <= WS_Z && WS_Z + (size_t)MR * SW * 2 <= WS_GL &&
              WS_GL + (size_t)MR * SW * 2 <= WS_CAT && WS_CAT + (size_t)MR * D * 2 <= WS_END && WS_H + (size_t)MR * DFF * 2 <= WS_END, "d_ws map");
constexpr int CW_BAR = 4096;
constexpr int RING_BYTES = 131072, LDS_BYTES = 163840, LDSCTL_OFF = LDS_BYTES - 512, MISC_OFF = LDSCTL_OFF + 320;

#define GAS __attribute__((address_space(1)))
#define LAS __attribute__((address_space(3)))
typedef unsigned short bf16;
typedef unsigned v4u __attribute__((ext_vector_type(4)));
typedef unsigned v2u __attribute__((ext_vector_type(2)));
typedef float f32x4 __attribute__((ext_vector_type(4)));
typedef GAS unsigned gu32;
#define RLX_AGENT __ATOMIC_RELAXED, __HIP_MEMORY_SCOPE_AGENT
#define LDS_WAIT() asm volatile("s_waitcnt lgkmcnt(0)" ::: "memory")
#define VM_WAIT() asm volatile("s_waitcnt vmcnt(0)" ::: "memory")
__device__ __forceinline__ unsigned f2bf(float f) { unsigned u = __builtin_bit_cast(unsigned, f); return (u + 0x7fffu + ((u >> 16) & 1u)) >> 16; }
__device__ __forceinline__ unsigned pk2(float lo, float hi) { return f2bf(lo) | (f2bf(hi) << 16); }
__device__ __forceinline__ float bflo(unsigned w) { return __uint_as_float(w << 16); }
__device__ __forceinline__ float bfhi(unsigned w) { return __uint_as_float(w & 0xffff0000u); }
__device__ __forceinline__ float bf1(bf16 b) { return __uint_as_float((unsigned)b << 16); }

#define XB_TMO      128
#define XB_XCNT(j)  (256  + 64 * (j))
#define XB_XSUB(j)  (1280 + 64 * (j))
#define XB_XGEN(j)  (2304 + 64 * (j))
#define XB_TOP      3328
#define XB_TOPGEN   3392
#define XCD_BAR_WORDS 3456
#define XB_SPIN_CAP (1u << 18)
__device__ __forceinline__ unsigned xb_ld(unsigned* p)              { return __hip_atomic_load(p, __ATOMIC_RELAXED, __HIP_MEMORY_SCOPE_AGENT); }
__device__ __forceinline__ unsigned xb_add(unsigned* p, unsigned v) { return __hip_atomic_fetch_add(p, v, __ATOMIC_RELAXED, __HIP_MEMORY_SCOPE_AGENT); }
__device__ __forceinline__ unsigned xb_xcc_id() { return (unsigned)__builtin_amdgcn_s_getreg((3 << 11) | 20) & 0xFu; }
#define XB_SPIN(cond, bar) do { unsigned _sp = 0; while (cond) { __builtin_amdgcn_s_sleep(1); \
    if ((++_sp & 255u) == 0u) { if (xb_ld(&(bar)[XB_TMO])) break; if (_sp > XB_SPIN_CAP) { atomicAdd(&(bar)[XB_TMO], 1u); break; } } } } while (0)
struct XcdBarrier { unsigned* bar; unsigned x; volatile LAS unsigned* st; };
__device__ __forceinline__ XcdBarrier xcd_barrier_post(unsigned* bar, volatile LAS unsigned* st) {
    XcdBarrier b; b.bar = bar; b.x = xb_xcc_id(); b.st = st;
    if (threadIdx.x == 0) (void)xb_add(&bar[XB_XCNT(b.x)], 1u);
    return b;
}
__device__ __forceinline__ void xcd_barrier_complete(unsigned* bar, unsigned x, unsigned& nloc, unsigned& nx) {
    const unsigned G = gridDim.x * gridDim.y * gridDim.z;
    unsigned sum, cnt, mine, sp = 0u;
    for (;;) {
        sum = 0u; cnt = 0u; mine = 0u;
#pragma unroll
        for (unsigned j = 0; j < 16; ++j) { const unsigned c = xb_ld(&bar[XB_XCNT(j)]); sum += c; cnt += (c > 0u) ? 1u : 0u; mine = (j == x) ? c : mine; }
        if (sum == G) break;
        __builtin_amdgcn_s_sleep(1);
        if ((++sp & 255u) == 0u) { if (xb_ld(&bar[XB_TMO])) break; if (sp > XB_SPIN_CAP) { atomicAdd(&bar[XB_TMO], 1u); break; } }
    }
    nloc = mine > 0u ? mine : 1u; nx = cnt > 0u ? cnt : 1u;
}
__device__ __forceinline__ void xcd_barrier(const XcdBarrier& b) {
    asm volatile("s_waitcnt vmcnt(0)" ::: "memory");
    __syncthreads();
    if (threadIdx.x == 0) {
        unsigned* bar = b.bar;
        __builtin_amdgcn_s_waitcnt(0);
        unsigned nloc = b.st[0], nx = b.st[1];
        if (nloc == 0u) { xcd_barrier_complete(bar, b.x, nloc, nx); b.st[0] = nloc; b.st[1] = nx; }
        const unsigned old = xb_add(&bar[XB_XSUB(b.x)], 1u);
        const unsigned gen = old / nloc;
        if (old + 1u == (gen + 1u) * nloc) {
            __builtin_amdgcn_fence(__ATOMIC_RELEASE, "agent");
            asm volatile("s_waitcnt vmcnt(0)" ::: "memory");
            const unsigned og = xb_add(&bar[XB_TOP], 1u);
            const unsigned tg = og / nx;
            if (og + 1u == (tg + 1u) * nx) xb_add(&bar[XB_TOPGEN], 1u);
            else XB_SPIN(xb_ld(&bar[XB_TOPGEN]) == tg, bar);
            __builtin_amdgcn_fence(__ATOMIC_ACQUIRE, "agent");
            xb_add(&bar[XB_XGEN(b.x)], 1u);
            asm volatile("s_waitcnt vmcnt(0)" ::: "memory");
        } else {
            XB_SPIN(xb_ld(&bar[XB_XGEN(b.x)]) == gen, bar);
            __builtin_amdgcn_fence(__ATOMIC_ACQUIRE, "agent");
            asm volatile("s_waitcnt vmcnt(0)" ::: "memory");
        }
    }
    __syncthreads();
}

struct Frame {
    LAS unsigned char* lds;
    volatile LAS unsigned* MISC;
    gu32* ctl;
    int tid, lane, wave;
    int vcu, G;
    const float* in[27]; float* out; unsigned char* ws;
};
enum { I_XP = 0, I_XS, I_CK, I_CV, I_SRE, I_SIM, I_META, I_GPRE, I_WIN, I_SINK, I_ARE, I_AIM, I_LDT, I_BRE, I_BIM, I_CRE, I_CIM, I_DD, I_WGLU, I_GATT, I_GSSM, I_WOUT, I_GPOST, I_GMLP, I_WUP, I_WDN, I_GMLPP };

__device__ __forceinline__ float wave_sum(float v) {
#pragma unroll
    for (int o = 1; o < 64; o <<= 1) v += __shfl_xor(v, o);
    return v;
}
__device__ __forceinline__ float wave_max(float v) {
#pragma unroll
    for (int o = 1; o < 64; o <<= 1) v = fmaxf(v, __shfl_xor(v, o));
    return v;
}
__device__ __forceinline__ void sincos_d(double a, double& s, double& c) {
    const double k = __builtin_rint(a * 0.63661977236758134308);
    double r = __builtin_fma(-k, 1.57079632679489655800e+00, a);
    r = __builtin_fma(-k, 6.12323399573676603587e-17, r);
    const double r2 = r * r;
    double sp = 1.0 / 6227020800.0; sp = sp * r2 - 1.0 / 39916800.0; sp = sp * r2 + 1.0 / 362880.0; sp = sp * r2 - 1.0 / 5040.0; sp = sp * r2 + 1.0 / 120.0; sp = sp * r2 - 1.0 / 6.0; sp = sp * r2 + 1.0; sp = sp * r;
    double cp = -1.0 / 87178291200.0; cp = cp * r2 + 1.0 / 479001600.0; cp = cp * r2 - 1.0 / 3628800.0; cp = cp * r2 + 1.0 / 40320.0; cp = cp * r2 - 1.0 / 720.0; cp = cp * r2 + 1.0 / 24.0; cp = cp * r2 - 0.5; cp = cp * r2 + 1.0;
    const int q = ((int)k) & 3;
    s = (q == 0) ? sp : (q == 1) ? cp : (q == 2) ? -sp : -cp;
    c = (q == 0) ? cp : (q == 1) ? -sp : (q == 2) ? -cp : sp;
}
__device__ __forceinline__ double exp_d(double x) {
    const double k = __builtin_rint(x * 1.44269504088896340736);
    double r = __builtin_fma(-k, 6.93147180369123816490e-01, x); r = __builtin_fma(-k, 1.90821492927058770002e-10, r);
    double p = 1.0 / 6227020800.0; p = p * r + 1.0 / 479001600.0; p = p * r + 1.0 / 39916800.0; p = p * r + 1.0 / 3628800.0; p = p * r + 1.0 / 362880.0; p = p * r + 1.0 / 40320.0; p = p * r + 1.0 / 5040.0;
    p = p * r + 1.0 / 720.0; p = p * r + 1.0 / 120.0; p = p * r + 1.0 / 24.0; p = p * r + 1.0 / 6.0; p = p * r + 0.5; p = p * r + 1.0; p = p * r + 1.0;
    const long long bits = ((long long)(1023 + (int)k)) << 52;
    return p * __builtin_bit_cast(double, bits);
}
__device__ __forceinline__ float gelu_tanh(float x) {
    const float a = 0.7978845608028654f * (x + 0.044715f * x * x * x);
    const float e = __expf(2.0f * a);
    const float t = 1.0f - 2.0f / (e + 1.0f);
    return 0.5f * x * (1.0f + t);
}
__device__ __forceinline__ float sigmoidf_(float x) { return 1.0f / (1.0f + __expf(-x)); }

__device__ __forceinline__ void p0_transpose_item(const float* W, int K, int N, bf16* WT, LAS float* scr, int item, int lane) {
    const int nblk = N / 32, kb = item / nblk, nb = item % nblk, k0 = 64 * kb, n0 = 32 * nb;
#pragma unroll 8
    for (int i = 0; i < 32; ++i) { const int kk = 2 * i + (lane >> 5); scr[kk * 33 + (lane & 31)] = W[(size_t)(k0 + kk) * N + n0 + (lane & 31)]; }
    LDS_WAIT(); asm volatile("" ::: "memory");
    const int c = lane & 7;
#pragma unroll
    for (int j = 0; j < 4; ++j) { const int n = (lane >> 3) + 8 * j; const LAS float* s = scr + (8 * c) * 33 + n;
        v4u o; o.x = pk2(s[0 * 33], s[1 * 33]); o.y = pk2(s[2 * 33], s[3 * 33]); o.z = pk2(s[4 * 33], s[5 * 33]); o.w = pk2(s[6 * 33], s[7 * 33]);
        *(GAS v4u*)(WT + (size_t)(n0 + n) * K + k0 + 8 * c) = o; }
    LDS_WAIT(); asm volatile("" ::: "memory");
}
__device__ __forceinline__ void rms_row_to_bf16(const float* xrow, const float* g, bf16* orow, int lane) {
    const GAS f32x4* xr = (const GAS f32x4*)xrow + lane;
    f32x4 v[4]; float s = 0.f;
#pragma unroll
    for (int j = 0; j < 4; ++j) { v[j] = xr[64 * j]; s += (v[j].x * v[j].x + v[j].y * v[j].y) + (v[j].z * v[j].z + v[j].w * v[j].w); }
    const float rs = 1.0f / sqrtf(wave_sum(s) * (1.f / 1024.f) + EPS);
    GAS unsigned long long* o8 = (GAS unsigned long long*)orow + lane;
#pragma unroll
    for (int j = 0; j < 4; ++j) { const f32x4 gg = ((const GAS f32x4*)g)[lane + 64 * j];
        o8[64 * j] = (unsigned long long)pk2(v[j].x * rs * gg.x, v[j].y * rs * gg.y) | ((unsigned long long)pk2(v[j].z * rs * gg.z, v[j].w * rs * gg.w) << 32); }
}
__device__ __forceinline__ const float* x_row_ptr(const Frame& F, int r) {
    return r < MP ? F.in[I_XP] + (size_t)r * D : (r < MR ? F.in[I_XS] + (size_t)(r - MP) * D : F.in[I_META] + (size_t)(r - MR) * D);
}
__device__ __forceinline__ void p0_prologue(Frame& F) {
    LAS float* scr = (LAS float*)(F.lds + F.wave * 16384);
    const int gw = F.vcu * NWAVES + F.wave, NGW = F.G * NWAVES;
    constexpr int I_IN = (D / 64) * (DIN / 32), I_GL = (SW / 64) * (SW / 32), I_OU = (D / 64) * (D / 32), I_UP = (D / 64) * (DFF / 32), I_DN = (DFF / 64) * (D / 32);
    constexpr int NITEMS = I_IN + I_GL + I_OU + I_UP + I_DN;
    for (int it = gw; it < NITEMS; it += NGW) {
        int r = it;
        if (r < I_IN) { p0_transpose_item(F.in[I_WIN], D, DIN, (bf16*)(F.ws + WS_WIN), scr, r, F.lane); continue; } r -= I_IN;
        if (r < I_GL) { p0_transpose_item(F.in[I_WGLU], SW, SW, (bf16*)(F.ws + WS_WGLU), scr, r, F.lane); continue; } r -= I_GL;
        if (r < I_OU) { p0_transpose_item(F.in[I_WOUT], D, D, (bf16*)(F.ws + WS_WOUT), scr, r, F.lane); continue; } r -= I_OU;
        if (r < I_UP) { p0_transpose_item(F.in[I_WUP], D, DFF, (bf16*)(F.ws + WS_WUP), scr, r, F.lane); continue; } r -= I_UP;
        p0_transpose_item(F.in[I_WDN], DFF, D, (bf16*)(F.ws + WS_WDN), scr, r, F.lane);
    }
    bf16* XN = (bf16*)(F.ws + WS_XN);
    for (int m = gw; m < MIN_ROWS; m += NGW) {
        if (m < MR + NMETA) rms_row_to_bf16(x_row_ptr(F, m), F.in[I_GPRE], XN + (size_t)m * D, F.lane);
        else { GAS unsigned long long* o8 = (GAS unsigned long long*)(XN + (size_t)m * D) + F.lane;
#pragma unroll
            for (int j = 0; j < 4; ++j) o8[64 * j] = 0ull; }
    }
    const int gt = F.vcu * (NWAVES * 64) + F.tid, NT = F.G * NWAVES * 64;
    float* ropeC = (float*)(F.ws + WS_ROPEC); float* ropeS = (float*)(F.ws + WS_ROPES);
    for (int i = gt; i < NPOS * 8; i += NT) {
        const int idx = i >> 3, fi = i & 7; const int pos = idx < 4112 ? idx : 8192 + (idx - 4112);
        const float inv = (float)exp_d(-(double)fi * 1.640295422175541);
        const float ang = (float)pos * inv;
        double s, c; sincos_d((double)ang, s, c);
        ropeC[i] = (float)c; ropeS[i] = (float)s;
    }
    float* abr = (float*)(F.ws + WS_ABR); float* abi = (float*)(F.ws + WS_ABI); float* bbr = (float*)(F.ws + WS_BBR); float* bbi = (float*)(F.ws + WS_BBI);
    for (int i = gt; i < 2048; i += NT) {
        const int g = i >> 6;
        const double dt = exp_d((double)F.in[I_LDT][g]); const double ar = (double)F.in[I_ARE][i], ai = (double)F.in[I_AIM][i];
        const double mag = exp_d(ar * dt); double s, c; sincos_d(ai * dt, s, c);
        const double are = mag * c, aim = mag * s;
        const double nr = are - 1.0, ni = aim, den = ar * ar + ai * ai;
        const double cr = (nr * ar + ni * ai) / den, ci = (ni * ar - nr * ai) / den;
        abr[i] = (float)are; abi[i] = (float)aim;
        for (int h = 0; h < 16; ++h) { const double br = (double)F.in[I_BRE][i * 16 + h], bi = (double)F.in[I_BIM][i * 16 + h];
            bbr[i * 16 + h] = (float)(cr * br - ci * bi); bbi[i * 16 + h] = (float)(cr * bi + ci * br); }
    }
}
__device__ __forceinline__ int pos_index(int r) { return r < MP ? (r & 4095) + 16 : (r < MR ? 4112 + ((r - MP) & 3) : r - MR); }
__device__ __forceinline__ void p2_rope(Frame& F) {
    const int gt = F.vcu * (NWAVES * 64) + F.tid, NT = F.G * NWAVES * 64;
    bf16* P = (bf16*)(F.ws + WS_P); const float* ropeC = (const float*)(F.ws + WS_ROPEC); const float* ropeS = (const float*)(F.ws + WS_ROPES);
    for (int it = gt; it < (MR + NMETA) * 80; it += NT) {
        const int r = it / 80, rem = it - r * 80, hh = rem >> 3, fi = rem & 7;
        bf16* p = P + (size_t)r * DIN + hh * 64 + fi;
        const float x1 = bf1(p[0]), x2 = bf1(p[8]);
        const int pi = pos_index(r) * 8 + fi; const float c = ropeC[pi], s = ropeS[pi];
        p[0] = (bf16)f2bf(x1 * c - x2 * s); p[8] = (bf16)f2bf(x2 * c + x1 * s);
    }
}
__device__ __forceinline__ void p3_ssm_naive(Frame& F) {
    LAS float* hs = (LAS float*)(F.lds + F.wave * 16384);
    const int gw = F.vcu * NWAVES + F.wave, NGW = F.G * NWAVES, lane = F.lane;
    const bf16* P = (const bf16*)(F.ws + WS_P); bf16* Z = (bf16*)(F.ws + WS_Z);
    const float* abr = (const float*)(F.ws + WS_ABR); const float* abi = (const float*)(F.ws + WS_ABI); const float* bbr = (const float*)(F.ws + WS_BBR); const float* bbi = (const float*)(F.ws + WS_BBI);
    for (int task = gw; task < (4 + 128) * 32; task += NGW) {
        const int seq = task >> 5, g = task & 31, gp = g * 64 + lane;
        const float are = abr[gp], aim = abi[gp];
        float br[16], bi[16];
#pragma unroll
        for (int h = 0; h < 16; ++h) { br[h] = bbr[gp * 16 + h]; bi[h] = bbi[gp * 16 + h]; }
        const int ho = lane & 15, qq = lane >> 4;
        float cr[16], ci[16];
#pragma unroll
        for (int j = 0; j < 16; ++j) { cr[j] = F.in[I_CRE][(g * 16 + ho) * 64 + qq * 16 + j]; ci[j] = F.in[I_CIM][(g * 16 + ho) * 64 + qq * 16 + j]; }
        const float dd = F.in[I_DD][g * 16 + ho];
        float hr, hi; int nsteps;
        if (seq < 4) { hr = 0.f; hi = 0.f; nsteps = 4112; }
        else { const int db = seq - 4; hr = F.in[I_SRE][(db * 32 + g) * 64 + lane]; hi = F.in[I_SIM][(db * 32 + g) * 64 + lane]; nsteps = 4; }
        for (int st = 0; st < nsteps; ++st) {
            int row; bool wr_out;
            if (seq < 4) { if (st < 16) { row = MR + st; wr_out = false; } else { row = seq * 4096 + st - 16; wr_out = true; } }
            else { row = MP + (seq - 4) * 4 + st; wr_out = true; }
            const v4u* up = (const v4u*)(P + (size_t)row * DIN + 768 + g * 16);
            const v4u u0 = up[0], u1 = up[1];
            float u[16];
            u[0] = bflo(u0.x); u[1] = bfhi(u0.x); u[2] = bflo(u0.y); u[3] = bfhi(u0.y); u[4] = bflo(u0.z); u[5] = bfhi(u0.z); u[6] = bflo(u0.w); u[7] = bfhi(u0.w);
            u[8] = bflo(u1.x); u[9] = bfhi(u1.x); u[10] = bflo(u1.y); u[11] = bfhi(u1.y); u[12] = bflo(u1.z); u[13] = bfhi(u1.z); u[14] = bflo(u1.w); u[15] = bfhi(u1.w);
            float bur = 0.f, bui = 0.f;
#pragma unroll
            for (int h = 0; h < 16; ++h) { bur += br[h] * u[h]; bui += bi[h] * u[h]; }
            const float nhr = are * hr - aim * hi + bur, nhi = are * hi + aim * hr + bui;
            hr = nhr; hi = nhi;
            if (wr_out) {
                hs[lane] = hr; hs[64 + lane] = hi;
                LDS_WAIT(); asm volatile("" ::: "memory");
                float y = 0.f;
#pragma unroll
                for (int j = 0; j < 16; ++j) y += cr[j] * hs[qq * 16 + j] - ci[j] * hs[64 + qq * 16 + j];
                y += __shfl_xor(y, 16); y += __shfl_xor(y, 32);
                float uo = u[0];
#pragma unroll
                for (int h = 1; h < 16; ++h) uo = (ho == h) ? u[h] : uo;
                y += dd * uo;
                const float z = gelu_tanh(y);
                if (lane < 16) Z[(size_t)row * SW + g * 16 + ho] = (bf16)f2bf(z);
                LDS_WAIT(); asm volatile("" ::: "memory");
            }
        }
        if (seq < 4) { F.out[O_SRP + (seq * 32 + g) * 64 + lane] = hr; F.out[O_SIP + (seq * 32 + g) * 64 + lane] = hi; }
        else { F.out[O_SRS + ((seq - 4) * 32 + g) * 64 + lane] = hr; F.out[O_SIS + ((seq - 4) * 32 + g) * 64 + lane] = hi; }
    }
}
__device__ __forceinline__ float dot64_bf16(const LAS float* qf, const bf16* kp) {
    float s = 0.f;
#pragma unroll 2
    for (int i = 0; i < 8; ++i) { const v4u k = ((const v4u*)kp)[i]; const f32x4 a = ((const LAS f32x4*)qf)[2 * i], b = ((const LAS f32x4*)qf)[2 * i + 1];
        s += a.x * bflo(k.x) + a.y * bfhi(k.x) + a.z * bflo(k.y) + a.w * bfhi(k.y) + b.x * bflo(k.z) + b.y * bfhi(k.z) + b.z * bflo(k.w) + b.w * bfhi(k.w); }
    return s;
}
__device__ __forceinline__ float dot64_f32(const LAS float* qf, const float* kp) {
    float s = 0.f;
#pragma unroll 2
    for (int i = 0; i < 16; ++i) { const f32x4 k = ((const f32x4*)kp)[i]; const f32x4 a = ((const LAS f32x4*)qf)[i];
        s += a.x * k.x + a.y * k.y + a.z * k.z + a.w * k.w; }
    return s;
}
__device__ __forceinline__ void p3_attn_naive(Frame& F) {
    LAS float* pw = (LAS float*)(F.lds + F.wave * 16384 + 1024);
    LAS float* qf = (LAS float*)(F.lds + F.wave * 16384 + 2048);
    const int gw = F.vcu * NWAVES + F.wave, NGW = F.G * NWAVES, lane = F.lane;
    const bf16* P = (const bf16*)(F.ws + WS_P); bf16* ATT = (bf16*)(F.ws + WS_ATT);
    const float NEG = -1e30f;
#pragma unroll 1
    for (int task = gw; task < MR * 8; task += NGW) {
        const int r = task >> 3, h = task & 7, kvh = h >> 2;
        qf[lane] = bf1(P[(size_t)r * DIN + h * 64 + lane]);
        LDS_WAIT(); asm volatile("" ::: "memory");
        const float sink = F.in[I_SINK][h];
        float l0, l1, l2 = NEG; bool v0, v1, v2 = false;
        if (r < MP) {
            const int b = r >> 12, s = r & 4095, pos = s + 16;
            const int kp0 = pos - 127 + lane, kp1 = kp0 + 64;
            v0 = kp0 >= 0; v1 = kp1 >= 0;
            const int kr0 = kp0 >= 16 ? b * 4096 + kp0 - 16 : MR + (kp0 < 0 ? 0 : kp0);
            const int kr1 = kp1 >= 16 ? b * 4096 + kp1 - 16 : MR + (kp1 < 0 ? 0 : kp1);
            l0 = dot64_bf16(qf, P + (size_t)kr0 * DIN + 512 + kvh * 64) * 0.125f;
            l1 = dot64_bf16(qf, P + (size_t)kr1 * DIN + 512 + kvh * 64) * 0.125f;
        } else {
            const int db = (r - MP) >> 2, t = (r - MP) & 3;
            v0 = lane >= t + 1; v1 = true;
            l0 = dot64_f32(qf, F.in[I_CK] + ((size_t)(db * 128 + lane) * 2 + kvh) * 64) * 0.125f;
            l1 = dot64_f32(qf, F.in[I_CK] + ((size_t)(db * 128 + lane + 64) * 2 + kvh) * 64) * 0.125f;
            v2 = lane <= t;
            const int tr = lane < 4 ? lane : 0;
            l2 = dot64_bf16(qf, P + (size_t)(MP + db * 4 + tr) * DIN + 512 + kvh * 64) * 0.125f;
        }
        l0 = v0 ? l0 : NEG; l1 = v1 ? l1 : NEG; l2 = v2 ? l2 : NEG;
        float m = wave_max(fmaxf(fmaxf(l0, l1), l2)); m = fmaxf(m, sink);
        const float e0 = v0 ? __expf(l0 - m) : 0.f, e1 = v1 ? __expf(l1 - m) : 0.f, e2 = v2 ? __expf(l2 - m) : 0.f;
        const float den = wave_sum(e0 + e1 + e2) + __expf(sink - m);
        const float inv = 1.0f / den;
        pw[lane] = e0 * inv; pw[64 + lane] = e1 * inv; pw[128 + lane] = e2 * inv;
        LDS_WAIT(); asm volatile("" ::: "memory");
        float o = 0.f;
        if (r < MP) {
            const int b = r >> 12, s = r & 4095, pos = s + 16;
#pragma unroll 1
            for (int j = 0; j < 128; ++j) { const int kp = pos - 127 + j; if (kp < 0) continue;
                const int kr = kp >= 16 ? b * 4096 + kp - 16 : MR + kp;
                o += pw[j] * bf1(P[(size_t)kr * DIN + 640 + kvh * 64 + lane]); }
        } else {
            const int db = (r - MP) >> 2, t = (r - MP) & 3;
#pragma unroll 1
            for (int j = t + 1; j < 128; ++j) o += pw[j] * F.in[I_CV][((size_t)(db * 128 + j) * 2 + kvh) * 64 + lane];
#pragma unroll 1
            for (int j = 0; j <= t; ++j) o += pw[128 + j] * bf1(P[(size_t)(MP + db * 4 + j) * DIN + 640 + kvh * 64 + lane]);
        }
        ATT[(size_t)r * AW + h * 64 + lane] = (bf16)f2bf(o);
        LDS_WAIT(); asm volatile("" ::: "memory");
    }
}
__device__ __forceinline__ void p3_windows(Frame& F) {
    const int gt = F.vcu * (NWAVES * 64) + F.tid, NT = F.G * NWAVES * 64;
    const bf16* P = (const bf16*)(F.ws + WS_P);
    for (int e = gt; e < 65536; e += NT) { const int b = e >> 14, j = (e >> 7) & 127, c = e & 127; const size_t base = (size_t)(b * 4096 + 3968 + j) * DIN;
        F.out[O_KP + e] = bf1(P[base + 512 + c]); F.out[O_VP + e] = bf1(P[base + 640 + c]); }
    for (int e = gt; e < 2097152; e += NT) { const int db = e >> 14, j = (e >> 7) & 127, c = e & 127;
        float kv, vv;
        if (j < 124) { kv = F.in[I_CK][(size_t)(db * 128 + j + 4) * 128 + c]; vv = F.in[I_CV][(size_t)(db * 128 + j + 4) * 128 + c]; }
        else { const size_t base = (size_t)(MP + db * 4 + j - 124) * DIN; kv = bf1(P[base + 512 + c]); vv = bf1(P[base + 640 + c]); }
        F.out[O_KS + e] = kv; F.out[O_VS + e] = vv; }
}
__device__ __forceinline__ void unpack8(const v4u w, float (&f)[8]) { f[0] = bflo(w.x); f[1] = bfhi(w.x); f[2] = bflo(w.y); f[3] = bfhi(w.y); f[4] = bflo(w.z); f[5] = bfhi(w.z); f[6] = bflo(w.w); f[7] = bfhi(w.w); }
__device__ __forceinline__ v4u pack8(const float (&f)[8]) { v4u w; w.x = pk2(f[0], f[1]); w.y = pk2(f[2], f[3]); w.z = pk2(f[4], f[5]); w.w = pk2(f[6], f[7]); return w; }
__device__ __forceinline__ void p5_mixnorm(Frame& F) {
    const int gw = F.vcu * NWAVES + F.wave, NGW = F.G * NWAVES, lane = F.lane;
    const bf16* ATT = (const bf16*)(F.ws + WS_ATT); const bf16* Z = (const bf16*)(F.ws + WS_Z); const bf16* GL = (const bf16*)(F.ws + WS_GL); bf16* CAT = (bf16*)(F.ws + WS_CAT);
    for (int r = gw; r < MR; r += NGW) {
        float a[8], z[8], gt[8], o[8];
        unpack8(*(const v4u*)(ATT + (size_t)r * AW + lane * 8), a); unpack8(*(const v4u*)(Z + (size_t)r * SW + lane * 8), z); unpack8(*(const v4u*)(GL + (size_t)r * SW + lane * 8), gt);
        float sa = 0.f, so = 0.f;
#pragma unroll
        for (int i = 0; i < 8; ++i) { o[i] = z[i] * sigmoidf_(gt[i]); sa += a[i] * a[i]; so += o[i] * o[i]; }
        const float ra = 1.0f / sqrtf(wave_sum(sa) * (1.f / 512.f) + EPS), ro = 1.0f / sqrtf(wave_sum(so) * (1.f / 512.f) + EPS);
#pragma unroll
        for (int i = 0; i < 8; ++i) { a[i] = a[i] * ra * F.in[I_GATT][lane * 8 + i]; o[i] = o[i] * ro * F.in[I_GSSM][lane * 8 + i]; }
        *(v4u*)(CAT + (size_t)r * D + lane * 8) = pack8(a); *(v4u*)(CAT + (size_t)r * D + 512 + lane * 8) = pack8(o);
    }
}
__device__ __forceinline__ void p7_mid(Frame& F) {
    const int gw = F.vcu * NWAVES + F.wave, NGW = F.G * NWAVES, lane = F.lane;
    const bf16* O1 = (const bf16*)(F.ws + WS_O); bf16* XN2 = (bf16*)(F.ws + WS_XN);
    for (int r = gw; r < MR; r += NGW) {
        float o[16], x[16];
        { float t[8]; unpack8(*(const v4u*)(O1 + (size_t)r * D + lane * 8), t);
#pragma unroll
          for (int i = 0; i < 8; ++i) o[i] = t[i];
          unpack8(*(const v4u*)(O1 + (size_t)r * D + 512 + lane * 8), t);
#pragma unroll
          for (int i = 0; i < 8; ++i) o[8 + i] = t[i]; }
        const float* xr = x_row_ptr(F, r);
#pragma unroll
        for (int hf = 0; hf < 2; ++hf) { const f32x4 a = *(const f32x4*)(xr + hf * 512 + lane * 8), b = *(const f32x4*)(xr + hf * 512 + lane * 8 + 4);
            x[hf * 8 + 0] = a.x; x[hf * 8 + 1] = a.y; x[hf * 8 + 2] = a.z; x[hf * 8 + 3] = a.w; x[hf * 8 + 4] = b.x; x[hf * 8 + 5] = b.y; x[hf * 8 + 6] = b.z; x[hf * 8 + 7] = b.w; }
        float ss = 0.f;
#pragma unroll
        for (int i = 0; i < 16; ++i) ss += o[i] * o[i];
        const float r1 = 1.0f / sqrtf(wave_sum(ss) * (1.f / 1024.f) + EPS);
        float s2 = 0.f;
#pragma unroll
        for (int i = 0; i < 16; ++i) { const int col = (i >> 3) * 512 + lane * 8 + (i & 7); x[i] = x[i] + o[i] * r1 * F.in[I_GPOST][col]; s2 += x[i] * x[i]; }
        const float r2 = 1.0f / sqrtf(wave_sum(s2) * (1.f / 1024.f) + EPS);
        float* yo = F.out + (size_t)r * D;
#pragma unroll
        for (int hf = 0; hf < 2; ++hf) {
            *(f32x4*)(yo + hf * 512 + lane * 8) = (f32x4){x[hf * 8 + 0], x[hf * 8 + 1], x[hf * 8 + 2], x[hf * 8 + 3]};
            *(f32x4*)(yo + hf * 512 + lane * 8 + 4) = (f32x4){x[hf * 8 + 4], x[hf * 8 + 5], x[hf * 8 + 6], x[hf * 8 + 7]};
            float n[8];
#pragma unroll
            for (int i = 0; i < 8; ++i) n[i] = x[hf * 8 + i] * r2 * F.in[I_GMLP][hf * 512 + lane * 8 + i];
            *(v4u*)(XN2 + (size_t)r * D + hf * 512 + lane * 8) = pack8(n);
        }
    }
}
__device__ __forceinline__ void p10_final(Frame& F) {
    const int gw = F.vcu * NWAVES + F.wave, NGW = F.G * NWAVES, lane = F.lane;
    const bf16* O2 = (const bf16*)(F.ws + WS_O);
    for (int r = gw; r < MR; r += NGW) {
        float o[16];
        { float t[8]; unpack8(*(const v4u*)(O2 + (size_t)r * D + lane * 8), t);
#pragma unroll
          for (int i = 0; i < 8; ++i) o[i] = t[i];
          unpack8(*(const v4u*)(O2 + (size_t)r * D + 512 + lane * 8), t);
#pragma unroll
          for (int i = 0; i < 8; ++i) o[8 + i] = t[i]; }
        float ss = 0.f;
#pragma unroll
        for (int i = 0; i < 16; ++i) ss += o[i] * o[i];
        const float r1 = 1.0f / sqrtf(wave_sum(ss) * (1.f / 1024.f) + EPS);
        float* yo = F.out + (size_t)r * D;
#pragma unroll
        for (int hf = 0; hf < 2; ++hf) {
            f32x4 a = *(const f32x4*)(yo + hf * 512 + lane * 8), b = *(const f32x4*)(yo + hf * 512 + lane * 8 + 4);
            const float* g = F.in[I_GMLPP] + hf * 512 + lane * 8;
            a.x += o[hf * 8 + 0] * r1 * g[0]; a.y += o[hf * 8 + 1] * r1 * g[1]; a.z += o[hf * 8 + 2] * r1 * g[2]; a.w += o[hf * 8 + 3] * r1 * g[3];
            b.x += o[hf * 8 + 4] * r1 * g[4]; b.y += o[hf * 8 + 5] * r1 * g[5]; b.z += o[hf * 8 + 6] * r1 * g[6]; b.w += o[hf * 8 + 7] * r1 * g[7];
            *(f32x4*)(yo + hf * 512 + lane * 8) = a; *(f32x4*)(yo + hf * 512 + lane * 8 + 4) = b;
        }
    }
}

typedef short bf16x8 __attribute__((ext_vector_type(8)));
constexpr int KC_PER_G = 33 * 256;
struct ZohD { double adt_r, adt_i, cr, ci; };
__device__ __forceinline__ ZohD zoh_d(const Frame& F, int gp) {
    const int g = gp >> 6;
    const double dt = exp_d((double)F.in[I_LDT][g]); const double ar = (double)F.in[I_ARE][gp], ai = (double)F.in[I_AIM][gp];
    ZohD z; z.adt_r = ar * dt; z.adt_i = ai * dt;
    const double mag = exp_d(z.adt_r); double s, c; sincos_d(z.adt_i, s, c);
    const double nr = mag * c - 1.0, ni = mag * s, den = ar * ar + ai * ai;
    z.cr = (nr * ar + ni * ai) / den; z.ci = (ni * ar - nr * ai) / den; return z;
}
__device__ __forceinline__ void abar_pow(const ZohD& z, int m, double& wr, double& wi) { const double mag = exp_d(z.adt_r * (double)m); double s, c; sincos_d(z.adt_i * (double)m, s, c); wr = mag * c; wi = mag * s; }

__device__ __forceinline__ void p0_ssm_tables(Frame& F) {
    const int gt = F.vcu * (NWAVES * 64) + F.tid, NT = F.G * NWAVES * 64;
    bf16* VT = (bf16*)(F.ws + WS_VT); bf16* QT = (bf16*)(F.ws + WS_QT); bf16* KC = (bf16*)(F.ws + WS_KC); float* A32 = (float*)(F.ws + WS_A32);
    for (int i = gt; i < 2048; i += NT) { const ZohD z = zoh_d(F, i); double wr, wi; abar_pow(z, 32, wr, wi); A32[2 * i] = (float)wr; A32[2 * i + 1] = (float)wi; }
    for (int it = gt; it < 65536; it += NT) {
        const int gp = it >> 5, s = it & 31, g = gp >> 6, p = gp & 63;
        const ZohD z = zoh_d(F, gp); double wr, wi; abar_pow(z, 31 - s, wr, wi);
        const float er = (float)(wr * z.cr - wi * z.ci), ei = (float)(wr * z.ci + wi * z.cr);
        float re[16], im[16];
#pragma unroll
        for (int h = 0; h < 16; ++h) { const float br = F.in[I_BRE][gp * 16 + h], bi = F.in[I_BIM][gp * 16 + h]; re[h] = er * br - ei * bi; im[h] = er * bi + ei * br; }
        bf16* d0 = VT + (size_t)g * 65536 + (size_t)(2 * p) * 512 + 16 * s; bf16* d1 = d0 + 512;
        v4u w;
        w.x = pk2(re[0], re[1]); w.y = pk2(re[2], re[3]); w.z = pk2(re[4], re[5]); w.w = pk2(re[6], re[7]); ((v4u*)d0)[0] = w;
        w.x = pk2(re[8], re[9]); w.y = pk2(re[10], re[11]); w.z = pk2(re[12], re[13]); w.w = pk2(re[14], re[15]); ((v4u*)d0)[1] = w;
        w.x = pk2(im[0], im[1]); w.y = pk2(im[2], im[3]); w.z = pk2(im[4], im[5]); w.w = pk2(im[6], im[7]); ((v4u*)d1)[0] = w;
        w.x = pk2(im[8], im[9]); w.y = pk2(im[10], im[11]); w.z = pk2(im[12], im[13]); w.w = pk2(im[14], im[15]); ((v4u*)d1)[1] = w;
    }
    for (int it = gt; it < 65536; it += NT) {
        const int gp = it >> 5, t = it & 31, g = gp >> 6, p = gp & 63;
        const ZohD z = zoh_d(F, gp); double wrd, wid; abar_pow(z, t + 1, wrd, wid); const float wr = (float)wrd, wi = (float)wid;
        unsigned* d = (unsigned*)(QT + (size_t)g * 65536 + (size_t)(16 * t) * 128 + 2 * p);
#pragma unroll
        for (int ho = 0; ho < 16; ++ho) { const float cr = F.in[I_CRE][(g * 16 + ho) * 64 + p], ci = F.in[I_CIM][(g * 16 + ho) * 64 + p];
            d[ho * 64] = pk2(cr * wr - ci * wi, -(cr * wi + ci * wr)); }
    }
    LAS float* E = (LAS float*)(F.lds + 131072);
    for (int bt = F.vcu; bt < 1024; bt += F.G) {
        const int g = bt >> 5, tau = bt & 31;
        if (F.tid < 64) { const int gp = g * 64 + F.tid; const ZohD z = zoh_d(F, gp); double wr, wi; abar_pow(z, tau, wr, wi);
            E[F.tid] = (float)(wr * z.cr - wi * z.ci); E[64 + F.tid] = (float)(wr * z.ci + wi * z.cr); }
        __syncthreads();
        if (F.tid < 256) { const int ho = F.tid >> 4, hi = F.tid & 15; float acc = 0.f;
            for (int p = 0; p < 64; ++p) { const float cr = F.in[I_CRE][(g * 16 + ho) * 64 + p], ci = F.in[I_CIM][(g * 16 + ho) * 64 + p];
                const float br = F.in[I_BRE][(g * 64 + p) * 16 + hi], bi = F.in[I_BIM][(g * 64 + p) * 16 + hi];
                const float er = E[p], ei = E[64 + p];
                acc += cr * (er * br - ei * bi) - ci * (er * bi + ei * br); }
            if (tau == 0 && ho == hi) acc += F.in[I_DD][g * 16 + ho];
            KC[(size_t)g * KC_PER_G + (tau + 1) * 256 + F.tid] = (bf16)f2bf(acc);
        } else if (tau == 0) { KC[(size_t)g * KC_PER_G + (F.tid - 256)] = (bf16)0; }
        __syncthreads();
    }
}
__device__ __forceinline__ void stage_rows(LAS unsigned char* dst, const unsigned char* src, int nrows, int cshift, int dst_stride, int tid) {
    const int total = nrows << cshift;
    for (int c = tid; c < total; c += NWAVES * 64) { const int row = c >> cshift, col = c & ((1 << cshift) - 1);
        const v4u v = *(const v4u*)(src + ((size_t)c << 4)); *(LAS v4u*)(dst + row * dst_stride + col * 16) = v; }
}
#define MFMA16(a, b, c) __builtin_amdgcn_mfma_f32_16x16x32_bf16((a), (b), (c), 0, 0, 0)
constexpr int VT_STRIDE = 1040, QT_STRIDE = 272, LDS_KC_OFF = 512 * QT_STRIDE;
static_assert(LDS_KC_OFF + KC_PER_G * 2 <= LDSCTL_OFF && 128 * VT_STRIDE <= LDSCTL_OFF, "SSM LDS images");
__device__ __forceinline__ void s1_hloc(Frame& F) {
    const bf16* P = (const bf16*)(F.ws + WS_P); const bf16* VT = (const bf16*)(F.ws + WS_VT); float* HL = (float*)(F.ws + WS_HL);
    const int lane = F.lane;
    for (int bt = F.vcu; bt < 256; bt += F.G) {
        const int g = bt >> 3, sub = bt & 7;
        __syncthreads();
        stage_rows(F.lds, (const unsigned char*)(VT + (size_t)g * 65536), 128, 6, VT_STRIDE, F.tid);
        __syncthreads();
        const int ntile = 4 * sub + (F.wave >> 1), half = F.wave & 1;
        const int n = ntile * 16 + (lane & 15), b = n >> 7, c = n & 127, row0 = b * 4096 + 32 * c;
        const bf16* up = P + (size_t)(row0 + (lane >> 5)) * DIN + 768 + g * 16 + 8 * ((lane >> 4) & 1);
        bf16x8 U[16];
#pragma unroll
        for (int ks = 0; ks < 16; ++ks) U[ks] = *(const bf16x8*)(up + (size_t)(2 * ks) * DIN);
#pragma unroll
        for (int mi = 0; mi < 4; ++mi) {
            const int mf = 4 * half + mi;
            const LAS unsigned char* ap = F.lds + (16 * mf + (lane & 15)) * VT_STRIDE + 16 * (lane >> 4);
            f32x4 acc = (f32x4){0.f, 0.f, 0.f, 0.f};
#pragma unroll
            for (int ks = 0; ks < 16; ++ks) acc = MFMA16(*(const LAS bf16x8*)(ap + 64 * ks), U[ks], acc);
            *(f32x4*)(HL + ((size_t)n * 32 + g) * 128 + 16 * mf + 4 * (lane >> 4)) = acc;
        }
    }
}
__device__ __forceinline__ void s1_small_seqs(Frame& F) {
    LAS float* hs = (LAS float*)(F.lds + 133120 + F.wave * 512);
    const int gw = F.vcu * NWAVES + F.wave, NGW = F.G * NWAVES, lane = F.lane;
    const bf16* P = (const bf16*)(F.ws + WS_P); bf16* Z = (bf16*)(F.ws + WS_Z); float* HM = (float*)(F.ws + WS_HM);
    const float* abr = (const float*)(F.ws + WS_ABR); const float* abi = (const float*)(F.ws + WS_ABI); const float* bbr = (const float*)(F.ws + WS_BBR); const float* bbi = (const float*)(F.ws + WS_BBI);
#pragma unroll 1
    for (int task = gw; task < 32 + 128 * 32; task += NGW) {
        const bool meta = task < 32; const int g = meta ? task : ((task - 32) & 31), db = meta ? 0 : ((task - 32) >> 5), gp = g * 64 + lane;
        const float are = abr[gp], aim = abi[gp];
        float br[16], bi[16];
#pragma unroll
        for (int h = 0; h < 16; ++h) { br[h] = bbr[gp * 16 + h]; bi[h] = bbi[gp * 16 + h]; }
        const int ho = lane & 15, qq = lane >> 4;
        float cr[16], ci[16];
#pragma unroll
        for (int j = 0; j < 16; ++j) { cr[j] = F.in[I_CRE][(g * 16 + ho) * 64 + qq * 16 + j]; ci[j] = F.in[I_CIM][(g * 16 + ho) * 64 + qq * 16 + j]; }
        const float dd = F.in[I_DD][g * 16 + ho];
        float hr = 0.f, hi = 0.f;
        if (!meta) { hr = F.in[I_SRE][(db * 32 + g) * 64 + lane]; hi = F.in[I_SIM][(db * 32 + g) * 64 + lane]; }
        const int nsteps = meta ? 16 : 4;
#pragma unroll 1
        for (int st = 0; st < nsteps; ++st) {
            const int row = meta ? MR + st : MP + db * 4 + st;
            const v4u* up = (const v4u*)(P + (size_t)row * DIN + 768 + g * 16);
            const v4u u0 = up[0], u1 = up[1];
            float u[16];
            u[0] = bflo(u0.x); u[1] = bfhi(u0.x); u[2] = bflo(u0.y); u[3] = bfhi(u0.y); u[4] = bflo(u0.z); u[5] = bfhi(u0.z); u[6] = bflo(u0.w); u[7] = bfhi(u0.w);
            u[8] = bflo(u1.x); u[9] = bfhi(u1.x); u[10] = bflo(u1.y); u[11] = bfhi(u1.y); u[12] = bflo(u1.z); u[13] = bfhi(u1.z); u[14] = bflo(u1.w); u[15] = bfhi(u1.w);
            float bur = 0.f, bui = 0.f;
#pragma unroll
            for (int h = 0; h < 16; ++h) { bur += br[h] * u[h]; bui += bi[h] * u[h]; }
            const float nhr = are * hr - aim * hi + bur, nhi = are * hi + aim * hr + bui;
            hr = nhr; hi = nhi;
            if (!meta) {
                hs[lane] = hr; hs[64 + lane] = hi;
                LDS_WAIT(); asm volatile("" ::: "memory");
                float y = 0.f;
#pragma unroll
                for (int j = 0; j < 16; ++j) y += cr[j] * hs[qq * 16 + j] - ci[j] * hs[64 + qq * 16 + j];
                y += __shfl_xor(y, 16); y += __shfl_xor(y, 32);
                float uo = u[0];
#pragma unroll
                for (int h = 1; h < 16; ++h) uo = (ho == h) ? u[h] : uo;
                y += dd * uo;
                const float z = gelu_tanh(y);
                if (lane < 16) Z[(size_t)row * SW + g * 16 + ho] = (bf16)f2bf(z);
                LDS_WAIT(); asm volatile("" ::: "memory");
            }
        }
        if (meta) { HM[g * 128 + 2 * lane] = hr; HM[g * 128 + 2 * lane + 1] = hi; }
        else { F.out[O_SRS + (db * 32 + g) * 64 + lane] = hr; F.out[O_SIS + (db * 32 + g) * 64 + lane] = hi; }
    }
}
__device__ __forceinline__ void s2_scan(Frame& F) {
    const int gt = F.vcu * (NWAVES * 64) + F.tid;
    if (gt < 8192) {
        const int b = gt >> 11, gp = gt & 2047, g = gp >> 6, p = gp & 63;
        const float* A32 = (const float*)(F.ws + WS_A32); const float* HM = (const float*)(F.ws + WS_HM);
        const float ar = A32[2 * gp], ai = A32[2 * gp + 1];
        float hr = HM[g * 128 + 2 * p], hi = HM[g * 128 + 2 * p + 1];
        const float* hl = (const float*)(F.ws + WS_HL) + ((size_t)(b * 128) * 32 + g) * 128 + 2 * p;
        unsigned* hin = (unsigned*)((bf16*)(F.ws + WS_HIN) + ((size_t)(b * 128) * 32 + g) * 128 + 2 * p);
#pragma unroll 1
        for (int c0 = 0; c0 < 128; c0 += 16) {
            float vr[16], vi[16];
#pragma unroll
            for (int j = 0; j < 16; ++j) { const float* q = hl + (size_t)(c0 + j) * 4096; vr[j] = q[0]; vi[j] = q[1]; }
#pragma unroll
            for (int j = 0; j < 16; ++j) { hin[(size_t)(c0 + j) * 2048] = pk2(hr, hi);
                const float nr = ar * hr - ai * hi + vr[j], ni = ar * hi + ai * hr + vi[j]; hr = nr; hi = ni; }
        }
        F.out[O_SRP + (b * 32 + g) * 64 + p] = hr; F.out[O_SIP + (b * 32 + g) * 64 + p] = hi;
    }
}
__device__ __forceinline__ void s3_y(Frame& F) {
    const bf16* P = (const bf16*)(F.ws + WS_P); const bf16* QT = (const bf16*)(F.ws + WS_QT); const bf16* KC = (const bf16*)(F.ws + WS_KC); const bf16* HIN = (const bf16*)(F.ws + WS_HIN); bf16* Z = (bf16*)(F.ws + WS_Z);
    const int lane = F.lane;
    for (int bt = F.vcu; bt < 256; bt += F.G) {
        const int g = bt >> 3, sub = bt & 7;
        __syncthreads();
        stage_rows(F.lds, (const unsigned char*)(QT + (size_t)g * 65536), 512, 4, QT_STRIDE, F.tid);
        stage_rows(F.lds + LDS_KC_OFF, (const unsigned char*)(KC + (size_t)g * KC_PER_G), 33, 5, 512, F.tid);
        __syncthreads();
        const int ntile = 4 * sub + (F.wave >> 1), half = F.wave & 1;
        const int n = ntile * 16 + (lane & 15), b = n >> 7, c = n & 127, row0 = b * 4096 + 32 * c;
        const bf16* up = P + (size_t)(row0 + (lane >> 5)) * DIN + 768 + g * 16 + 8 * ((lane >> 4) & 1);
        bf16x8 U[16], H[4];
#pragma unroll
        for (int ks = 0; ks < 16; ++ks) U[ks] = *(const bf16x8*)(up + (size_t)(2 * ks) * DIN);
        const bf16* hp = HIN + ((size_t)n * 32 + g) * 128 + 8 * (lane >> 4);
#pragma unroll
        for (int kk = 0; kk < 4; ++kk) H[kk] = *(const bf16x8*)(hp + 32 * kk);
        const LAS unsigned char* qp = F.lds + (16 * half + (lane & 15)) * QT_STRIDE + 16 * (lane >> 4);
        const LAS unsigned char* kp = F.lds + LDS_KC_OFF + (half - (lane >> 5) + 1) * 512 + (lane & 15) * 32 + 16 * ((lane >> 4) & 1);
        bf16* zp = Z + (size_t)(row0 + half) * SW + g * 16 + 4 * (lane >> 4);
#pragma unroll
        for (int i = 0; i < 16; ++i) {
            f32x4 acc = (f32x4){0.f, 0.f, 0.f, 0.f};
#pragma unroll
            for (int kk = 0; kk < 4; ++kk) acc = MFMA16(*(const LAS bf16x8*)(qp + i * 32 * QT_STRIDE + kk * 64), H[kk], acc);
#pragma unroll
            for (int ks = 0; ks < 16; ++ks) if (ks <= i) acc = MFMA16(*(const LAS bf16x8*)(kp + (2 * i - 2 * ks) * 512), U[ks], acc);
            v2u w; w.x = pk2(gelu_tanh(acc[0]), gelu_tanh(acc[1])); w.y = pk2(gelu_tanh(acc[2]), gelu_tanh(acc[3]));
            *(v2u*)(zp + (size_t)(2 * i) * SW) = w;
        }
    }
}
#ifndef MK_N_LAUNCHES
#define MK_N_LAUNCHES 1
#endif
constexpr int N_PHASES = 13;
struct Args { const float* in[27]; float* out; unsigned char* ws; int ph_lo, ph_hi; };
__global__ void __launch_bounds__(NWAVES * 64, 2) hymba_fwd(Args args) {
    extern __shared__ __attribute__((aligned(16))) unsigned char lds[];
    Frame F;
    F.lds = (LAS unsigned char*)lds;
    F.MISC = (volatile LAS unsigned*)(F.lds + MISC_OFF);
    F.tid = threadIdx.x; F.lane = F.tid & 63; F.wave = __builtin_amdgcn_readfirstlane(F.tid >> 6);
    F.G = gridDim.x; { const int bx = blockIdx.x; F.vcu = (F.G % 8 == 0) ? (bx % 8) * (F.G / 8) + bx / 8 : bx; }
#pragma unroll
    for (int i = 0; i < 27; ++i) F.in[i] = args.in[i];
    F.out = args.out; F.ws = args.ws; F.ctl = (gu32*)(args.ws + WS_CTL);
    for (int u = F.tid; u < (LDS_BYTES - LDSCTL_OFF) / 4; u += NWAVES * 64) ((LAS unsigned*)(F.lds + LDSCTL_OFF))[u] = 0u;
    __syncthreads();
    const int lo = args.ph_lo, hi = args.ph_hi;
    const bool one = (hi - lo) > 1;
    XcdBarrier bar; bar.bar = (unsigned*)(F.ctl + CW_BAR); bar.x = 0; bar.st = nullptr;
    if (one) bar = xcd_barrier_post((unsigned*)(F.ctl + CW_BAR), F.MISC + 8);
#define IN(k) (lo <= (k) && (k) < hi)
#define SEAM(k) do { if (IN(k) && IN((k) + 1)) xcd_barrier(bar); } while (0)
    bf16* const XN = (bf16*)(F.ws + WS_XN); bf16* const OB = (bf16*)(F.ws + WS_O); bf16* const PB = (bf16*)(F.ws + WS_P);
    if (IN(0)) { p0_prologue(F); p0_ssm_tables(F); } SEAM(0);
    if (IN(1)) { pg8::Gemm g{XN, (const bf16*)(F.ws + WS_WIN), MIN_ROWS, DIN, D}; pg8::StaticOrder S; S.init(MIN_ROWS, DIN, F.G, (int)blockIdx.x);
        pg8::EpiBf16<0> E{PB, DIN}; pg8::gemm_phase<pg8::EpiBf16<0>, pg8::StaticOrder, true, true>(F.lds, g, S, E); } SEAM(1);
    if (IN(2)) { p2_rope(F); } SEAM(2);
    if (IN(3)) { s1_hloc(F); __syncthreads(); s1_small_seqs(F); p3_attn_naive(F); p3_windows(F); } SEAM(3);
    if (IN(4)) { s2_scan(F); } SEAM(4);
    if (IN(5)) { s3_y(F); } SEAM(5);
    if (IN(6)) { pg8::Gemm g{(const bf16*)(F.ws + WS_Z), (const bf16*)(F.ws + WS_WGLU), MR, SW, SW}; pg8::StaticOrder S; S.init(MR, SW, F.G, (int)blockIdx.x);
        pg8::EpiBf16<0> E{(bf16*)(F.ws + WS_GL), SW}; pg8::gemm_phase<pg8::EpiBf16<0>, pg8::StaticOrder, true, true>(F.lds, g, S, E); } SEAM(6);
    if (IN(7)) { p5_mixnorm(F); } SEAM(7);
    if (IN(8)) { pg8::Gemm g{(const bf16*)(F.ws + WS_CAT), (const bf16*)(F.ws + WS_WOUT), MR, D, D}; pg8::StaticOrder S; S.init(MR, D, F.G, (int)blockIdx.x);
        pg8::EpiBf16<0> E{OB, D}; pg8::gemm_phase<pg8::EpiBf16<0>, pg8::StaticOrder, true, true>(F.lds, g, S, E); } SEAM(8);
    if (IN(9)) { p7_mid(F); } SEAM(9);
    if (IN(10)) { pg8::Gemm g{XN, (const bf16*)(F.ws + WS_WUP), MR, DFF, D}; pg8::StaticOrder S; S.init(MR, DFF, F.G, (int)blockIdx.x);
        pg8::EpiBf16<2> E{(bf16*)(F.ws + WS_H), DFF}; pg8::gemm_phase<pg8::EpiBf16<2>, pg8::StaticOrder, true, true>(F.lds, g, S, E); } SEAM(10);
    if (IN(11)) { pg8::Gemm g{(const bf16*)(F.ws + WS_H), (const bf16*)(F.ws + WS_WDN), MR, D, DFF}; pg8::StaticOrder S; S.init(MR, D, F.G, (int)blockIdx.x);
        pg8::EpiBf16<0> E{OB, D}; pg8::gemm_phase<pg8::EpiBf16<0>, pg8::StaticOrder, true, true>(F.lds, g, S, E); } SEAM(11);
    if (IN(12)) { p10_final(F); }
#undef IN
#undef SEAM
}

extern "C" void kernel_launch(void* const* d_in, const int* in_sizes, int n_in, void* d_out, int out_size, void* d_ws, size_t ws_size, hipStream_t stream) {
    static int grid = 0;
    if (grid == 0) {
        if (n_in != 27 || ws_size < WS_TOP) { fprintf(stderr, "kernel_launch: unexpected n_in %d / ws %zu\n", n_in, ws_size); grid = -1; return; }
        int dev = 0, cus = 0, per_cu = 0;
        if (hipGetDevice(&dev) != hipSuccess || hipDeviceGetAttribute(&cus, hipDeviceAttributeMultiprocessorCount, dev) != hipSuccess) { grid = -1; return; }
        if (hipFuncSetAttribute((const void*)hymba_fwd, hipFuncAttributeMaxDynamicSharedMemorySize, LDS_BYTES) != hipSuccess) { fprintf(stderr, "kernel_launch: hipFuncSetAttribute failed\n"); grid = -1; return; }
        if (hipOccupancyMaxActiveBlocksPerMultiprocessor(&per_cu, (const void*)hymba_fwd, NWAVES * 64, LDS_BYTES) != hipSuccess || per_cu < 1) { fprintf(stderr, "kernel_launch: occupancy query says %d\n", per_cu); per_cu = 1; }
        (void)hipGetLastError();
        grid = cus;
    }
    if (grid < 0) return;
    (void)hipMemsetAsync((char*)d_ws + WS_CTL, 0, CTL_ZERO_BYTES, stream);
    Args a{};
    for (int i = 0; i < 27; ++i) a.in[i] = (const float*)d_in[i];
    a.out = (float*)d_out; a.ws = (unsigned char*)d_ws;
#if MK_N_LAUNCHES == 1
    a.ph_lo = 0; a.ph_hi = N_PHASES;
    void* kargs[] = {&a};
    hipError_t e = hipLaunchCooperativeKernel((const void*)hymba_fwd, dim3(grid), dim3(NWAVES * 64), kargs, LDS_BYTES, stream);
    if (e != hipSuccess) fprintf(stderr, "kernel_launch: cooperative launch failed: %s (grid %d)\n", hipGetErrorString(e), grid);
#else
    for (int p = 0; p < N_PHASES; ++p) { a.ph_lo = p; a.ph_hi = p + 1; hipLaunchKernelGGL(hymba_fwd, dim3(grid), dim3(NWAVES * 64), LDS_BYTES, stream, a); }
#endif
}
```

```cpp
#include <hip/hip_runtime.h>
#include <cstdio>
#include <cstdint>
namespace pg8 {
#define PG8_LAS __attribute__((address_space(3)))
typedef unsigned short bf16_t;
typedef short bf16x8 __attribute__((ext_vector_type(8)));
typedef float f32x4 __attribute__((ext_vector_type(4)));
typedef unsigned u32x4 __attribute__((ext_vector_type(4)));
constexpr int BM = 256, BK = 64, HALF = 128, HTB = HALF * BK * 2  , STAGE_BYTES = 8 * HTB, NXCD = 8, WGM = 8;

__host__ __device__ __forceinline__ int lds_byte(int r, int c) { const int st = (r >> 4) * 2 + (c >> 5), rr = r & 15, cc = c & 31, ob = rr * 64 + cc * 2; return st * 1024 + (ob ^ (((ob >> 9) & 1) << 5)); }
__host__ __device__ __forceinline__ void stage_rc(int b, int& R, int& C) { const int st = b / 1024, sb = b % 1024, swz = sb ^ (((sb >> 9) & 1) << 5); R = (st >> 1) * 16 + swz / 64; C = (st & 1) * 32 + (swz % 64) / 2; }
__host__ __device__ __forceinline__ int perm32(int rho) { const int n = rho >> 4, i = rho & 15; return 8 * (i >> 2) + 4 * n + (i & 3); }

struct Unit { int pm, pn; };
struct Gemm { const bf16_t* A; const bf16_t* Bt; int M, N, K; };

struct StaticOrder {
    int nM, nN, nwg, G, c;
    __host__ __device__ void init(int M, int N, int G_, int c_) { nM = M / BM; nN = N / BM; nwg = nM * nN; G = G_; c = c_; }
    __host__ __device__ bool next(int i, Unit& u) const {
        const long L = (long)i * G + c; if (L >= nwg) return false;
        int wgid = (int)L; { const int q = nwg / NXCD, r = nwg % NXCD, xcd = wgid % NXCD, off = wgid / NXCD; wgid = (xcd < r ? xcd * (q + 1) : r * (q + 1) + (xcd - r) * q) + off; }
        const int nig = WGM * nN, gid = wgid / nig, fm = gid * WGM, gsz = (nM - fm) < WGM ? (nM - fm) : WGM;
        u.pm = fm + ((wgid % nig) % gsz); u.pn = (wgid % nig) / gsz; return true;
    }
    __device__ __forceinline__ void a_ready(const Unit&) const {}
    __device__ __forceinline__ void done(const Unit&) const {}
};
__device__ __forceinline__ unsigned cvt_pk_bf16(float lo, float hi) { unsigned r; asm volatile("v_cvt_pk_bf16_f32 %0, %1, %2" : "=v"(r) : "v"(lo), "v"(hi)); return r; }
template <int ACT> struct EpiBf16 {
    static constexpr bool PERM = true, AFTER_DRAIN = false;
    bf16_t* O; int ldc;
    __device__ __forceinline__ void operator()(const f32x4 (&acc)[2][2][4][2], const Unit& u, int wr, int wc, int fr, int fq) const {
        const int row0 = u.pm * BM + wr * 64 + fr; const int col0 = u.pn * BM + wc * 32 + 8 * fq;
#pragma unroll
        for (int ai = 0; ai < 2; ++ai)
#pragma unroll
            for (int m = 0; m < 4; ++m) { bf16_t* rowp = O + (size_t)(row0 + ai * HALF + m * 16) * ldc + col0;
#pragma unroll
                for (int bj = 0; bj < 2; ++bj) { f32x4 v0 = acc[ai][bj][m][0], v1 = acc[ai][bj][m][1];
                    if (ACT == 2) {
#pragma unroll
                        for (int e = 0; e < 4; ++e) { const float a = fmaxf(v0[e], 0.f), b = fmaxf(v1[e], 0.f); v0[e] = a * a; v1[e] = b * b; } }
                    u32x4 w; w.x = cvt_pk_bf16(v0[0], v0[1]); w.y = cvt_pk_bf16(v0[2], v0[3]); w.z = cvt_pk_bf16(v1[0], v1[1]); w.w = cvt_pk_bf16(v1[2], v1[3]);
                    *(u32x4*)(rowp + bj * HALF) = w; } }
    }
};
template <class Epi, class Sched, bool ALIGN_EPI = false, bool SP2 = false>
__device__ __forceinline__ void gemm_phase(PG8_LAS unsigned char* lds, const Gemm g, const Sched& S, const Epi& E) {
    const int tid = threadIdx.x, wid = __builtin_amdgcn_readfirstlane(tid >> 6), lane = tid & 63, wr = wid >> 2, wc = wid & 3, fr = lane & 15, fq = lane >> 4;
    const int K = g.K, nt = K / BK;
    unsigned voffA[2], voffB[2];
#pragma unroll
    for (int i = 0; i < 2; ++i) { int R, C; stage_rc(tid * 16 + i * 8192, R, C); const int Rb = Epi::PERM ? ((R & ~31) + perm32(R & 31)) : R;
        voffA[i] = (unsigned)(R * K + C) * 2u; voffB[i] = (unsigned)(Rb * K + C) * 2u; }
    const size_t kstep = (size_t)(BK * 2);
    const size_t hstep = (size_t)HALF * K * 2;
    const size_t tstep = 2 * hstep;
    const unsigned ldsw = (unsigned)wid * 1024u;
    const int aoff = lds_byte(wr * 64 + fr, fq * 8), boff = lds_byte(wc * 32 + fr, fq * 8);
#define PG8_SA(b, h) (((b) * 2 + (h)) * HTB)
#define PG8_SB(b, h) ((4 + (b) * 2 + (h)) * HTB)
#define PG8_STAGE(bufoff, gbase, voff) do { _Pragma("unroll") for (int _i = 0; _i < 2; ++_i) \
        __builtin_amdgcn_global_load_lds((const unsigned*)((const char*)(gbase) + (voff)[_i]), (PG8_LAS unsigned*)(lds + (bufoff) + ldsw + _i * 8192), 16, 0, 0); } while (0)
#define PG8_LDA(dst, b, h) do { _Pragma("unroll") for (int m = 0; m < 4; ++m) _Pragma("unroll") for (int k = 0; k < 2; ++k) dst[m][k] = *(const PG8_LAS bf16x8*)(lds + PG8_SA(b, h) + aoff + m * 2048 + k * 1024); } while (0)
#define PG8_LDB(dst, b, h) do { _Pragma("unroll") for (int n = 0; n < 2; ++n) _Pragma("unroll") for (int k = 0; k < 2; ++k) dst[n][k] = *(const PG8_LAS bf16x8*)(lds + PG8_SB(b, h) + boff + n * 2048 + k * 1024); } while (0)
#define PG8_MMA(ai, bj, At, Bt) do { __builtin_amdgcn_s_setprio(1); _Pragma("unroll") for (int m = 0; m < 4; ++m) _Pragma("unroll") for (int n = 0; n < 2; ++n) _Pragma("unroll") for (int k = 0; k < 2; ++k) \
        acc[ai][bj][m][n] = __builtin_amdgcn_mfma_f32_16x16x32_bf16(Bt[n][k], At[m][k], acc[ai][bj][m][n], 0, 0, 0); __builtin_amdgcn_s_setprio(0); } while (0)
#define PG8_WAIT_V(n) asm volatile("s_waitcnt vmcnt(" #n ")" ::: "memory")
#define PG8_WAIT_L(n) asm volatile("s_waitcnt lgkmcnt(" #n ")" ::: "memory")
#define PG8_BAR __builtin_amdgcn_s_barrier()
#define PG8_SCHED __builtin_amdgcn_sched_barrier(0)
    Unit cur, nxt; int ui = 0;
    if (!S.next(0, cur)) return;
    f32x4 acc[2][2][4][2];
#pragma unroll
    for (int a = 0; a < 2; ++a)
#pragma unroll
        for (int b = 0; b < 2; ++b)
#pragma unroll
            for (int m = 0; m < 4; ++m)
#pragma unroll
                for (int n = 0; n < 2; ++n) acc[a][b][m][n] = (f32x4){0.f, 0.f, 0.f, 0.f};
    bf16x8 At[4][2], B0[2][2], B1[2][2];
    const char* cA = (const char*)g.A + (size_t)cur.pm * tstep; const char* cB = (const char*)g.Bt + (size_t)cur.pn * tstep;
    S.a_ready(cur);
    if constexpr (SP2) {
        PG8_STAGE(PG8_SB(0, 0), cB, voffB); PG8_STAGE(PG8_SB(0, 1), cB + hstep, voffB); PG8_STAGE(PG8_SA(0, 0), cA, voffA); PG8_STAGE(PG8_SA(0, 1), cA + hstep, voffA);
        if (wr == 1) PG8_BAR;
        PG8_WAIT_V(2); PG8_BAR;
        PG8_STAGE(PG8_SB(1, 0), cB + kstep, voffB); PG8_STAGE(PG8_SA(1, 0), cA + kstep, voffA); PG8_STAGE(PG8_SB(1, 1), cB + hstep + kstep, voffB);
        PG8_WAIT_V(6); PG8_BAR;
    } else {
        PG8_STAGE(PG8_SB(0, 0), cB, voffB); PG8_STAGE(PG8_SA(0, 0), cA, voffA); PG8_STAGE(PG8_SB(0, 1), cB + hstep, voffB); PG8_STAGE(PG8_SA(0, 1), cA + hstep, voffA);
        if (wr == 1) PG8_BAR;
        PG8_WAIT_V(4); PG8_BAR;
        PG8_STAGE(PG8_SB(1, 0), cB + kstep, voffB); PG8_STAGE(PG8_SA(1, 0), cA + kstep, voffA); PG8_STAGE(PG8_SB(1, 1), cB + hstep + kstep, voffB);
        PG8_WAIT_V(6); PG8_BAR;
    }
    for (;;) {
        const bool has_next = S.next(ui + 1, nxt);
        const char* nA = has_next ? (const char*)g.A + (size_t)nxt.pm * tstep : cA; const char* nB = has_next ? (const char*)g.Bt + (size_t)nxt.pn * tstep : cB;
        for (int t = 0; t < nt; t += 2) {
            const bool last = (t == nt - 2);
            const char* a1 = cA + (size_t)(t + 1) * kstep;
            const char* a2 = last ? nA : cA + (size_t)(t + 2) * kstep; const char* b2 = last ? nB : cB + (size_t)(t + 2) * kstep;
            const char* a3 = a2 + kstep; const char* b3 = b2 + kstep;
            if (last && has_next) S.a_ready(nxt);
            if constexpr (SP2) {
            PG8_LDB(B0, 0, 0); PG8_LDB(B1, 0, 1); PG8_SCHED; PG8_LDA(At, 0, 0); PG8_STAGE(PG8_SA(1, 1), a1 + hstep, voffA);
            PG8_WAIT_V(8); PG8_WAIT_L(0); PG8_BAR; PG8_MMA(0, 0, At, B0); PG8_MMA(0, 1, At, B1); PG8_BAR; PG8_SCHED;
            PG8_LDA(At, 0, 1); PG8_STAGE(PG8_SB(0, 0), b2, voffB); PG8_STAGE(PG8_SB(0, 1), b2 + hstep, voffB); PG8_STAGE(PG8_SA(0, 0), a2, voffA);
            PG8_WAIT_V(8); PG8_WAIT_L(0); PG8_BAR; PG8_MMA(1, 0, At, B0); PG8_MMA(1, 1, At, B1); PG8_BAR; PG8_SCHED;
            PG8_LDB(B0, 1, 0); PG8_LDB(B1, 1, 1); PG8_SCHED; PG8_LDA(At, 1, 0); PG8_STAGE(PG8_SA(0, 1), a2 + hstep, voffA);
            PG8_WAIT_V(8); PG8_WAIT_L(0); PG8_BAR; PG8_MMA(0, 0, At, B0); PG8_MMA(0, 1, At, B1); PG8_BAR; PG8_SCHED;
            PG8_LDA(At, 1, 1); PG8_STAGE(PG8_SB(1, 0), b3, voffB); PG8_STAGE(PG8_SB(1, 1), b3 + hstep, voffB); PG8_STAGE(PG8_SA(1, 0), a3, voffA);
            PG8_WAIT_V(8); PG8_WAIT_L(0); PG8_BAR; PG8_MMA(1, 0, At, B0); PG8_MMA(1, 1, At, B1); PG8_BAR; PG8_SCHED;
            } else {
            PG8_LDB(B0, 0, 0); PG8_SCHED; PG8_LDA(At, 0, 0); PG8_STAGE(PG8_SA(1, 1), a1 + hstep, voffA);
            PG8_WAIT_L(8); PG8_BAR; PG8_WAIT_L(0); PG8_MMA(0, 0, At, B0); PG8_BAR; PG8_SCHED;
            PG8_LDB(B1, 0, 1); PG8_STAGE(PG8_SB(0, 0), b2, voffB);
            PG8_BAR; PG8_WAIT_L(0); PG8_MMA(0, 1, At, B1); PG8_BAR;
            PG8_LDA(At, 0, 1); PG8_STAGE(PG8_SA(0, 0), a2, voffA);
            PG8_BAR; PG8_WAIT_L(0); PG8_MMA(1, 0, At, B0); PG8_BAR; PG8_SCHED;
            PG8_STAGE(PG8_SB(0, 1), b2 + hstep, voffB);
            PG8_WAIT_V(6); PG8_BAR; PG8_MMA(1, 1, At, B1); PG8_BAR;
            PG8_LDB(B0, 1, 0); PG8_SCHED; PG8_LDA(At, 1, 0); PG8_STAGE(PG8_SA(0, 1), a2 + hstep, voffA);
            PG8_WAIT_L(8); PG8_BAR; PG8_WAIT_L(0); PG8_MMA(0, 0, At, B0); PG8_BAR; PG8_SCHED;
            PG8_LDB(B1, 1, 1); PG8_STAGE(PG8_SB(1, 0), b3, voffB);
            PG8_BAR; PG8_WAIT_L(0); PG8_MMA(0, 1, At, B1); PG8_BAR;
            PG8_LDA(At, 1, 1); PG8_STAGE(PG8_SA(1, 0), a3, voffA);
            PG8_BAR; PG8_WAIT_L(0); PG8_MMA(1, 0, At, B0); PG8_BAR; PG8_SCHED;
            PG8_STAGE(PG8_SB(1, 1), b3 + hstep, voffB);
            PG8_WAIT_V(6); PG8_BAR; PG8_MMA(1, 1, At, B1); PG8_BAR;
            }
        }
        if constexpr (ALIGN_EPI) { if (wr == 0) PG8_BAR; }
        if constexpr (!Epi::AFTER_DRAIN) { E(acc, cur, wr, wc, fr, fq); S.done(cur); }
        if (!has_next) break;
#pragma unroll
        for (int a = 0; a < 2; ++a)
#pragma unroll
            for (int b = 0; b < 2; ++b)
#pragma unroll
                for (int m = 0; m < 4; ++m)
#pragma unroll
                    for (int n = 0; n < 2; ++n) acc[a][b][m][n] = (f32x4){0.f, 0.f, 0.f, 0.f};
        cur = nxt; cA = nA; cB = nB; ++ui;
        if constexpr (ALIGN_EPI) { if (wr == 1) PG8_BAR; }
    }
    PG8_WAIT_V(0);
    if constexpr (!ALIGN_EPI) { if (wr == 0) PG8_BAR; }
    PG8_BAR;
    if constexpr (Epi::AFTER_DRAIN) { E.fused(acc, cur, wr, wc, fr, fq, lds, wid, lane); S.done(cur); }
#undef PG8_SA
#undef PG8_SB
#undef PG8_STAGE
#undef PG8_LDA
#undef PG8_LDB
#undef PG8_MMA
#undef PG8_WAIT_V
#undef PG8_WAIT_L
#undef PG8_BAR
#undef PG8_SCHED
}
}

constexpr int NWAVES = 8;
constexpr int D = 1024, DIN = 1280, DFF = 4096, AW = 512, SW = 512;
constexpr int MP = 16384, MS = 512, MR = MP + MS;
constexpr int MMETA = MR, NMETA = 16, MIN_ROWS = 17152;
constexpr int NPOS = 4112 + 4;
constexpr float EPS = 1e-6f;
constexpr size_t O_YP = 0, O_YS = 16777216, O_KP = 17301504, O_VP = 17367040, O_SRP = 17432576, O_SIP = 17440768, O_KS = 17448960, O_VS = 19546112, O_SRS = 21643264, O_SIS = 21905408;
constexpr size_t MiB = 1u << 20;
constexpr size_t WS_CTL = 0, CTL_ZERO_BYTES = 1 * MiB;
constexpr size_t WS_ROPEC = 1 * MiB, WS_ROPES = WS_ROPEC + 160 * 1024, WS_ABR = WS_ROPES + 160 * 1024, WS_ABI = WS_ABR + 8192, WS_BBR = WS_ABI + 8192, WS_BBI = WS_BBR + 131072;
static_assert(WS_BBI + 131072 <= 2 * MiB && NPOS * 8 * 4 <= 160 * 1024, "tables");
constexpr size_t WS_WIN = 2 * MiB, WS_WGLU = 5 * MiB, WS_WOUT = 6 * MiB, WS_WUP = 8 * MiB, WS_WDN = 16 * MiB;
constexpr size_t WS_XN = 24 * MiB, WS_O = 58 * MiB, WS_P = 92 * MiB, WS_ATT = 134 * MiB, WS_Z = 151 * MiB, WS_GL = 168 * MiB, WS_CAT = 185 * MiB, WS_H = 92 * MiB, WS_END = 224 * MiB;
constexpr size_t WS_VT = 224 * MiB, WS_QT = 228 * MiB, WS_KC = 232 * MiB, WS_HL = 233 * MiB, WS_HIN = 241 * MiB, WS_HM = 245 * MiB, WS_A32 = WS_HM + 16384, WS_TOP = 246 * MiB;
static_assert(WS_XN + (size_t)MIN_ROWS * D * 2 <= WS_O && WS_O + (size_t)MR * D * 2 <= WS_P && WS_P + (size_t)MIN_ROWS * DIN * 2 <= WS_ATT && WS_ATT + (size_t)MR * AW * 2 <= WS_Z && WS_Z + (size_t)MR * SW * 2 <= WS_GL &&
              WS_GL + (size_t)MR * SW * 2 <= WS_CAT && WS_CAT + (size_t)MR * D * 2 <= WS_END && WS_H + (size_t)MR * DFF * 2 <= WS_END, "d_ws map");
constexpr int CW_BAR = 4096;
constexpr int RING_BYTES = 131072, LDS_BYTES = 163840, LDSCTL_OFF = LDS_BYTES - 512, MISC_OFF = LDSCTL_OFF + 320;

#define GAS __attribute__((address_space(1)))
#define LAS __attribute__((address_space(3)))
typedef unsigned short bf16;
typedef unsigned v4u __attribute__((ext_vector_type(4)));
typedef unsigned v2u __attribute__((ext_vector_type(2)));
typedef float f32x4 __attribute__((ext_vector_type(4)));
typedef GAS unsigned gu32;
#define RLX_AGENT __ATOMIC_RELAXED, __HIP_MEMORY_SCOPE_AGENT
#define LDS_WAIT() asm volatile("s_waitcnt lgkmcnt(0)" ::: "memory")
#define VM_WAIT() asm volatile("s_waitcnt vmcnt(0)" ::: "memory")
__device__ __forceinline__ unsigned f2bf(float f) { unsigned u = __builtin_bit_cast(unsigned, f); return (u + 0x7fffu + ((u >> 16) & 1u)) >> 16; }
__device__ __forceinline__ unsigned pk2(float lo, float hi) { return f2bf(lo) | (f2bf(hi) << 16); }
__device__ __forceinline__ float bflo(unsigned w) { return __uint_as_float(w << 16); }
__device__ __forceinline__ float bfhi(unsigned w) { return __uint_as_float(w & 0xffff0000u); }
__device__ __forceinline__ float bf1(bf16 b) { return __uint_as_float((unsigned)b << 16); }

#define XB_TMO      128
#define XB_XCNT(j)  (256  + 64 * (j))
#define XB_XSUB(j)  (1280 + 64 * (j))
#define XB_XGEN(j)  (2304 + 64 * (j))
#define XB_TOP      3328
#define XB_TOPGEN   3392
#define XCD_BAR_WORDS 3456
#define XB_SPIN_CAP (1u << 18)
__device__ __forceinline__ unsigned xb_ld(unsigned* p)              { return __hip_atomic_load(p, __ATOMIC_RELAXED, __HIP_MEMORY_SCOPE_AGENT); }
__device__ __forceinline__ unsigned xb_add(unsigned* p, unsigned v) { return __hip_atomic_fetch_add(p, v, __ATOMIC_RELAXED, __HIP_MEMORY_SCOPE_AGENT); }
__device__ __forceinline__ unsigned xb_xcc_id() { return (unsigned)__builtin_amdgcn_s_getreg((3 << 11) | 20) & 0xFu; }
#define XB_SPIN(cond, bar) do { unsigned _sp = 0; while (cond) { __builtin_amdgcn_s_sleep(1); \
    if ((++_sp & 255u) == 0u) { if (xb_ld(&(bar)[XB_TMO])) break; if (_sp > XB_SPIN_CAP) { atomicAdd(&(bar)[XB_TMO], 1u); break; } } } } while (0)
struct XcdBarrier { unsigned* bar; unsigned x; volatile LAS unsigned* st; };
__device__ __forceinline__ XcdBarrier xcd_barrier_post(unsigned* bar, volatile LAS unsigned* st) {
    XcdBarrier b; b.bar = bar; b.x = xb_xcc_id(); b.st = st;
    if (threadIdx.x == 0) (void)xb_add(&bar[XB_XCNT(b.x)], 1u);
    return b;
}
__device__ __forceinline__ void xcd_barrier_complete(unsigned* bar, unsigned x, unsigned& nloc, unsigned& nx) {
    const unsigned G = gridDim.x * gridDim.y * gridDim.z;
    unsigned sum, cnt, mine, sp = 0u;
    for (;;) {
        sum = 0u; cnt = 0u; mine = 0u;
#pragma unroll
        for (unsigned j = 0; j < 16; ++j) { const unsigned c = xb_ld(&bar[XB_XCNT(j)]); sum += c; cnt += (c > 0u) ? 1u : 0u; mine = (j == x) ? c : mine; }
        if (sum == G) break;
        __builtin_amdgcn_s_sleep(1);
        if ((++sp & 255u) == 0u) { if (xb_ld(&bar[XB_TMO])) break; if (sp > XB_SPIN_CAP) { atomicAdd(&bar[XB_TMO], 1u); break; } }
    }
    nloc = mine > 0u ? mine : 1u; nx = cnt > 0u ? cnt : 1u;
}
__device__ __forceinline__ void xcd_barrier(const XcdBarrier& b) {
    asm volatile("s_waitcnt vmcnt(0)" ::: "memory");
    __syncthreads();
    if (threadIdx.x == 0) {
        unsigned* bar = b.bar;
        __builtin_amdgcn_s_waitcnt(0);
        unsigned nloc = b.st[0], nx = b.st[1];
        if (nloc == 0u) { xcd_barrier_complete(bar, b.x, nloc, nx); b.st[0] = nloc; b.st[1] = nx; }
        const unsigned old = xb_add(&bar[XB_XSUB(b.x)], 1u);
        const unsigned gen = old / nloc;
        if (old + 1u == (gen + 1u) * nloc) {
            __builtin_amdgcn_fence(__ATOMIC_RELEASE, "agent");
            asm volatile("s_waitcnt vmcnt(0)" ::: "memory");
            const unsigned og = xb_add(&bar[XB_TOP], 1u);
            const unsigned tg = og / nx;
            if (og + 1u == (tg + 1u) * nx) xb_add(&bar[XB_TOPGEN], 1u);
            else XB_SPIN(xb_ld(&bar[XB_TOPGEN]) == tg, bar);
            __builtin_amdgcn_fence(__ATOMIC_ACQUIRE, "agent");
            xb_add(&bar[XB_XGEN(b.x)], 1u);
            asm volatile("s_waitcnt vmcnt(0)" ::: "memory");
        } else {
            XB_SPIN(xb_ld(&bar[XB_XGEN(b.x)]) == gen, bar);
            __builtin_amdgcn_fence(__ATOMIC_ACQUIRE, "agent");
            asm volatile("s_waitcnt vmcnt(0)" ::: "memory");
        }
    }
    __syncthreads();
}

struct Frame {
    LAS unsigned char* lds;
    volatile LAS unsigned* MISC;
    gu32* ctl;
    int tid, lane, wave;
    int vcu, G;
    const float* in[27]; float* out; unsigned char* ws;
};
enum { I_XP = 0, I_XS, I_CK, I_CV, I_SRE, I_SIM, I_META, I_GPRE, I_WIN, I_SINK, I_ARE, I_AIM, I_LDT, I_BRE, I_BIM, I_CRE, I_CIM, I_DD, I_WGLU, I_GATT, I_GSSM, I_WOUT, I_GPOST, I_GMLP, I_WUP, I_WDN, I_GMLPP };

__device__ __forceinline__ float wave_sum(float v) {
#pragma unroll
    for (int o = 1; o < 64; o <<= 1) v += __shfl_xor(v, o);
    return v;
}
__device__ __forceinline__ float wave_max(float v) {
#pragma unroll
    for (int o = 1; o < 64; o <<= 1) v = fmaxf(v, __shfl_xor(v, o));
    return v;
}
__device__ __forceinline__ void sincos_d(double a, double& s, double& c) {
    const double k = __builtin_rint(a * 0.63661977236758134308);
    double r = __builtin_fma(-k, 1.57079632679489655800e+00, a);
    r = __builtin_fma(-k, 6.12323399573676603587e-17, r);
    const double r2 = r * r;
    double sp = 1.0 / 6227020800.0; sp = sp * r2 - 1.0 / 39916800.0; sp = sp * r2 + 1.0 / 362880.0; sp = sp * r2 - 1.0 / 5040.0; sp = sp * r2 + 1.0 / 120.0; sp = sp * r2 - 1.0 / 6.0; sp = sp * r2 + 1.0; sp = sp * r;
    double cp = -1.0 / 87178291200.0; cp = cp * r2 + 1.0 / 479001600.0; cp = cp * r2 - 1.0 / 3628800.0; cp = cp * r2 + 1.0 / 40320.0; cp = cp * r2 - 1.0 / 720.0; cp = cp * r2 + 1.0 / 24.0; cp = cp * r2 - 0.5; cp = cp * r2 + 1.0;
    const int q = ((int)k) & 3;
    s = (q == 0) ? sp : (q == 1) ? cp : (q == 2) ? -sp : -cp;
    c = (q == 0) ? cp : (q == 1) ? -sp : (q == 2) ? -cp : sp;
}
__device__ __forceinline__ double exp_d(double x) {
    const double k = __builtin_rint(x * 1.44269504088896340736);
    double r = __builtin_fma(-k, 6.93147180369123816490e-01, x); r = __builtin_fma(-k, 1.90821492927058770002e-10, r);
    double p = 1.0 / 6227020800.0; p = p * r + 1.0 / 479001600.0; p = p * r + 1.0 / 39916800.0; p = p * r + 1.0 / 3628800.0; p = p * r + 1.0 / 362880.0; p = p * r + 1.0 / 40320.0; p = p * r + 1.0 / 5040.0;
    p = p * r + 1.0 / 720.0; p = p * r + 1.0 / 120.0; p = p * r + 1.0 / 24.0; p = p * r + 1.0 / 6.0; p = p * r + 0.5; p = p * r + 1.0; p = p * r + 1.0;
    const long long bits = ((long long)(1023 + (int)k)) << 52;
    return p * __builtin_bit_cast(double, bits);
}
__device__ __forceinline__ float gelu_tanh(float x) {
    const float a = 0.7978845608028654f * (x + 0.044715f * x * x * x);
    const float e = __expf(2.0f * a);
    const float t = 1.0f - 2.0f / (e + 1.0f);
    return 0.5f * x * (1.0f + t);
}
__device__ __forceinline__ float sigmoidf_(float x) { return 1.0f / (1.0f + __expf(-x)); }

__device__ __forceinline__ void p0_transpose_item(const float* W, int K, int N, bf16* WT, LAS float* scr, int item, int lane) {
    const int nblk = N / 32, kb = item / nblk, nb = item % nblk, k0 = 64 * kb, n0 = 32 * nb;
#pragma unroll 8
    for (int i = 0; i < 32; ++i) { const int kk = 2 * i + (lane >> 5); scr[kk * 33 + (lane & 31)] = W[(size_t)(k0 + kk) * N + n0 + (lane & 31)]; }
    LDS_WAIT(); asm volatile("" ::: "memory");
    const int c = lane & 7;
#pragma unroll
    for (int j = 0; j < 4; ++j) { const int n = (lane >> 3) + 8 * j; const LAS float* s = scr + (8 * c) * 33 + n;
        v4u o; o.x = pk2(s[0 * 33], s[1 * 33]); o.y = pk2(s[2 * 33], s[3 * 33]); o.z = pk2(s[4 * 33], s[5 * 33]); o.w = pk2(s[6 * 33], s[7 * 33]);
        *(GAS v4u*)(WT + (size_t)(n0 + n) * K + k0 + 8 * c) = o; }
    LDS_WAIT(); asm volatile("" ::: "memory");
}
__device__ __forceinline__ void rms_row_to_bf16(const float* xrow, const float* g, bf16* orow, int lane) {
    const GAS f32x4* xr = (const GAS f32x4*)xrow + lane;
    f32x4 v[4]; float s = 0.f;
#pragma unroll
    for (int j = 0; j < 4; ++j) { v[j] = xr[64 * j]; s += (v[j].x * v[j].x + v[j].y * v[j].y) + (v[j].z * v[j].z + v[j].w * v[j].w); }
    const float rs = 1.0f / sqrtf(wave_sum(s) * (1.f / 1024.f) + EPS);
    GAS unsigned long long* o8 = (GAS unsigned long long*)orow + lane;
#pragma unroll
    for (int j = 0; j < 4; ++j) { const f32x4 gg = ((const GAS f32x4*)g)[lane + 64 * j];
        o8[64 * j] = (unsigned long long)pk2(v[j].x * rs * gg.x, v[j].y * rs * gg.y) | ((unsigned long long)pk2(v[j].z * rs * gg.z, v[j].w * rs * gg.w) << 32); }
}
__device__ __forceinline__ const float* x_row_ptr(const Frame& F, int r) {
    return r < MP ? F.in[I_XP] + (size_t)r * D : (r < MR ? F.in[I_XS] + (size_t)(r - MP) * D : F.in[I_META] + (size_t)(r - MR) * D);
}
__device__ __forceinline__ void p0_prologue(Frame& F) {
    LAS float* scr = (LAS float*)(F.lds + F.wave * 16384);
    const int gw = F.vcu * NWAVES + F.wave, NGW = F.G * NWAVES;
    constexpr int I_IN = (D / 64) * (DIN / 32), I_GL = (SW / 64) * (SW / 32), I_OU = (D / 64) * (D / 32), I_UP = (D / 64) * (DFF / 32), I_DN = (DFF / 64) * (D / 32);
    constexpr int NITEMS = I_IN + I_GL + I_OU + I_UP + I_DN;
    for (int it = gw; it < NITEMS; it += NGW) {
        int r = it;
        if (r < I_IN) { p0_transpose_item(F.in[I_WIN], D, DIN, (bf16*)(F.ws + WS_WIN), scr, r, F.lane); continue; } r -= I_IN;
        if (r < I_GL) { p0_transpose_item(F.in[I_WGLU], SW, SW, (bf16*)(F.ws + WS_WGLU), scr, r, F.lane); continue; } r -= I_GL;
        if (r < I_OU) { p0_transpose_item(F.in[I_WOUT], D, D, (bf16*)(F.ws + WS_WOUT), scr, r, F.lane); continue; } r -= I_OU;
        if (r < I_UP) { p0_transpose_item(F.in[I_WUP], D, DFF, (bf16*)(F.ws + WS_WUP), scr, r, F.lane); continue; } r -= I_UP;
        p0_transpose_item(F.in[I_WDN], DFF, D, (bf16*)(F.ws + WS_WDN), scr, r, F.lane);
    }
    bf16* XN = (bf16*)(F.ws + WS_XN);
    for (int m = gw; m < MIN_ROWS; m += NGW) {
        if (m < MR + NMETA) rms_row_to_bf16(x_row_ptr(F, m), F.in[I_GPRE], XN + (size_t)m * D, F.lane);
        else { GAS unsigned long long* o8 = (GAS unsigned long long*)(XN + (size_t)m * D) + F.lane;
#pragma unroll
            for (int j = 0; j < 4; ++j) o8[64 * j] = 0ull; }
    }
    const int gt = F.vcu * (NWAVES * 64) + F.tid, NT = F.G * NWAVES * 64;
    float* ropeC = (float*)(F.ws + WS_ROPEC); float* ropeS = (float*)(F.ws + WS_ROPES);
    for (int i = gt; i < NPOS * 8; i += NT) {
        const int idx = i >> 3, fi = i & 7; const int pos = idx < 4112 ? idx : 8192 + (idx - 4112);
        const float inv = (float)exp_d(-(double)fi * 1.640295422175541);
        const float ang = (float)pos * inv;
        double s, c; sincos_d((double)ang, s, c);
        ropeC[i] = (float)c; ropeS[i] = (float)s;
    }
    float* abr = (float*)(F.ws + WS_ABR); float* abi = (float*)(F.ws + WS_ABI); float* bbr = (float*)(F.ws + WS_BBR); float* bbi = (float*)(F.ws + WS_BBI);
    for (int i = gt; i < 2048; i += NT) {
        const int g = i >> 6;
        const double dt = exp_d((double)F.in[I_LDT][g]); const double ar = (double)F.in[I_ARE][i], ai = (double)F.in[I_AIM][i];
        const double mag = exp_d(ar * dt); double s, c; sincos_d(ai * dt, s, c);
        const double are = mag * c, aim = mag * s;
        const double nr = are - 1.0, ni = aim, den = ar * ar + ai * ai;
        const double cr = (nr * ar + ni * ai) / den, ci = (ni * ar - nr * ai) / den;
        abr[i] = (float)are; abi[i] = (float)aim;
        for (int h = 0; h < 16; ++h) { const double br = (double)F.in[I_BRE][i * 16 + h], bi = (double)F.in[I_BIM][i * 16 + h];
            bbr[i * 16 + h] = (float)(cr * br - ci * bi); bbi[i * 16 + h] = (float)(cr * bi + ci * br); }
    }
}
__device__ __forceinline__ int pos_index(int r) { return r < MP ? (r & 4095) + 16 : (r < MR ? 4112 + ((r - MP) & 3) : r - MR); }
__device__ __forceinline__ void p2_rope(Frame& F) {
    const int gt = F.vcu * (NWAVES * 64) + F.tid, NT = F.G * NWAVES * 64;
    bf16* P = (bf16*)(F.ws + WS_P); const float* ropeC = (const float*)(F.ws + WS_ROPEC); const float* ropeS = (const float*)(F.ws + WS_ROPES);
    for (int it = gt; it < (MR + NMETA) * 80; it += NT) {
        const int r = it / 80, rem = it - r * 80, hh = rem >> 3, fi = rem & 7;
        bf16* p = P + (size_t)r * DIN + hh * 64 + fi;
        const float x1 = bf1(p[0]), x2 = bf1(p[8]);
        const int pi = pos_index(r) * 8 + fi; const float c = ropeC[pi], s = ropeS[pi];
        p[0] = (bf16)f2bf(x1 * c - x2 * s); p[8] = (bf16)f2bf(x2 * c + x1 * s);
    }
}
__device__ __forceinline__ void p3_ssm_naive(Frame& F) {
    LAS float* hs = (LAS float*)(F.lds + F.wave * 16384);
    const int gw = F.vcu * NWAVES + F.wave, NGW = F.G * NWAVES, lane = F.lane;
    const bf16* P = (const bf16*)(F.ws + WS_P); bf16* Z = (bf16*)(F.ws + WS_Z);
    const float* abr = (const float*)(F.ws + WS_ABR); const float* abi = (const float*)(F.ws + WS_ABI); const float* bbr = (const float*)(F.ws + WS_BBR); const float* bbi = (const float*)(F.ws + WS_BBI);
    for (int task = gw; task < (4 + 128) * 32; task += NGW) {
        const int seq = task >> 5, g = task & 31, gp = g * 64 + lane;
        const float are = abr[gp], aim = abi[gp];
        float br[16], bi[16];
#pragma unroll
        for (int h = 0; h < 16; ++h) { br[h] = bbr[gp * 16 + h]; bi[h] = bbi[gp * 16 + h]; }
        const int ho = lane & 15, qq = lane >> 4;
        float cr[16], ci[16];
#pragma unroll
        for (int j = 0; j < 16; ++j) { cr[j] = F.in[I_CRE][(g * 16 + ho) * 64 + qq * 16 + j]; ci[j] = F.in[I_CIM][(g * 16 + ho) * 64 + qq * 16 + j]; }
        const float dd = F.in[I_DD][g * 16 + ho];
        float hr, hi; int nsteps;
        if (seq < 4) { hr = 0.f; hi = 0.f; nsteps = 4112; }
        else { const int db = seq - 4; hr = F.in[I_SRE][(db * 32 + g) * 64 + lane]; hi = F.in[I_SIM][(db * 32 + g) * 64 + lane]; nsteps = 4; }
        for (int st = 0; st < nsteps; ++st) {
            int row; bool wr_out;
            if (seq < 4) { if (st < 16) { row = MR + st; wr_out = false; } else { row = seq * 4096 + st - 16; wr_out = true; } }
            else { row = MP + (seq - 4) * 4 + st; wr_out = true; }
            const v4u* up = (const v4u*)(P + (size_t)row * DIN + 768 + g * 16);
            const v4u u0 = up[0], u1 = up[1];
            float u[16];
            u[0] = bflo(u0.x); u[1] = bfhi(u0.x); u[2] = bflo(u0.y); u[3] = bfhi(u0.y); u[4] = bflo(u0.z); u[5] = bfhi(u0.z); u[6] = bflo(u0.w); u[7] = bfhi(u0.w);
            u[8] = bflo(u1.x); u[9] = bfhi(u1.x); u[10] = bflo(u1.y); u[11] = bfhi(u1.y); u[12] = bflo(u1.z); u[13] = bfhi(u1.z); u[14] = bflo(u1.w); u[15] = bfhi(u1.w);
            float bur = 0.f, bui = 0.f;
#pragma unroll
            for (int h = 0; h < 16; ++h) { bur += br[h] * u[h]; bui += bi[h] * u[h]; }
            const float nhr = are * hr - aim * hi + bur, nhi = are * hi + aim * hr + bui;
            hr = nhr; hi = nhi;
            if (wr_out) {
                hs[lane] = hr; hs[64 + lane] = hi;
                LDS_WAIT(); asm volatile("" ::: "memory");
                float y = 0.f;
#pragma unroll
                for (int j = 0; j < 16; ++j) y += cr[j] * hs[qq * 16 + j] - ci[j] * hs[64 + qq * 16 + j];
                y += __shfl_xor(y, 16); y += __shfl_xor(y, 32);
                float uo = u[0];
#pragma unroll
                for (int h = 1; h < 16; ++h) uo = (ho == h) ? u[h] : uo;
                y += dd * uo;
                const float z = gelu_tanh(y);
                if (lane < 16) Z[(size_t)row * SW + g * 16 + ho] = (bf16)f2bf(z);
                LDS_WAIT(); asm volatile("" ::: "memory");
            }
        }
        if (seq < 4) { F.out[O_SRP + (seq * 32 + g) * 64 + lane] = hr; F.out[O_SIP + (seq * 32 + g) * 64 + lane] = hi; }
        else { F.out[O_SRS + ((seq - 4) * 32 + g) * 64 + lane] = hr; F.out[O_SIS + ((seq - 4) * 32 + g) * 64 + lane] = hi; }
    }
}
__device__ __forceinline__ float dot64_bf16(const LAS float* qf, const bf16* kp) {
    float s = 0.f;
#pragma unroll 2
    for (int i = 0; i < 8; ++i) { const v4u k = ((const v4u*)kp)[i]; const f32x4 a = ((const LAS f32x4*)qf)[2 * i], b = ((const LAS f32x4*)qf)[2 * i + 1];
        s += a.x * bflo(k.x) + a.y * bfhi(k.x) + a.z * bflo(k.y) + a.w * bfhi(k.y) + b.x * bflo(k.z) + b.y * bfhi(k.z) + b.z * bflo(k.w) + b.w * bfhi(k.w); }
    return s;
}
__device__ __forceinline__ float dot64_f32(const LAS float* qf, const float* kp) {
    float s = 0.f;
#pragma unroll 2
    for (int i = 0; i < 16; ++i) { const f32x4 k = ((const f32x4*)kp)[i]; const f32x4 a = ((const LAS f32x4*)qf)[i];
        s += a.x * k.x + a.y * k.y + a.z * k.z + a.w * k.w; }
    return s;
}
__device__ __forceinline__ void p3_attn_naive(Frame& F) {
    LAS float* pw = (LAS float*)(F.lds + F.wave * 16384 + 1024);
    LAS float* qf = (LAS float*)(F.lds + F.wave * 16384 + 2048);
    const int gw = F.vcu * NWAVES + F.wave, NGW = F.G * NWAVES, lane = F.lane;
    const bf16* P = (const bf16*)(F.ws + WS_P); bf16* ATT = (bf16*)(F.ws + WS_ATT);
    const float NEG = -1e30f;
#pragma unroll 1
    for (int task = gw; task < MR * 8; task += NGW) {
        const int r = task >> 3, h = task & 7, kvh = h >> 2;
        qf[lane] = bf1(P[(size_t)r * DIN + h * 64 + lane]);
        LDS_WAIT(); asm volatile("" ::: "memory");
        const float sink = F.in[I_SINK][h];
        float l0, l1, l2 = NEG; bool v0, v1, v2 = false;
        if (r < MP) {
            const int b = r >> 12, s = r & 4095, pos = s + 16;
            const int kp0 = pos - 127 + lane, kp1 = kp0 + 64;
            v0 = kp0 >= 0; v1 = kp1 >= 0;
            const int kr0 = kp0 >= 16 ? b * 4096 + kp0 - 16 : MR + (kp0 < 0 ? 0 : kp0);
            const int kr1 = kp1 >= 16 ? b * 4096 + kp1 - 16 : MR + (kp1 < 0 ? 0 : kp1);
            l0 = dot64_bf16(qf, P + (size_t)kr0 * DIN + 512 + kvh * 64) * 0.125f;
            l1 = dot64_bf16(qf, P + (size_t)kr1 * DIN + 512 + kvh * 64) * 0.125f;
        } else {
            const int db = (r - MP) >> 2, t = (r - MP) & 3;
            v0 = lane >= t + 1; v1 = true;
            l0 = dot64_f32(qf, F.in[I_CK] + ((size_t)(db * 128 + lane) * 2 + kvh) * 64) * 0.125f;
            l1 = dot64_f32(qf, F.in[I_CK] + ((size_t)(db * 128 + lane + 64) * 2 + kvh) * 64) * 0.125f;
            v2 = lane <= t;
            const int tr = lane < 4 ? lane : 0;
            l2 = dot64_bf16(qf, P + (size_t)(MP + db * 4 + tr) * DIN + 512 + kvh * 64) * 0.125f;
        }
        l0 = v0 ? l0 : NEG; l1 = v1 ? l1 : NEG; l2 = v2 ? l2 : NEG;
        float m = wave_max(fmaxf(fmaxf(l0, l1), l2)); m = fmaxf(m, sink);
        const float e0 = v0 ? __expf(l0 - m) : 0.f, e1 = v1 ? __expf(l1 - m) : 0.f, e2 = v2 ? __expf(l2 - m) : 0.f;
        const float den = wave_sum(e0 + e1 + e2) + __expf(sink - m);
        const float inv = 1.0f / den;
        pw[lane] = e0 * inv; pw[64 + lane] = e1 * inv; pw[128 + lane] = e2 * inv;
        LDS_WAIT(); asm volatile("" ::: "memory");
        float o = 0.f;
        if (r < MP) {
            const int b = r >> 12, s = r & 4095, pos = s + 16;
#pragma unroll 1
            for (int j = 0; j < 128; ++j) { const int kp = pos - 127 + j; if (kp < 0) continue;
                const int kr = kp >= 16 ? b * 4096 + kp - 16 : MR + kp;
                o += pw[j] * bf1(P[(size_t)kr * DIN + 640 + kvh * 64 + lane]); }
        } else {
            const int db = (r - MP) >> 2, t = (r - MP) & 3;
#pragma unroll 1
            for (int j = t + 1; j < 128; ++j) o += pw[j] * F.in[I_CV][((size_t)(db * 128 + j) * 2 + kvh) * 64 + lane];
#pragma unroll 1
            for (int j = 0; j <= t; ++j) o += pw[128 + j] * bf1(P[(size_t)(MP + db * 4 + j) * DIN + 640 + kvh * 64 + lane]);
        }
        ATT[(size_t)r * AW + h * 64 + lane] = (bf16)f2bf(o);
        LDS_WAIT(); asm volatile("" ::: "memory");
    }
}
__device__ __forceinline__ void p3_windows(Frame& F) {
    const int gt = F.vcu * (NWAVES * 64) + F.tid, NT = F.G * NWAVES * 64;
    const bf16* P = (const bf16*)(F.ws + WS_P);
    for (int e = gt; e < 65536; e += NT) { const int b = e >> 14, j = (e >> 7) & 127, c = e & 127; const size_t base = (size_t)(b * 4096 + 3968 + j) * DIN;
        F.out[O_KP + e] = bf1(P[base + 512 + c]); F.out[O_VP + e] = bf1(P[base + 640 + c]); }
    for (int e = gt; e < 2097152; e += NT) { const int db = e >> 14, j = (e >> 7) & 127, c = e & 127;
        float kv, vv;
        if (j < 124) { kv = F.in[I_CK][(size_t)(db * 128 + j + 4) * 128 + c]; vv = F.in[I_CV][(size_t)(db * 128 + j + 4) * 128 + c]; }
        else { const size_t base = (size_t)(MP + db * 4 + j - 124) * DIN; kv = bf1(P[base + 512 + c]); vv = bf1(P[base + 640 + c]); }
        F.out[O_KS + e] = kv; F.out[O_VS + e] = vv; }
}
__device__ __forceinline__ void unpack8(const v4u w, float (&f)[8]) { f[0] = bflo(w.x); f[1] = bfhi(w.x); f[2] = bflo(w.y); f[3] = bfhi(w.y); f[4] = bflo(w.z); f[5] = bfhi(w.z); f[6] = bflo(w.w); f[7] = bfhi(w.w); }
__device__ __forceinline__ v4u pack8(const float (&f)[8]) { v4u w; w.x = pk2(f[0], f[1]); w.y = pk2(f[2], f[3]); w.z = pk2(f[4], f[5]); w.w = pk2(f[6], f[7]); return w; }
__device__ __forceinline__ void p5_mixnorm(Frame& F) {
    const int gw = F.vcu * NWAVES + F.wave, NGW = F.G * NWAVES, lane = F.lane;
    const bf16* ATT = (const bf16*)(F.ws + WS_ATT); const bf16* Z = (const bf16*)(F.ws + WS_Z); const bf16* GL = (const bf16*)(F.ws + WS_GL); bf16* CAT = (bf16*)(F.ws + WS_CAT);
    for (int r = gw; r < MR; r += NGW) {
        float a[8], z[8], gt[8], o[8];
        unpack8(*(const v4u*)(ATT + (size_t)r * AW + lane * 8), a); unpack8(*(const v4u*)(Z + (size_t)r * SW + lane * 8), z); unpack8(*(const v4u*)(GL + (size_t)r * SW + lane * 8), gt);
        float sa = 0.f, so = 0.f;
#pragma unroll
        for (int i = 0; i < 8; ++i) { o[i] = z[i] * sigmoidf_(gt[i]); sa += a[i] * a[i]; so += o[i] * o[i]; }
        const float ra = 1.0f / sqrtf(wave_sum(sa) * (1.f / 512.f) + EPS), ro = 1.0f / sqrtf(wave_sum(so) * (1.f / 512.f) + EPS);
#pragma unroll
        for (int i = 0; i < 8; ++i) { a[i] = a[i] * ra * F.in[I_GATT][lane * 8 + i]; o[i] = o[i] * ro * F.in[I_GSSM][lane * 8 + i]; }
        *(v4u*)(CAT + (size_t)r * D + lane * 8) = pack8(a); *(v4u*)(CAT + (size_t)r * D + 512 + lane * 8) = pack8(o);
    }
}
__device__ __forceinline__ void p7_mid(Frame& F) {
    const int gw = F.vcu * NWAVES + F.wave, NGW = F.G * NWAVES, lane = F.lane;
    const bf16* O1 = (const bf16*)(F.ws + WS_O); bf16* XN2 = (bf16*)(F.ws + WS_XN);
    for (int r = gw; r < MR; r += NGW) {
        float o[16], x[16];
        { float t[8]; unpack8(*(const v4u*)(O1 + (size_t)r * D + lane * 8), t);
#pragma unroll
          for (int i = 0; i < 8; ++i) o[i] = t[i];
          unpack8(*(const v4u*)(O1 + (size_t)r * D + 512 + lane * 8), t);
#pragma unroll
          for (int i = 0; i < 8; ++i) o[8 + i] = t[i]; }
        const float* xr = x_row_ptr(F, r);
#pragma unroll
        for (int hf = 0; hf < 2; ++hf) { const f32x4 a = *(const f32x4*)(xr + hf * 512 + lane * 8), b = *(const f32x4*)(xr + hf * 512 + lane * 8 + 4);
            x[hf * 8 + 0] = a.x; x[hf * 8 + 1] = a.y; x[hf * 8 + 2] = a.z; x[hf * 8 + 3] = a.w; x[hf * 8 + 4] = b.x; x[hf * 8 + 5] = b.y; x[hf * 8 + 6] = b.z; x[hf * 8 + 7] = b.w; }
        float ss = 0.f;
#pragma unroll
        for (int i = 0; i < 16; ++i) ss += o[i] * o[i];
        const float r1 = 1.0f / sqrtf(wave_sum(ss) * (1.f / 1024.f) + EPS);
        float s2 = 0.f;
#pragma unroll
        for (int i = 0; i < 16; ++i) { const int col = (i >> 3) * 512 + lane * 8 + (i & 7); x[i] = x[i] + o[i] * r1 * F.in[I_GPOST][col]; s2 += x[i] * x[i]; }
        const float r2 = 1.0f / sqrtf(wave_sum(s2) * (1.f / 1024.f) + EPS);
        float* yo = F.out + (size_t)r * D;
#pragma unroll
        for (int hf = 0; hf < 2; ++hf) {
            *(f32x4*)(yo + hf * 512 + lane * 8) = (f32x4){x[hf * 8 + 0], x[hf * 8 + 1], x[hf * 8 + 2], x[hf * 8 + 3]};
            *(f32x4*)(yo + hf * 512 + lane * 8 + 4) = (f32x4){x[hf * 8 + 4], x[hf * 8 + 5], x[hf * 8 + 6], x[hf * 8 + 7]};
            float n[8];
#pragma unroll
            for (int i = 0; i < 8; ++i) n[i] = x[hf * 8 + i] * r2 * F.in[I_GMLP][hf * 512 + lane * 8 + i];
            *(v4u*)(XN2 + (size_t)r * D + hf * 512 + lane * 8) = pack8(n);
        }
    }
}
__device__ __forceinline__ void p10_final(Frame& F) {
    const int gw = F.vcu * NWAVES + F.wave, NGW = F.G * NWAVES, lane = F.lane;
    const bf16* O2 = (const bf16*)(F.ws + WS_O);
    for (int r = gw; r < MR; r += NGW) {
        float o[16];
        { float t[8]; unpack8(*(const v4u*)(O2 + (size_t)r * D + lane * 8), t);
#pragma unroll
          for (int i = 0; i < 8; ++i) o[i] = t[i];
          unpack8(*(const v4u*)(O2 + (size_t)r * D + 512 + lane * 8), t);
#pragma unroll
          for (int i = 0; i < 8; ++i) o[8 + i] = t[i]; }
        float ss = 0.f;
#pragma unroll
        for (int i = 0; i < 16; ++i) ss += o[i] * o[i];
        const float r1 = 1.0f / sqrtf(wave_sum(ss) * (1.f / 1024.f) + EPS);
        float* yo = F.out + (size_t)r * D;
#pragma unroll
        for (int hf = 0; hf < 2; ++hf) {
            f32x4 a = *(const f32x4*)(yo + hf * 512 + lane * 8), b = *(const f32x4*)(yo + hf * 512 + lane * 8 + 4);
            const float* g = F.in[I_GMLPP] + hf * 512 + lane * 8;
            a.x += o[hf * 8 + 0] * r1 * g[0]; a.y += o[hf * 8 + 1] * r1 * g[1]; a.z += o[hf * 8 + 2] * r1 * g[2]; a.w += o[hf * 8 + 3] * r1 * g[3];
            b.x += o[hf * 8 + 4] * r1 * g[4]; b.y += o[hf * 8 + 5] * r1 * g[5]; b.z += o[hf * 8 + 6] * r1 * g[6]; b.w += o[hf * 8 + 7] * r1 * g[7];
            *(f32x4*)(yo + hf * 512 + lane * 8) = a; *(f32x4*)(yo + hf * 512 + lane * 8 + 4) = b;
        }
    }
}

typedef short bf16x8 __attribute__((ext_vector_type(8)));
constexpr int KC_PER_G = 33 * 256;
struct ZohD { double adt_r, adt_i, cr, ci; };
__device__ __forceinline__ ZohD zoh_d(const Frame& F, int gp) {
    const int g = gp >> 6;
    const double dt = exp_d((double)F.in[I_LDT][g]); const double ar = (double)F.in[I_ARE][gp], ai = (double)F.in[I_AIM][gp];
    ZohD z; z.adt_r = ar * dt; z.adt_i = ai * dt;
    const double mag = exp_d(z.adt_r); double s, c; sincos_d(z.adt_i, s, c);
    const double nr = mag * c - 1.0, ni = mag * s, den = ar * ar + ai * ai;
    z.cr = (nr * ar + ni * ai) / den; z.ci = (ni * ar - nr * ai) / den; return z;
}
__device__ __forceinline__ void abar_pow(const ZohD& z, int m, double& wr, double& wi) { const double mag = exp_d(z.adt_r * (double)m); double s, c; sincos_d(z.adt_i * (double)m, s, c); wr = mag * c; wi = mag * s; }

__device__ __forceinline__ void p0_ssm_tables(Frame& F) {
    const int gt = F.vcu * (NWAVES * 64) + F.tid, NT = F.G * NWAVES * 64;
    bf16* VT = (bf16*)(F.ws + WS_VT); bf16* QT = (bf16*)(F.ws + WS_QT); bf16* KC = (bf16*)(F.ws + WS_KC); float* A32 = (float*)(F.ws + WS_A32);
    for (int i = gt; i < 2048; i += NT) { const ZohD z = zoh_d(F, i); double wr, wi; abar_pow(z, 32, wr, wi); A32[2 * i] = (float)wr; A32[2 * i + 1] = (float)wi; }
    for (int it = gt; it < 65536; it += NT) {
        const int gp = it >> 5, s = it & 31, g = gp >> 6, p = gp & 63;
        const ZohD z = zoh_d(F, gp); double wr, wi; abar_pow(z, 31 - s, wr, wi);
        const float er = (float)(wr * z.cr - wi * z.ci), ei = (float)(wr * z.ci + wi * z.cr);
        float re[16], im[16];
#pragma unroll
        for (int h = 0; h < 16; ++h) { const float br = F.in[I_BRE][gp * 16 + h], bi = F.in[I_BIM][gp * 16 + h]; re[h] = er * br - ei * bi; im[h] = er * bi + ei * br; }
        bf16* d0 = VT + (size_t)g * 65536 + (size_t)(2 * p) * 512 + 16 * s; bf16* d1 = d0 + 512;
        v4u w;
        w.x = pk2(re[0], re[1]); w.y = pk2(re[2], re[3]); w.z = pk2(re[4], re[5]); w.w = pk2(re[6], re[7]); ((v4u*)d0)[0] = w;
        w.x = pk2(re[8], re[9]); w.y = pk2(re[10], re[11]); w.z = pk2(re[12], re[13]); w.w = pk2(re[14], re[15]); ((v4u*)d0)[1] = w;
        w.x = pk2(im[0], im[1]); w.y = pk2(im[2], im[3]); w.z = pk2(im[4], im[5]); w.w = pk2(im[6], im[7]); ((v4u*)d1)[0] = w;
        w.x = pk2(im[8], im[9]); w.y = pk2(im[10], im[11]); w.z = pk2(im[12], im[13]); w.w = pk2(im[14], im[15]); ((v4u*)d1)[1] = w;
    }
    for (int it = gt; it < 65536; it += NT) {
        const int gp = it >> 5, t = it & 31, g = gp >> 6, p = gp & 63;
        const ZohD z = zoh_d(F, gp); double wrd, wid; abar_pow(z, t + 1, wrd, wid); const float wr = (float)wrd, wi = (float)wid;
        unsigned* d = (unsigned*)(QT + (size_t)g * 65536 + (size_t)(16 * t) * 128 + 2 * p);
#pragma unroll
        for (int ho = 0; ho < 16; ++ho) { const float cr = F.in[I_CRE][(g * 16 + ho) * 64 + p], ci = F.in[I_CIM][(g * 16 + ho) * 64 + p];
            d[ho * 64] = pk2(cr * wr - ci * wi, -(cr * wi + ci * wr)); }
    }
    LAS float* E = (LAS float*)(F.lds + 131072);
    for (int bt = F.vcu; bt < 1024; bt += F.G) {
        const int g = bt >> 5, tau = bt & 31;
        if (F.tid < 64) { const int gp = g * 64 + F.tid; const ZohD z = zoh_d(F, gp); double wr, wi; abar_pow(z, tau, wr, wi);
            E[F.tid] = (float)(wr * z.cr - wi * z.ci); E[64 + F.tid] = (float)(wr * z.ci + wi * z.cr); }
        __syncthreads();
        if (F.tid < 256) { const int ho = F.tid >> 4, hi = F.tid & 15; float acc = 0.f;
            for (int p = 0; p < 64; ++p) { const float cr = F.in[I_CRE][(g * 16 + ho) * 64 + p], ci = F.in[I_CIM][(g * 16 + ho) * 64 + p];
                const float br = F.in[I_BRE][(g * 64 + p) * 16 + hi], bi = F.in[I_BIM][(g * 64 + p) * 16 + hi];
                const float er = E[p], ei = E[64 + p];
                acc += cr * (er * br - ei * bi) - ci * (er * bi + ei * br); }
            if (tau == 0 && ho == hi) acc += F.in[I_DD][g * 16 + ho];
            KC[(size_t)g * KC_PER_G + (tau + 1) * 256 + F.tid] = (bf16)f2bf(acc);
        } else if (tau == 0) { KC[(size_t)g * KC_PER_G + (F.tid - 256)] = (bf16)0; }
        __syncthreads();
    }
}
__device__ __forceinline__ void stage_rows(LAS unsigned char* dst, const unsigned char* src, int nrows, int cshift, int dst_stride, int tid) {
    const int total = nrows << cshift;
    for (int c = tid; c < total; c += NWAVES * 64) { const int row = c >> cshift, col = c & ((1 << cshift) - 1);
        const v4u v = *(const v4u*)(src + ((size_t)c << 4)); *(LAS v4u*)(dst + row * dst_stride + col * 16) = v; }
}
#define MFMA16(a, b, c) __builtin_amdgcn_mfma_f32_16x16x32_bf16((a), (b), (c), 0, 0, 0)
constexpr int VT_STRIDE = 1040, QT_STRIDE = 272, LDS_KC_OFF = 512 * QT_STRIDE;
static_assert(LDS_KC_OFF + KC_PER_G * 2 <= LDSCTL_OFF && 128 * VT_STRIDE <= LDSCTL_OFF, "SSM LDS images");
__device__ __forceinline__ void s1_hloc(Frame& F) {
    const bf16* P = (const bf16*)(F.ws + WS_P); const bf16* VT = (const bf16*)(F.ws + WS_VT); float* HL = (float*)(F.ws + WS_HL);
    const int lane = F.lane;
    for (int bt = F.vcu; bt < 256; bt += F.G) {
        const int g = bt >> 3, sub = bt & 7;
        __syncthreads();
        stage_rows(F.lds, (const unsigned char*)(VT + (size_t)g * 65536), 128, 6, VT_STRIDE, F.tid);
        __syncthreads();
        const int ntile = 4 * sub + (F.wave >> 1), half = F.wave & 1;
        const int n = ntile * 16 + (lane & 15), b = n >> 7, c = n & 127, row0 = b * 4096 + 32 * c;
        const bf16* up = P + (size_t)(row0 + (lane >> 5)) * DIN + 768 + g * 16 + 8 * ((lane >> 4) & 1);
        bf16x8 U[16];
#pragma unroll
        for (int ks = 0; ks < 16; ++ks) U[ks] = *(const bf16x8*)(up + (size_t)(2 * ks) * DIN);
#pragma unroll
        for (int mi = 0; mi < 4; ++mi) {
            const int mf = 4 * half + mi;
            const LAS unsigned char* ap = F.lds + (16 * mf + (lane & 15)) * VT_STRIDE + 16 * (lane >> 4);
            f32x4 acc = (f32x4){0.f, 0.f, 0.f, 0.f};
#pragma unroll
            for (int ks = 0; ks < 16; ++ks) acc = MFMA16(*(const LAS bf16x8*)(ap + 64 * ks), U[ks], acc);
            *(f32x4*)(HL + ((size_t)n * 32 + g) * 128 + 16 * mf + 4 * (lane >> 4)) = acc;
        }
    }
}
__device__ __forceinline__ void s1_small_seqs(Frame& F) {
    LAS float* hs = (LAS float*)(F.lds + 133120 + F.wave * 512);
    const int gw = F.vcu * NWAVES + F.wave, NGW = F.G * NWAVES, lane = F.lane;
    const bf16* P = (const bf16*)(F.ws + WS_P); bf16* Z = (bf16*)(F.ws + WS_Z); float* HM = (float*)(F.ws + WS_HM);
    const float* abr = (const float*)(F.ws + WS_ABR); const float* abi = (const float*)(F.ws + WS_ABI); const float* bbr = (const float*)(F.ws + WS_BBR); const float* bbi = (const float*)(F.ws + WS_BBI);
#pragma unroll 1
    for (int task = gw; task < 32 + 128 * 32; task += NGW) {
        const bool meta = task < 32; const int g = meta ? task : ((task - 32) & 31), db = meta ? 0 : ((task - 32) >> 5), gp = g * 64 + lane;
        const float are = abr[gp], aim = abi[gp];
        float br[16], bi[16];
#pragma unroll
        for (int h = 0; h < 16; ++h) { br[h] = bbr[gp * 16 + h]; bi[h] = bbi[gp * 16 + h]; }
        const int ho = lane & 15, qq = lane >> 4;
        float cr[16], ci[16];
#pragma unroll
        for (int j = 0; j < 16; ++j) { cr[j] = F.in[I_CRE][(g * 16 + ho) * 64 + qq * 16 + j]; ci[j] = F.in[I_CIM][(g * 16 + ho) * 64 + qq * 16 + j]; }
        const float dd = F.in[I_DD][g * 16 + ho];
        float hr = 0.f, hi = 0.f;
        if (!meta) { hr = F.in[I_SRE][(db * 32 + g) * 64 + lane]; hi = F.in[I_SIM][(db * 32 + g) * 64 + lane]; }
        const int nsteps = meta ? 16 : 4;
#pragma unroll 1
        for (int st = 0; st < nsteps; ++st) {
            const int row = meta ? MR + st : MP + db * 4 + st;
            const v4u* up = (const v4u*)(P + (size_t)row * DIN + 768 + g * 16);
            const v4u u0 = up[0], u1 = up[1];
            float u[16];
            u[0] = bflo(u0.x); u[1] = bfhi(u0.x); u[2] = bflo(u0.y); u[3] = bfhi(u0.y); u[4] = bflo(u0.z); u[5] = bfhi(u0.z); u[6] = bflo(u0.w); u[7] = bfhi(u0.w);
            u[8] = bflo(u1.x); u[9] = bfhi(u1.x); u[10] = bflo(u1.y); u[11] = bfhi(u1.y); u[12] = bflo(u1.z); u[13] = bfhi(u1.z); u[14] = bflo(u1.w); u[15] = bfhi(u1.w);
            float bur = 0.f, bui = 0.f;
#pragma unroll
            for (int h = 0; h < 16; ++h) { bur += br[h] * u[h]; bui += bi[h] * u[h]; }
            const float nhr = are * hr - aim * hi + bur, nhi = are * hi + aim * hr + bui;
            hr = nhr; hi = nhi;
            if (!meta) {
                hs[lane] = hr; hs[64 + lane] = hi;
                LDS_WAIT(); asm volatile("" ::: "memory");
                float y = 0.f;
#pragma unroll
                for (int j = 0; j < 16; ++j) y += cr[j] * hs[qq * 16 + j] - ci[j] * hs[64 + qq * 16 + j];
                y += __shfl_xor(y, 16); y += __shfl_xor(y, 32);
                float uo = u[0];
#pragma unroll
                for (int h = 1; h < 16; ++h) uo = (ho == h) ? u[h] : uo;
                y += dd * uo;
                const float z = gelu_tanh(y);
                if (lane < 16) Z[(size_t)row * SW + g * 16 + ho] = (bf16)f2bf(z);
                LDS_WAIT(); asm volatile("" ::: "memory");
            }
        }
        if (meta) { HM[g * 128 + 2 * lane] = hr; HM[g * 128 + 2 * lane + 1] = hi; }
        else { F.out[O_SRS + (db * 32 + g) * 64 + lane] = hr; F.out[O_SIS + (db * 32 + g) * 64 + lane] = hi; }
    }
}
__device__ __forceinline__ void s2_scan(Frame& F) {
    const int gt = F.vcu * (NWAVES * 64) + F.tid;
    if (gt < 8192) {
        const int b = gt >> 11, gp = gt & 2047, g = gp >> 6, p = gp & 63;
        const float* A32 = (const float*)(F.ws + WS_A32); const float* HM = (const float*)(F.ws + WS_HM);
        const float ar = A32[2 * gp], ai = A32[2 * gp + 1];
        float hr = HM[g * 128 + 2 * p], hi = HM[g * 128 + 2 * p + 1];
        const float* hl = (const float*)(F.ws + WS_HL) + ((size_t)(b * 128) * 32 + g) * 128 + 2 * p;
        unsigned* hin = (unsigned*)((bf16*)(F.ws + WS_HIN) + ((size_t)(b * 128) * 32 + g) * 128 + 2 * p);
#pragma unroll 1
        for (int c0 = 0; c0 < 128; c0 += 16) {
            float vr[16], vi[16];
#pragma unroll
            for (int j = 0; j < 16; ++j) { const float* q = hl + (size_t)(c0 + j) * 4096; vr[j] = q[0]; vi[j] = q[1]; }
#pragma unroll
            for (int j = 0; j < 16; ++j) { hin[(size_t)(c0 + j) * 2048] = pk2(hr, hi);
                const float nr = ar * hr - ai * hi + vr[j], ni = ar * hi + ai * hr + vi[j]; hr = nr; hi = ni; }
        }
        F.out[O_SRP + (b * 32 + g) * 64 + p] = hr; F.out[O_SIP + (b * 32 + g) * 64 + p] = hi;
    }
}
__device__ __forceinline__ void s3_y(Frame& F) {
    const bf16* P = (const bf16*)(F.ws + WS_P); const bf16* QT = (const bf16*)(F.ws + WS_QT); const bf16* KC = (const bf16*)(F.ws + WS_KC); const bf16* HIN = (const bf16*)(F.ws + WS_HIN); bf16* Z = (bf16*)(F.ws + WS_Z);
    const int lane = F.lane;
    for (int bt = F.vcu; bt < 256; bt += F.G) {
        const int g = bt >> 3, sub = bt & 7;
        __syncthreads();
        stage_rows(F.lds, (const unsigned char*)(QT + (size_t)g * 65536), 512, 4, QT_STRIDE, F.tid);
        stage_rows(F.lds + LDS_KC_OFF, (const unsigned char*)(KC + (size_t)g * KC_PER_G), 33, 5, 512, F.tid);
        __syncthreads();
        const int ntile = 4 * sub + (F.wave >> 1), half = F.wave & 1;
        const int n = ntile * 16 + (lane & 15), b = n >> 7, c = n & 127, row0 = b * 4096 + 32 * c;
        const bf16* up = P + (size_t)(row0 + (lane >> 5)) * DIN + 768 + g * 16 + 8 * ((lane >> 4) & 1);
        bf16x8 U[16], H[4];
#pragma unroll
        for (int ks = 0; ks < 16; ++ks) U[ks] = *(const bf16x8*)(up + (size_t)(2 * ks) * DIN);
        const bf16* hp = HIN + ((size_t)n * 32 + g) * 128 + 8 * (lane >> 4);
#pragma unroll
        for (int kk = 0; kk < 4; ++kk) H[kk] = *(const bf16x8*)(hp + 32 * kk);
        const LAS unsigned char* qp = F.lds + (16 * half + (lane & 15)) * QT_STRIDE + 16 * (lane >> 4);
        const LAS unsigned char* kp = F.lds + LDS_KC_OFF + (half - (lane >> 5) + 1) * 512 + (lane & 15) * 32 + 16 * ((lane >> 4) & 1);
        bf16* zp = Z + (size_t)(row0 + half) * SW + g * 16 + 4 * (lane >> 4);
#pragma unroll
        for (int i = 0; i < 16; ++i) {
            f32x4 acc = (f32x4){0.f, 0.f, 0.f, 0.f};
#pragma unroll
            for (int kk = 0; kk < 4; ++kk) acc = MFMA16(*(const LAS bf16x8*)(qp + i * 32 * QT_STRIDE + kk * 64), H[kk], acc);
#pragma unroll
            for (int ks = 0; ks < 16; ++ks) if (ks <= i) acc = MFMA16(*(const LAS bf16x8*)(kp + (2 * i - 2 * ks) * 512), U[ks], acc);
            v2u w; w.x = pk2(gelu_tanh(acc[0]), gelu_tanh(acc[1])); w.y = pk2(gelu_tanh(acc[2]), gelu_tanh(acc[3]));
            *(v2u*)(zp + (size_t)(2 * i) * SW) = w;
        }
    }
}
typedef float f32x16 __attribute__((ext_vector_type(16)));
#define MFMA32(a, b, c) __builtin_amdgcn_mfma_f32_32x32x16_bf16((a), (b), (c), 0, 0, 0)
__device__ __forceinline__ int crow(int r, int hl) { return (r & 3) + 8 * (r >> 2) + 4 * hl; }
constexpr float LOG2E = 1.4426950408889634f, QK_C2 = 0.125f * 1.4426950408889634f;
constexpr int AK_STRIDE = 144;
template <class MaskF>
__device__ __forceinline__ void attn_qblock(const LAS unsigned char* Kl, const LAS unsigned char* Vl, int vstride, const bf16x8 (&qf)[4], int kb0, float sink2, const MaskF& valid, LAS float* wsf, f32x16 (&O)[2], int lane) {
    const int i = lane & 31, hl = lane >> 5;
    f32x16 S[5];
#pragma unroll
    for (int kbi = 0; kbi < 5; ++kbi) {
        const LAS unsigned char* kp = Kl + (32 * (kb0 + kbi) + i) * AK_STRIDE + 16 * hl;
        f32x16 acc = (f32x16){0.f, 0.f, 0.f, 0.f, 0.f, 0.f, 0.f, 0.f, 0.f, 0.f, 0.f, 0.f, 0.f, 0.f, 0.f, 0.f};
#pragma unroll
        for (int kd = 0; kd < 4; ++kd) acc = MFMA32(*(const LAS bf16x8*)(kp + 32 * kd), qf[kd], acc);
        S[kbi] = acc;
    }
    float m = -1e30f;
#pragma unroll
    for (int kbi = 0; kbi < 5; ++kbi)
#pragma unroll
        for (int r = 0; r < 16; ++r) { const int kk = 32 * (kb0 + kbi) + crow(r, hl); const float t = valid(kk, i) ? S[kbi][r] * QK_C2 : -1e30f; S[kbi][r] = t; m = fmaxf(m, t); }
    m = fmaxf(m, __shfl_xor(m, 32)); m = fmaxf(m, sink2);
    float sum = 0.f;
#pragma unroll
    for (int kbi = 0; kbi < 5; ++kbi)
#pragma unroll
        for (int r = 0; r < 16; ++r) { const float p = __builtin_amdgcn_exp2f(S[kbi][r] - m); S[kbi][r] = p; sum += p; }
    sum += __shfl_xor(sum, 32); sum += __builtin_amdgcn_exp2f(sink2 - m);
    wsf[i] = 1.0f / sum;
    O[0] = (f32x16){0.f, 0.f, 0.f, 0.f, 0.f, 0.f, 0.f, 0.f, 0.f, 0.f, 0.f, 0.f, 0.f, 0.f, 0.f, 0.f}; O[1] = O[0];
#pragma unroll
    for (int kbi = 0; kbi < 5; ++kbi)
#pragma unroll
        for (int s = 0; s < 2; ++s) {
            v4u pw; pw.x = pg8::cvt_pk_bf16(S[kbi][8 * s + 0], S[kbi][8 * s + 1]); pw.y = pg8::cvt_pk_bf16(S[kbi][8 * s + 2], S[kbi][8 * s + 3]); pw.z = pg8::cvt_pk_bf16(S[kbi][8 * s + 4], S[kbi][8 * s + 5]); pw.w = pg8::cvt_pk_bf16(S[kbi][8 * s + 6], S[kbi][8 * s + 7]);
            const bf16x8 pf = __builtin_bit_cast(bf16x8, pw);
#pragma unroll
            for (int dt = 0; dt < 2; ++dt) {
                const LAS unsigned char* vp = Vl + (32 * dt + i) * vstride + (32 * (kb0 + kbi) + 16 * s + 4 * hl) * 2;
                const v2u lo = *(const LAS v2u*)vp, hi = *(const LAS v2u*)(vp + 16);
                v4u vw; vw.x = lo.x; vw.y = lo.y; vw.z = hi.x; vw.w = hi.y;
                O[dt] = MFMA32(pf, __builtin_bit_cast(bf16x8, vw), O[dt]);
            }
        }
    LDS_WAIT(); asm volatile("" ::: "memory");
}
constexpr int AP_KEYS = 192, AP_VSTRIDE = 392, AP_LDS_V = 2 * AP_KEYS * AK_STRIDE, AP_LDS_W = AP_LDS_V + 2 * 64 * AP_VSTRIDE;
static_assert(AP_LDS_W + 8 * 128 <= LDSCTL_OFF, "attention LDS");
struct MaskPrompt { int lo0, hi0, kvmin; __device__ __forceinline__ bool operator()(int kk, int i) const { return kk >= lo0 + i && kk <= hi0 + i && kk >= kvmin; } };
__device__ __forceinline__ void attn_prompt(Frame& F) {
    const bf16* P = (const bf16*)(F.ws + WS_P); bf16* ATT = (bf16*)(F.ws + WS_ATT);
    const int lane = F.lane, i = lane & 31, hl = lane >> 5;
    LAS float* wsf = (LAS float*)(F.lds + AP_LDS_W + F.wave * 128);
    for (int u = F.vcu; u < 256; u += F.G) {
        const int b = u >> 6, j = u & 63, s0 = 64 * j - 128;
        __syncthreads();
        for (int c = F.tid; c < AP_KEYS * 32; c += NWAVES * 64) {
            const int key = c >> 5, cc = c & 31, sk = s0 + key;
            const int row = sk >= 0 ? b * 4096 + sk : (sk >= -16 ? MR + 16 + sk : MR);
            const v4u v = *(const v4u*)(P + (size_t)row * DIN + 512 + cc * 8);
            if (cc < 16) { *(LAS v4u*)(F.lds + ((cc >> 3) * AP_KEYS + key) * AK_STRIDE + (cc & 7) * 16) = v; }
            else { const int c2 = cc - 16; LAS bf16* vt = (LAS bf16*)(F.lds + AP_LDS_V + ((c2 >> 3) * 64 + (c2 & 7) * 8) * AP_VSTRIDE + key * 2);
                vt[0 * (AP_VSTRIDE / 2)] = (bf16)(v.x & 0xffffu); vt[1 * (AP_VSTRIDE / 2)] = (bf16)(v.x >> 16); vt[2 * (AP_VSTRIDE / 2)] = (bf16)(v.y & 0xffffu); vt[3 * (AP_VSTRIDE / 2)] = (bf16)(v.y >> 16);
                vt[4 * (AP_VSTRIDE / 2)] = (bf16)(v.z & 0xffffu); vt[5 * (AP_VSTRIDE / 2)] = (bf16)(v.z >> 16); vt[6 * (AP_VSTRIDE / 2)] = (bf16)(v.w & 0xffffu); vt[7 * (AP_VSTRIDE / 2)] = (bf16)(v.w >> 16); }
        }
        __syncthreads();
        const int h = F.wave, kvh = h >> 2;
        const float sink2 = F.in[I_SINK][h] * LOG2E;
        const LAS unsigned char* Kl = F.lds + kvh * AP_KEYS * AK_STRIDE; const LAS unsigned char* Vl = F.lds + AP_LDS_V + kvh * 64 * AP_VSTRIDE;
#pragma unroll 1
        for (int qh = 0; qh < 2; ++qh) {
            const int qrow0 = b * 4096 + 64 * j + 32 * qh;
            const bf16* qp = P + (size_t)(qrow0 + i) * DIN + h * 64 + 8 * hl;
            bf16x8 qf[4];
#pragma unroll
            for (int kd = 0; kd < 4; ++kd) qf[kd] = *(const bf16x8*)(qp + 16 * kd);
            const MaskPrompt mk{32 * qh + 1, 128 + 32 * qh, 112 - 64 * j};
            f32x16 O[2];
            attn_qblock(Kl, Vl, AP_VSTRIDE, qf, qh, sink2, mk, wsf, O, lane);
#pragma unroll
            for (int r = 0; r < 16; ++r) { const int q = crow(r, hl); const float inv = wsf[q];
                bf16* op = ATT + (size_t)(qrow0 + q) * AW + h * 64 + i;
                op[0] = (bf16)f2bf(O[0][r] * inv); op[32] = (bf16)f2bf(O[1][r] * inv); }
            LDS_WAIT(); asm volatile("" ::: "memory");
        }
    }
    __syncthreads();
}
constexpr int AS_KEYS = 160, AS_VSTRIDE = 328, AS_LDS_V = 2 * AS_KEYS * AK_STRIDE, AS_LDS_W = AS_LDS_V + 2 * 64 * AS_VSTRIDE;
struct MaskSample { __device__ __forceinline__ bool operator()(int kk, int i) const { const int t = i & 3; return kk < 128 ? kk >= t + 1 : (kk < 132 && kk - 128 <= t); } };
__device__ __forceinline__ void attn_sample(Frame& F) {
    const bf16* P = (const bf16*)(F.ws + WS_P); bf16* ATT = (bf16*)(F.ws + WS_ATT);
    const int lane = F.lane, i = lane & 31, hl = lane >> 5;
    LAS float* wsf = (LAS float*)(F.lds + AS_LDS_W + F.wave * 128);
    for (int db = F.vcu; db < 128; db += F.G) {
        __syncthreads();
        for (int c = F.tid; c < AS_KEYS * 32; c += NWAVES * 64) {
            const int key = c >> 5, cc = c & 31, c2 = cc & 15, kvh = c2 >> 3, d0 = (c2 & 7) * 8;
            float f[8];
            if (key < 128) { const float* src = (cc < 16 ? F.in[I_CK] : F.in[I_CV]) + ((size_t)(db * 128 + key) * 2 + kvh) * 64 + d0;
                const f32x4 a = *(const f32x4*)src, bq = *(const f32x4*)(src + 4); f[0] = a.x; f[1] = a.y; f[2] = a.z; f[3] = a.w; f[4] = bq.x; f[5] = bq.y; f[6] = bq.z; f[7] = bq.w; }
            else if (key < 132) { unpack8(*(const v4u*)(P + (size_t)(MP + db * 4 + key - 128) * DIN + (cc < 16 ? 512 : 640) + kvh * 64 + d0), f); }
            else {
#pragma unroll
                for (int e = 0; e < 8; ++e) f[e] = 0.f; }
            if (cc < 16) { *(LAS v4u*)(F.lds + (kvh * AS_KEYS + key) * AK_STRIDE + d0 * 2) = pack8(f); }
            else { LAS bf16* vt = (LAS bf16*)(F.lds + AS_LDS_V + (kvh * 64 + d0) * AS_VSTRIDE + key * 2);
#pragma unroll
                for (int e = 0; e < 8; ++e) vt[e * (AS_VSTRIDE / 2)] = (bf16)f2bf(f[e]); }
        }
        __syncthreads();
        if (F.wave < 2) {
            const int kvh = F.wave, t = i & 3, gq = (i >> 2) & 3, h = kvh * 4 + gq;
            const float sink2 = F.in[I_SINK][h] * LOG2E;
            const bf16* qp = P + (size_t)(MP + db * 4 + t) * DIN + h * 64 + 8 * hl;
            bf16x8 qf[4];
#pragma unroll
            for (int kd = 0; kd < 4; ++kd) qf[kd] = *(const bf16x8*)(qp + 16 * kd);
            const MaskSample mk{};
            f32x16 O[2];
            attn_qblock(F.lds + kvh * AS_KEYS * AK_STRIDE, F.lds + AS_LDS_V + kvh * 64 * AS_VSTRIDE, AS_VSTRIDE, qf, 0, sink2, mk, wsf, O, lane);
#pragma unroll
            for (int r = 0; r < 16; ++r) { const int q = crow(r, hl);
                if (q < 16) { const float inv = wsf[q];
                    bf16* op = ATT + (size_t)(MP + db * 4 + (q & 3)) * AW + (kvh * 4 + (q >> 2)) * 64 + i;
                    op[0] = (bf16)f2bf(O[0][r] * inv); op[32] = (bf16)f2bf(O[1][r] * inv); } }
            LDS_WAIT(); asm volatile("" ::: "memory");
        }
    }
    __syncthreads();
}
#ifndef MK_N_LAUNCHES
#define MK_N_LAUNCHES 1
#endif
constexpr int N_PHASES = 13;
struct Args { const float* in[27]; float* out; unsigned char* ws; int ph_lo, ph_hi; };
__global__ void __launch_bounds__(NWAVES * 64, 2) hymba_fwd(Args args) {
    extern __shared__ __attribute__((aligned(16))) unsigned char lds[];
    Frame F;
    F.lds = (LAS unsigned char*)lds;
    F.MISC = (volatile LAS unsigned*)(F.lds + MISC_OFF);
    F.tid = threadIdx.x; F.lane = F.tid & 63; F.wave = __builtin_amdgcn_readfirstlane(F.tid >> 6);
    F.G = gridDim.x; { const int bx = blockIdx.x; F.vcu = (F.G % 8 == 0) ? (bx % 8) * (F.G / 8) + bx / 8 : bx; }
#pragma unroll
    for (int i = 0; i < 27; ++i) F.in[i] = args.in[i];
    F.out = args.out; F.ws = args.ws; F.ctl = (gu32*)(args.ws + WS_CTL);
    for (int u = F.tid; u < (LDS_BYTES - LDSCTL_OFF) / 4; u += NWAVES * 64) ((LAS unsigned*)(F.lds + LDSCTL_OFF))[u] = 0u;
    __syncthreads();
    const int lo = args.ph_lo, hi = args.ph_hi;
    const bool one = (hi - lo) > 1;
    XcdBarrier bar; bar.bar = (unsigned*)(F.ctl + CW_BAR); bar.x = 0; bar.st = nullptr;
    if (one) bar = xcd_barrier_post((unsigned*)(F.ctl + CW_BAR), F.MISC + 8);
#define IN(k) (lo <= (k) && (k) < hi)
#define SEAM(k) do { if (IN(k) && IN((k) + 1)) xcd_barrier(bar); } while (0)
    bf16* const XN = (bf16*)(F.ws + WS_XN); bf16* const OB = (bf16*)(F.ws + WS_O); bf16* const PB = (bf16*)(F.ws + WS_P);
    if (IN(0)) { p0_prologue(F); p0_ssm_tables(F); } SEAM(0);
    if (IN(1)) { pg8::Gemm g{XN, (const bf16*)(F.ws + WS_WIN), MIN_ROWS, DIN, D}; pg8::StaticOrder S; S.init(MIN_ROWS, DIN, F.G, (int)blockIdx.x);
        pg8::EpiBf16<0> E{PB, DIN}; pg8::gemm_phase<pg8::EpiBf16<0>, pg8::StaticOrder, true, true>(F.lds, g, S, E); } SEAM(1);
    if (IN(2)) { p2_rope(F); } SEAM(2);
    if (IN(3)) { s1_hloc(F); __syncthreads(); s1_small_seqs(F); attn_prompt(F); attn_sample(F); p3_windows(F); } SEAM(3);
    if (IN(4)) { s2_scan(F); } SEAM(4);
    if (IN(5)) { s3_y(F); } SEAM(5);
    if (IN(6)) { pg8::Gemm g{(const bf16*)(F.ws + WS_Z), (const bf16*)(F.ws + WS_WGLU), MR, SW, SW}; pg8::StaticOrder S; S.init(MR, SW, F.G, (int)blockIdx.x);
        pg8::EpiBf16<0> E{(bf16*)(F.ws + WS_GL), SW}; pg8::gemm_phase<pg8::EpiBf16<0>, pg8::StaticOrder, true, true>(F.lds, g, S, E); } SEAM(6);
    if (IN(7)) { p5_mixnorm(F); } SEAM(7);
    if (IN(8)) { pg8::Gemm g{(const bf16*)(F.ws + WS_CAT), (const bf16*)(F.ws + WS_WOUT), MR, D, D}; pg8::StaticOrder S; S.init(MR, D, F.G, (int)blockIdx.x);
        pg8::EpiBf16<0> E{OB, D}; pg8::gemm_phase<pg8::EpiBf16<0>, pg8::StaticOrder, true, true>(F.lds, g, S, E); } SEAM(8);
    if (IN(9)) { p7_mid(F); } SEAM(9);
    if (IN(10)) { pg8::Gemm g{XN, (const bf16*)(F.ws + WS_WUP), MR, DFF, D}; pg8::StaticOrder S; S.init(MR, DFF, F.G, (int)blockIdx.x);
        pg8::EpiBf16<2> E{(bf16*)(F.ws + WS_H), DFF}; pg8::gemm_phase<pg8::EpiBf16<2>, pg8::StaticOrder, true, true>(F.lds, g, S, E); } SEAM(10);
    if (IN(11)) { pg8::Gemm g{(const bf16*)(F.ws + WS_H), (const bf16*)(F.ws + WS_WDN), MR, D, DFF}; pg8::StaticOrder S; S.init(MR, D, F.G, (int)blockIdx.x);
        pg8::EpiBf16<0> E{OB, D}; pg8::gemm_phase<pg8::EpiBf16<0>, pg8::StaticOrder, true, true>(F.lds, g, S, E); } SEAM(11);
    if (IN(12)) { p10_final(F); }
#undef IN
#undef SEAM
}

extern "C" void kernel_launch(void* const* d_in, const int* in_sizes, int n_in, void* d_out, int out_size, void* d_ws, size_t ws_size, hipStream_t stream) {
    static int grid = 0;
    if (grid == 0) {
        if (n_in != 27 || ws_size < WS_TOP) { fprintf(stderr, "kernel_launch: unexpected n_in %d / ws %zu\n", n_in, ws_size); grid = -1; return; }
        int dev = 0, cus = 0, per_cu = 0;
        if (hipGetDevice(&dev) != hipSuccess || hipDeviceGetAttribute(&cus, hipDeviceAttributeMultiprocessorCount, dev) != hipSuccess) { grid = -1; return; }
        if (hipFuncSetAttribute((const void*)hymba_fwd, hipFuncAttributeMaxDynamicSharedMemorySize, LDS_BYTES) != hipSuccess) { fprintf(stderr, "kernel_launch: hipFuncSetAttribute failed\n"); grid = -1; return; }
        if (hipOccupancyMaxActiveBlocksPerMultiprocessor(&per_cu, (const void*)hymba_fwd, NWAVES * 64, LDS_BYTES) != hipSuccess || per_cu < 1) { fprintf(stderr, "kernel_launch: occupancy query says %d\n", per_cu); per_cu = 1; }
        (void)hipGetLastError();
        grid = cus;
    }
    if (grid < 0) return;
    (void)hipMemsetAsync((char*)d_ws + WS_CTL, 0, CTL_ZERO_BYTES, stream);
    Args a{};
    for (int i = 0; i < 27; ++i) a.in[i] = (const float*)d_in[i];
    a.out = (float*)d_out; a.ws = (unsigned char*)d_ws;
#if MK_N_LAUNCHES == 1
    a.ph_lo = 0; a.ph_hi = N_PHASES;
    void* kargs[] = {&a};
    hipError_t e = hipLaunchCooperativeKernel((const void*)hymba_fwd, dim3(grid), dim3(NWAVES * 64), kargs, LDS_BYTES, stream);
    if (e != hipSuccess) fprintf(stderr, "kernel_launch: cooperative launch failed: %s (grid %d)\n", hipGetErrorString(e), grid);
#else
    for (int p = 0; p < N_PHASES; ++p) { a.ph_lo = p; a.ph_hi = p + 1; hipLaunchKernelGGL(hymba_fwd, dim3(grid), dim3(NWAVES * 64), LDS_BYTES, stream, a); }
#endif
}
```

```cpp
#include <hip/hip_runtime.h>
#include <cstdio>
#include <cstdint>
namespace pg8 {
#define PG8_LAS __attribute__((address_space(3)))
typedef unsigned short bf16_t;
typedef short bf16x8 __attribute__((ext_vector_type(8)));
typedef float f32x4 __attribute__((ext_vector_type(4)));
typedef unsigned u32x4 __attribute__((ext_vector_type(4)));
constexpr int BM = 256, BK = 64, HALF = 128, HTB = HALF * BK * 2  , STAGE_BYTES = 8 * HTB, NXCD = 8, WGM = 8;

__host__ __device__ __forceinline__ int lds_byte(int r, int c) { const int st = (r >> 4) * 2 + (c >> 5), rr = r & 15, cc = c & 31, ob = rr * 64 + cc * 2; return st * 1024 + (ob ^ (((ob >> 9) & 1) << 5)); }
__host__ __device__ __forceinline__ void stage_rc(int b, int& R, int& C) { const int st = b / 1024, sb = b % 1024, swz = sb ^ (((sb >> 9) & 1) << 5); R = (st >> 1) * 16 + swz / 64; C = (st & 1) * 32 + (swz % 64) / 2; }
__host__ __device__ __forceinline__ int perm32(int rho) { const int n = rho >> 4, i = rho & 15; return 8 * (i >> 2) + 4 * n + (i & 3); }

struct Unit { int pm, pn; };
struct Gemm { const bf16_t* A; const bf16_t* Bt; int M, N, K; };

struct StaticOrder {
    int nM, nN, nwg, G, c;
    __host__ __device__ void init(int M, int N, int G_, int c_) { nM = M / BM; nN = N / BM; nwg = nM * nN; G = G_; c = c_; }
    __host__ __device__ bool next(int i, Unit& u) const {
        const long L = (long)i * G + c; if (L >= nwg) return false;
        int wgid = (int)L; { const int q = nwg / NXCD, r = nwg % NXCD, xcd = wgid % NXCD, off = wgid / NXCD; wgid = (xcd < r ? xcd * (q + 1) : r * (q + 1) + (xcd - r) * q) + off; }
        const int nig = WGM * nN, gid = wgid / nig, fm = gid * WGM, gsz = (nM - fm) < WGM ? (nM - fm) : WGM;
        u.pm = fm + ((wgid % nig) % gsz); u.pn = (wgid % nig) / gsz; return true;
    }
    __device__ __forceinline__ void a_ready(const Unit&) const {}
    __device__ __forceinline__ void done(const Unit&) const {}
};
__device__ __forceinline__ unsigned cvt_pk_bf16(float lo, float hi) { unsigned r; asm volatile("v_cvt_pk_bf16_f32 %0, %1, %2" : "=v"(r) : "v"(lo), "v"(hi)); return r; }
template <int ACT> struct EpiBf16 {
    static constexpr bool PERM = true, AFTER_DRAIN = false;
    bf16_t* O; int ldc;
    __device__ __forceinline__ void operator()(const f32x4 (&acc)[2][2][4][2], const Unit& u, int wr, int wc, int fr, int fq) const {
        const int row0 = u.pm * BM + wr * 64 + fr; const int col0 = u.pn * BM + wc * 32 + 8 * fq;
#pragma unroll
        for (int ai = 0; ai < 2; ++ai)
#pragma unroll
            for (int m = 0; m < 4; ++m) { bf16_t* rowp = O + (size_t)(row0 + ai * HALF + m * 16) * ldc + col0;
#pragma unroll
                for (int bj = 0; bj < 2; ++bj) { f32x4 v0 = acc[ai][bj][m][0], v1 = acc[ai][bj][m][1];
                    if (ACT == 2) {
#pragma unroll
                        for (int e = 0; e < 4; ++e) { const float a = fmaxf(v0[e], 0.f), b = fmaxf(v1[e], 0.f); v0[e] = a * a; v1[e] = b * b; } }
                    u32x4 w; w.x = cvt_pk_bf16(v0[0], v0[1]); w.y = cvt_pk_bf16(v0[2], v0[3]); w.z = cvt_pk_bf16(v1[0], v1[1]); w.w = cvt_pk_bf16(v1[2], v1[3]);
                    *(u32x4*)(rowp + bj * HALF) = w; } }
    }
};
template <class Epi, class Sched, bool ALIGN_EPI = false, bool SP2 = false>
__device__ __forceinline__ void gemm_phase(PG8_LAS unsigned char* lds, const Gemm g, const Sched& S, const Epi& E) {
    const int tid = threadIdx.x, wid = __builtin_amdgcn_readfirstlane(tid >> 6), lane = tid & 63, wr = wid >> 2, wc = wid & 3, fr = lane & 15, fq = lane >> 4;
    const int K = g.K, nt = K / BK;
    unsigned voffA[2], voffB[2];
#pragma unroll
    for (int i = 0; i < 2; ++i) { int R, C; stage_rc(tid * 16 + i * 8192, R, C); const int Rb = Epi::PERM ? ((R & ~31) + perm32(R & 31)) : R;
        voffA[i] = (unsigned)(R * K + C) * 2u; voffB[i] = (unsigned)(Rb * K + C) * 2u; }
    const size_t kstep = (size_t)(BK * 2);
    const size_t hstep = (size_t)HALF * K * 2;
    const size_t tstep = 2 * hstep;
    const unsigned ldsw = (unsigned)wid * 1024u;
    const int aoff = lds_byte(wr * 64 + fr, fq * 8), boff = lds_byte(wc * 32 + fr, fq * 8);
#define PG8_SA(b, h) (((b) * 2 + (h)) * HTB)
#define PG8_SB(b, h) ((4 + (b) * 2 + (h)) * HTB)
#define PG8_STAGE(bufoff, gbase, voff) do { _Pragma("unroll") for (int _i = 0; _i < 2; ++_i) \
        __builtin_amdgcn_global_load_lds((const unsigned*)((const char*)(gbase) + (voff)[_i]), (PG8_LAS unsigned*)(lds + (bufoff) + ldsw + _i * 8192), 16, 0, 0); } while (0)
#define PG8_LDA(dst, b, h) do { _Pragma("unroll") for (int m = 0; m < 4; ++m) _Pragma("unroll") for (int k = 0; k < 2; ++k) dst[m][k] = *(const PG8_LAS bf16x8*)(lds + PG8_SA(b, h) + aoff + m * 2048 + k * 1024); } while (0)
#define PG8_LDB(dst, b, h) do { _Pragma("unroll") for (int n = 0; n < 2; ++n) _Pragma("unroll") for (int k = 0; k < 2; ++k) dst[n][k] = *(const PG8_LAS bf16x8*)(lds + PG8_SB(b, h) + boff + n * 2048 + k * 1024); } while (0)
#define PG8_MMA(ai, bj, At, Bt) do { __builtin_amdgcn_s_setprio(1); _Pragma("unroll") for (int m = 0; m < 4; ++m) _Pragma("unroll") for (int n = 0; n < 2; ++n) _Pragma("unroll") for (int k = 0; k < 2; ++k) \
        acc[ai][bj][m][n] = __builtin_amdgcn_mfma_f32_16x16x32_bf16(Bt[n][k], At[m][k], acc[ai][bj][m][n], 0, 0, 0); __builtin_amdgcn_s_setprio(0); } while (0)
#define PG8_WAIT_V(n) asm volatile("s_waitcnt vmcnt(" #n ")" ::: "memory")
#define PG8_WAIT_L(n) asm volatile("s_waitcnt lgkmcnt(" #n ")" ::: "memory")
#define PG8_BAR __builtin_amdgcn_s_barrier()
#define PG8_SCHED __builtin_amdgcn_sched_barrier(0)
    Unit cur, nxt; int ui = 0;
    if (!S.next(0, cur)) return;
    f32x4 acc[2][2][4][2];
#pragma unroll
    for (int a = 0; a < 2; ++a)
#pragma unroll
        for (int b = 0; b < 2; ++b)
#pragma unroll
            for (int m = 0; m < 4; ++m)
#pragma unroll
                for (int n = 0; n < 2; ++n) acc[a][b][m][n] = (f32x4){0.f, 0.f, 0.f, 0.f};
    bf16x8 At[4][2], B0[2][2], B1[2][2];
    const char* cA = (const char*)g.A + (size_t)cur.pm * tstep; const char* cB = (const char*)g.Bt + (size_t)cur.pn * tstep;
    S.a_ready(cur);
    if constexpr (SP2) {
        PG8_STAGE(PG8_SB(0, 0), cB, voffB); PG8_STAGE(PG8_SB(0, 1), cB + hstep, voffB); PG8_STAGE(PG8_SA(0, 0), cA, voffA); PG8_STAGE(PG8_SA(0, 1), cA + hstep, voffA);
        if (wr == 1) PG8_BAR;
        PG8_WAIT_V(2); PG8_BAR;
        PG8_STAGE(PG8_SB(1, 0), cB + kstep, voffB); PG8_STAGE(PG8_SA(1, 0), cA + kstep, voffA); PG8_STAGE(PG8_SB(1, 1), cB + hstep + kstep, voffB);
        PG8_WAIT_V(6); PG8_BAR;
    } else {
        PG8_STAGE(PG8_SB(0, 0), cB, voffB); PG8_STAGE(PG8_SA(0, 0), cA, voffA); PG8_STAGE(PG8_SB(0, 1), cB + hstep, voffB); PG8_STAGE(PG8_SA(0, 1), cA + hstep, voffA);
        if (wr == 1) PG8_BAR;
        PG8_WAIT_V(4); PG8_BAR;
        PG8_STAGE(PG8_SB(1, 0), cB + kstep, voffB); PG8_STAGE(PG8_SA(1, 0), cA + kstep, voffA); PG8_STAGE(PG8_SB(1, 1), cB + hstep + kstep, voffB);
        PG8_WAIT_V(6); PG8_BAR;
    }
    for (;;) {
        const bool has_next = S.next(ui + 1, nxt);
        const char* nA = has_next ? (const char*)g.A + (size_t)nxt.pm * tstep : cA; const char* nB = has_next ? (const char*)g.Bt + (size_t)nxt.pn * tstep : cB;
        for (int t = 0; t < nt; t += 2) {
            const bool last = (t == nt - 2);
            const char* a1 = cA + (size_t)(t + 1) * kstep;
            const char* a2 = last ? nA : cA + (size_t)(t + 2) * kstep; const char* b2 = last ? nB : cB + (size_t)(t + 2) * kstep;
            const char* a3 = a2 + kstep; const char* b3 = b2 + kstep;
            if (last && has_next) S.a_ready(nxt);
            if constexpr (SP2) {
            PG8_LDB(B0, 0, 0); PG8_LDB(B1, 0, 1); PG8_SCHED; PG8_LDA(At, 0, 0); PG8_STAGE(PG8_SA(1, 1), a1 + hstep, voffA);
            PG8_WAIT_V(8); PG8_WAIT_L(0); PG8_BAR; PG8_MMA(0, 0, At, B0); PG8_MMA(0, 1, At, B1); PG8_BAR; PG8_SCHED;
            PG8_LDA(At, 0, 1); PG8_STAGE(PG8_SB(0, 0), b2, voffB); PG8_STAGE(PG8_SB(0, 1), b2 + hstep, voffB); PG8_STAGE(PG8_SA(0, 0), a2, voffA);
            PG8_WAIT_V(8); PG8_WAIT_L(0); PG8_BAR; PG8_MMA(1, 0, At, B0); PG8_MMA(1, 1, At, B1); PG8_BAR; PG8_SCHED;
            PG8_LDB(B0, 1, 0); PG8_LDB(B1, 1, 1); PG8_SCHED; PG8_LDA(At, 1, 0); PG8_STAGE(PG8_SA(0, 1), a2 + hstep, voffA);
            PG8_WAIT_V(8); PG8_WAIT_L(0); PG8_BAR; PG8_MMA(0, 0, At, B0); PG8_MMA(0, 1, At, B1); PG8_BAR; PG8_SCHED;
            PG8_LDA(At, 1, 1); PG8_STAGE(PG8_SB(1, 0), b3, voffB); PG8_STAGE(PG8_SB(1, 1), b3 + hstep, voffB); PG8_STAGE(PG8_SA(1, 0), a3, voffA);
            PG8_WAIT_V(8); PG8_WAIT_L(0); PG8_BAR; PG8_MMA(1, 0, At, B0); PG8_MMA(1, 1, At, B1); PG8_BAR; PG8_SCHED;
            } else {
            PG8_LDB(B0, 0, 0); PG8_SCHED; PG8_LDA(At, 0, 0); PG8_STAGE(PG8_SA(1, 1), a1 + hstep, voffA);
            PG8_WAIT_L(8); PG8_BAR; PG8_WAIT_L(0); PG8_MMA(0, 0, At, B0); PG8_BAR; PG8_SCHED;
            PG8_LDB(B1, 0, 1); PG8_STAGE(PG8_SB(0, 0), b2, voffB);
            PG8_BAR; PG8_WAIT_L(0); PG8_MMA(0, 1, At, B1); PG8_BAR;
            PG8_LDA(At, 0, 1); PG8_STAGE(PG8_SA(0, 0), a2, voffA);
            PG8_BAR; PG8_WAIT_L(0); PG8_MMA(1, 0, At, B0); PG8_BAR; PG8_SCHED;
            PG8_STAGE(PG8_SB(0, 1), b2 + hstep, voffB);
            PG8_WAIT_V(6); PG8_BAR; PG8_MMA(1, 1, At, B1); PG8_BAR;
            PG8_LDB(B0, 1, 0); PG8_SCHED; PG8_LDA(At, 1, 0); PG8_STAGE(PG8_SA(0, 1), a2 + hstep, voffA);
            PG8_WAIT_L(8); PG8_BAR; PG8_WAIT_L(0); PG8_MMA(0, 0, At, B0); PG8_BAR; PG8_SCHED;
            PG8_LDB(B1, 1, 1); PG8_STAGE(PG8_SB(1, 0), b3, voffB);
            PG8_BAR; PG8_WAIT_L(0); PG8_MMA(0, 1, At, B1); PG8_BAR;
            PG8_LDA(At, 1, 1); PG8_STAGE(PG8_SA(1, 0), a3, voffA);
            PG8_BAR; PG8_WAIT_L(0); PG8_MMA(1, 0, At, B0); PG8_BAR; PG8_SCHED;
            PG8_STAGE(PG8_SB(1, 1), b3 + hstep, voffB);
            PG8_WAIT_V(6); PG8_BAR; PG8_MMA(1, 1, At, B1); PG8_BAR;
            }
        }
        if constexpr (ALIGN_EPI) { if (wr == 0) PG8_BAR; }
        if constexpr (!Epi::AFTER_DRAIN) { E(acc, cur, wr, wc, fr, fq); S.done(cur); }
        if (!has_next) break;
#pragma unroll
        for (int a = 0; a < 2; ++a)
#pragma unroll
            for (int b = 0; b < 2; ++b)
#pragma unroll
                for (int m = 0; m < 4; ++m)
#pragma unroll
                    for (int n = 0; n < 2; ++n) acc[a][b][m][n] = (f32x4){0.f, 0.f, 0.f, 0.f};
        cur = nxt; cA = nA; cB = nB; ++ui;
        if constexpr (ALIGN_EPI) { if (wr == 1) PG8_BAR; }
    }
    PG8_WAIT_V(0);
    if constexpr (!ALIGN_EPI) { if (wr == 0) PG8_BAR; }
    PG8_BAR;
    if constexpr (Epi::AFTER_DRAIN) { E.fused(acc, cur, wr, wc, fr, fq, lds, wid, lane); S.done(cur); }
#undef PG8_SA
#undef PG8_SB
#undef PG8_STAGE
#undef PG8_LDA
#undef PG8_LDB
#undef PG8_MMA
#undef PG8_WAIT_V
#undef PG8_WAIT_L
#undef PG8_BAR
#undef PG8_SCHED
}
}

constexpr int NWAVES = 8;
constexpr int D = 1024, DIN = 1280, DFF = 4096, AW = 512, SW = 512;
constexpr int MP = 16384, MS = 512, MR = MP + MS;
constexpr int MMETA = MR, NMETA = 16, MIN_ROWS = 17152;
constexpr int NPOS = 4112 + 4;
constexpr float EPS = 1e-6f;
constexpr size_t O_YP = 0, O_YS = 16777216, O_KP = 17301504, O_VP = 17367040, O_SRP = 17432576, O_SIP = 17440768, O_KS = 17448960, O_VS = 19546112, O_SRS = 21643264, O_SIS = 21905408;
constexpr size_t MiB = 1u << 20;
constexpr size_t WS_CTL = 0, CTL_ZERO_BYTES = 1 * MiB;
constexpr size_t WS_ROPEC = 1 * MiB, WS_ROPES = WS_ROPEC + 160 * 1024, WS_ABR = WS_ROPES + 160 * 1024, WS_ABI = WS_ABR + 8192, WS_BBR = WS_ABI + 8192, WS_BBI = WS_BBR + 131072;
static_assert(WS_BBI + 131072 <= 2 * MiB && NPOS * 8 * 4 <= 160 * 1024, "tables");
constexpr size_t WS_WIN = 2 * MiB, WS_WGLU = 5 * MiB, WS_WOUT = 6 * MiB, WS_WUP = 8 * MiB, WS_WDN = 16 * MiB;
constexpr size_t WS_XN = 24 * MiB, WS_O = 58 * MiB, WS_P = 92 * MiB, WS_ATT = 134 * MiB, WS_Z = 151 * MiB, WS_GL = 168 * MiB, WS_CAT = 185 * MiB, WS_H = 92 * MiB, WS_END = 224 * MiB;
constexpr size_t WS_VT = 224 * MiB, WS_QT = 228 * MiB, WS_KC = 232 * MiB, WS_HL = 233 * MiB, WS_HIN = 241 * MiB, WS_HM = 245 * MiB, WS_A32 = WS_HM + 16384, WS_TOP = 246 * MiB;
static_assert(WS_XN + (size_t)MIN_ROWS * D * 2 <= WS_O && WS_O + (size_t)MR * D * 2 <= WS_P && WS_P + (size_t)MIN_ROWS * DIN * 2 <= WS_ATT && WS_ATT + (size_t)MR * AW * 2 <= WS_Z && WS_Z + (size_t)MR * SW * 2 <= WS_GL &&
              WS_GL + (size_t)MR * SW * 2 <= WS_CAT && WS_CAT + (size_t)MR * D * 2 <= WS_END && WS_H + (size_t)MR * DFF * 2 <= WS_END, "d_ws map");
constexpr int CW_BAR = 4096;
constexpr int RING_BYTES = 131072, LDS_BYTES = 163840, LDSCTL_OFF = LDS_BYTES - 512, MISC_OFF = LDSCTL_OFF + 320;

#define GAS __attribute__((address_space(1)))
#define LAS __attribute__((address_space(3)))
typedef unsigned short bf16;
typedef unsigned v4u __attribute__((ext_vector_type(4)));
typedef unsigned v2u __attribute__((ext_vector_type(2)));
typedef float f32x4 __attribute__((ext_vector_type(4)));
typedef GAS unsigned gu32;
#define RLX_AGENT __ATOMIC_RELAXED, __HIP_MEMORY_SCOPE_AGENT
#define LDS_WAIT() asm volatile("s_waitcnt lgkmcnt(0)" ::: "memory")
#define VM_WAIT() asm volatile("s_waitcnt vmcnt(0)" ::: "memory")
__device__ __forceinline__ unsigned f2bf(float f) { unsigned u = __builtin_bit_cast(unsigned, f); return (u + 0x7fffu + ((u >> 16) & 1u)) >> 16; }
__device__ __forceinline__ unsigned pk2(float lo, float hi) { return f2bf(lo) | (f2bf(hi) << 16); }
__device__ __forceinline__ float bflo(unsigned w) { return __uint_as_float(w << 16); }
__device__ __forceinline__ float bfhi(unsigned w) { return __uint_as_float(w & 0xffff0000u); }
__device__ __forceinline__ float bf1(bf16 b) { return __uint_as_float((unsigned)b << 16); }

#define XB_TMO      128
#define XB_XCNT(j)  (256  + 64 * (j))
#define XB_XSUB(j)  (1280 + 64 * (j))
#define XB_XGEN(j)  (2304 + 64 * (j))
#define XB_TOP      3328
#define XB_TOPGEN   3392
#define XCD_BAR_WORDS 3456
#define XB_SPIN_CAP (1u << 18)
__device__ __forceinline__ unsigned xb_ld(unsigned* p)              { return __hip_atomic_load(p, __ATOMIC_RELAXED, __HIP_MEMORY_SCOPE_AGENT); }
__device__ __forceinline__ unsigned xb_add(unsigned* p, unsigned v) { return __hip_atomic_fetch_add(p, v, __ATOMIC_RELAXED, __HIP_MEMORY_SCOPE_AGENT); }
__device__ __forceinline__ unsigned xb_xcc_id() { return (unsigned)__builtin_amdgcn_s_getreg((3 << 11) | 20) & 0xFu; }
#define XB_SPIN(cond, bar) do { unsigned _sp = 0; while (cond) { __builtin_amdgcn_s_sleep(1); \
    if ((++_sp & 255u) == 0u) { if (xb_ld(&(bar)[XB_TMO])) break; if (_sp > XB_SPIN_CAP) { atomicAdd(&(bar)[XB_TMO], 1u); break; } } } } while (0)
struct XcdBarrier { unsigned* bar; unsigned x; volatile LAS unsigned* st; };
__device__ __forceinline__ XcdBarrier xcd_barrier_post(unsigned* bar, volatile LAS unsigned* st) {
    XcdBarrier b; b.bar = bar; b.x = xb_xcc_id(); b.st = st;
    if (threadIdx.x == 0) (void)xb_add(&bar[XB_XCNT(b.x)], 1u);
    return b;
}
__device__ __forceinline__ void xcd_barrier_complete(unsigned* bar, unsigned x, unsigned& nloc, unsigned& nx) {
    const unsigned G = gridDim.x * gridDim.y * gridDim.z;
    unsigned sum, cnt, mine, sp = 0u;
    for (;;) {
        sum = 0u; cnt = 0u; mine = 0u;
#pragma unroll
        for (unsigned j = 0; j < 16; ++j) { const unsigned c = xb_ld(&bar[XB_XCNT(j)]); sum += c; cnt += (c > 0u) ? 1u : 0u; mine = (j == x) ? c : mine; }
        if (sum == G) break;
        __builtin_amdgcn_s_sleep(1);
        if ((++sp & 255u) == 0u) { if (xb_ld(&bar[XB_TMO])) break; if (sp > XB_SPIN_CAP) { atomicAdd(&bar[XB_TMO], 1u); break; } }
    }
    nloc = mine > 0u ? mine : 1u; nx = cnt > 0u ? cnt : 1u;
}
__device__ __forceinline__ void xcd_barrier(const XcdBarrier& b) {
    asm volatile("s_waitcnt vmcnt(0)" ::: "memory");
    __syncthreads();
    if (threadIdx.x == 0) {
        unsigned* bar = b.bar;
        __builtin_amdgcn_s_waitcnt(0);
        unsigned nloc = b.st[0], nx = b.st[1];
        if (nloc == 0u) { xcd_barrier_complete(bar, b.x, nloc, nx); b.st[0] = nloc; b.st[1] = nx; }
        const unsigned old = xb_add(&bar[XB_XSUB(b.x)], 1u);
        const unsigned gen = old / nloc;
        if (old + 1u == (gen + 1u) * nloc) {
            __builtin_amdgcn_fence(__ATOMIC_RELEASE, "agent");
            asm volatile("s_waitcnt vmcnt(0)" ::: "memory");
            const unsigned og = xb_add(&bar[XB_TOP], 1u);
            const unsigned tg = og / nx;
            if (og + 1u == (tg + 1u) * nx) xb_add(&bar[XB_TOPGEN], 1u);
            else XB_SPIN(xb_ld(&bar[XB_TOPGEN]) == tg, bar);
            __builtin_amdgcn_fence(__ATOMIC_ACQUIRE, "agent");
            xb_add(&bar[XB_XGEN(b.x)], 1u);
            asm volatile("s_waitcnt vmcnt(0)" ::: "memory");
        } else {
            XB_SPIN(xb_ld(&bar[XB_XGEN(b.x)]) == gen, bar);
            __builtin_amdgcn_fence(__ATOMIC_ACQUIRE, "agent");
            asm volatile("s_waitcnt vmcnt(0)" ::: "memory");
        }
    }
    __syncthreads();
}

struct Frame {
    LAS unsigned char* lds;
    volatile LAS unsigned* MISC;
    gu32* ctl;
    int tid, lane, wave;
    int vcu, G;
    const float* in[27]; float* out; unsigned char* ws;
};
enum { I_XP = 0, I_XS, I_CK, I_CV, I_SRE, I_SIM, I_META, I_GPRE, I_WIN, I_SINK, I_ARE, I_AIM, I_LDT, I_BRE, I_BIM, I_CRE, I_CIM, I_DD, I_WGLU, I_GATT, I_GSSM, I_WOUT, I_GPOST, I_GMLP, I_WUP, I_WDN, I_GMLPP };

__device__ __forceinline__ float wave_sum(float v) {
#pragma unroll
    for (int o = 1; o < 64; o <<= 1) v += __shfl_xor(v, o);
    return v;
}
__device__ __forceinline__ float wave_max(float v) {
#pragma unroll
    for (int o = 1; o < 64; o <<= 1) v = fmaxf(v, __shfl_xor(v, o));
    return v;
}
__device__ __forceinline__ void sincos_d(double a, double& s, double& c) {
    const double k = __builtin_rint(a * 0.63661977236758134308);
    double r = __builtin_fma(-k, 1.57079632679489655800e+00, a);
    r = __builtin_fma(-k, 6.12323399573676603587e-17, r);
    const double r2 = r * r;
    double sp = 1.0 / 6227020800.0; sp = sp * r2 - 1.0 / 39916800.0; sp = sp * r2 + 1.0 / 362880.0; sp = sp * r2 - 1.0 / 5040.0; sp = sp * r2 + 1.0 / 120.0; sp = sp * r2 - 1.0 / 6.0; sp = sp * r2 + 1.0; sp = sp * r;
    double cp = -1.0 / 87178291200.0; cp = cp * r2 + 1.0 / 479001600.0; cp = cp * r2 - 1.0 / 3628800.0; cp = cp * r2 + 1.0 / 40320.0; cp = cp * r2 - 1.0 / 720.0; cp = cp * r2 + 1.0 / 24.0; cp = cp * r2 - 0.5; cp = cp * r2 + 1.0;
    const int q = ((int)k) & 3;
    s = (q == 0) ? sp : (q == 1) ? cp : (q == 2) ? -sp : -cp;
    c = (q == 0) ? cp : (q == 1) ? -sp : (q == 2) ? -cp : sp;
}
__device__ __forceinline__ double exp_d(double x) {
    const double k = __builtin_rint(x * 1.44269504088896340736);
    double r = __builtin_fma(-k, 6.93147180369123816490e-01, x); r = __builtin_fma(-k, 1.90821492927058770002e-10, r);
    double p = 1.0 / 6227020800.0; p = p * r + 1.0 / 479001600.0; p = p * r + 1.0 / 39916800.0; p = p * r + 1.0 / 3628800.0; p = p * r + 1.0 / 362880.0; p = p * r + 1.0 / 40320.0; p = p * r + 1.0 / 5040.0;
    p = p * r + 1.0 / 720.0; p = p * r + 1.0 / 120.0; p = p * r + 1.0 / 24.0; p = p * r + 1.0 / 6.0; p = p * r + 0.5; p = p * r + 1.0; p = p * r + 1.0;
    const long long bits = ((long long)(1023 + (int)k)) << 52;
    return p * __builtin_bit_cast(double, bits);
}
__device__ __forceinline__ float gelu_tanh(float x) {
    const float a = 0.7978845608028654f * (x + 0.044715f * x * x * x);
    const float e = __expf(2.0f * a);
    const float t = 1.0f - 2.0f / (e + 1.0f);
    return 0.5f * x * (1.0f + t);
}
__device__ __forceinline__ float sigmoidf_(float x) { return 1.0f / (1.0f + __expf(-x)); }

__device__ __forceinline__ void p0_transpose_item(const float* W, int K, int N, bf16* WT, LAS float* scr, int item, int lane) {
    const int nblk = N / 32, kb = item / nblk, nb = item % nblk, k0 = 64 * kb, n0 = 32 * nb;
#pragma unroll 8
    for (int i = 0; i < 32; ++i) { const int kk = 2 * i + (lane >> 5); scr[kk * 33 + (lane & 31)] = W[(size_t)(k0 + kk) * N + n0 + (lane & 31)]; }
    LDS_WAIT(); asm volatile("" ::: "memory");
    const int c = lane & 7;
#pragma unroll
    for (int j = 0; j < 4; ++j) { const int n = (lane >> 3) + 8 * j; const LAS float* s = scr + (8 * c) * 33 + n;
        v4u o; o.x = pk2(s[0 * 33], s[1 * 33]); o.y = pk2(s[2 * 33], s[3 * 33]); o.z = pk2(s[4 * 33], s[5 * 33]); o.w = pk2(s[6 * 33], s[7 * 33]);
        *(GAS v4u*)(WT + (size_t)(n0 + n) * K + k0 + 8 * c) = o; }
    LDS_WAIT(); asm volatile("" ::: "memory");
}
__device__ __forceinline__ void rms_row_to_bf16(const float* xrow, const float* g, bf16* orow, int lane) {
    const GAS f32x4* xr = (const GAS f32x4*)xrow + lane;
    f32x4 v[4]; float s = 0.f;
#pragma unroll
    for (int j = 0; j < 4; ++j) { v[j] = xr[64 * j]; s += (v[j].x * v[j].x + v[j].y * v[j].y) + (v[j].z * v[j].z + v[j].w * v[j].w); }
    const float rs = 1.0f / sqrtf(wave_sum(s) * (1.f / 1024.f) + EPS);
    GAS unsigned long long* o8 = (GAS unsigned long long*)orow + lane;
#pragma unroll
    for (int j = 0; j < 4; ++j) { const f32x4 gg = ((const GAS f32x4*)g)[lane + 64 * j];
        o8[64 * j] = (unsigned long long)pk2(v[j].x * rs * gg.x, v[j].y * rs * gg.y) | ((unsigned long long)pk2(v[j].z * rs * gg.z, v[j].w * rs * gg.w) << 32); }
}
__device__ __forceinline__ const float* x_row_ptr(const Frame& F, int r) {
    return r < MP ? F.in[I_XP] + (size_t)r * D : (r < MR ? F.in[I_XS] + (size_t)(r - MP) * D : F.in[I_META] + (size_t)(r - MR) * D);
}
__device__ __forceinline__ void p0_prologue(Frame& F) {
    LAS float* scr = (LAS float*)(F.lds + F.wave * 16384);
    const int gw = F.vcu * NWAVES + F.wave, NGW = F.G * NWAVES;
    constexpr int I_IN = (D / 64) * (DIN / 32), I_GL = (SW / 64) * (SW / 32), I_OU = (D / 64) * (D / 32), I_UP = (D / 64) * (DFF / 32), I_DN = (DFF / 64) * (D / 32);
    constexpr int NITEMS = I_IN + I_GL + I_OU + I_UP + I_DN;
    for (int it = gw; it < NITEMS; it += NGW) {
        int r = it;
        if (r < I_IN) { p0_transpose_item(F.in[I_WIN], D, DIN, (bf16*)(F.ws + WS_WIN), scr, r, F.lane); continue; } r -= I_IN;
        if (r < I_GL) { p0_transpose_item(F.in[I_WGLU], SW, SW, (bf16*)(F.ws + WS_WGLU), scr, r, F.lane); continue; } r -= I_GL;
        if (r < I_OU) { p0_transpose_item(F.in[I_WOUT], D, D, (bf16*)(F.ws + WS_WOUT), scr, r, F.lane); continue; } r -= I_OU;
        if (r < I_UP) { p0_transpose_item(F.in[I_WUP], D, DFF, (bf16*)(F.ws + WS_WUP), scr, r, F.lane); continue; } r -= I_UP;
        p0_transpose_item(F.in[I_WDN], DFF, D, (bf16*)(F.ws + WS_WDN), scr, r, F.lane);
    }
    bf16* XN = (bf16*)(F.ws + WS_XN);
    for (int m = gw; m < MIN_ROWS; m += NGW) {
        if (m < MR + NMETA) rms_row_to_bf16(x_row_ptr(F, m), F.in[I_GPRE], XN + (size_t)m * D, F.lane);
        else { GAS unsigned long long* o8 = (GAS unsigned long long*)(XN + (size_t)m * D) + F.lane;
#pragma unroll
            for (int j = 0; j < 4; ++j) o8[64 * j] = 0ull; }
    }
    const int gt = F.vcu * (NWAVES * 64) + F.tid, NT = F.G * NWAVES * 64;
    float* ropeC = (float*)(F.ws + WS_ROPEC); float* ropeS = (float*)(F.ws + WS_ROPES);
    for (int i = gt; i < NPOS * 8; i += NT) {
        const int idx = i >> 3, fi = i & 7; const int pos = idx < 4112 ? idx : 8192 + (idx - 4112);
        const float inv = (float)exp_d(-(double)fi * 1.640295422175541);
        const float ang = (float)pos * inv;
        double s, c; sincos_d((double)ang, s, c);
        ropeC[i] = (float)c; ropeS[i] = (float)s;
    }
    float* abr = (float*)(F.ws + WS_ABR); float* abi = (float*)(F.ws + WS_ABI); float* bbr = (float*)(F.ws + WS_BBR); float* bbi = (float*)(F.ws + WS_BBI);
    for (int i = gt; i < 2048; i += NT) {
        const int g = i >> 6;
        const double dt = exp_d((double)F.in[I_LDT][g]); const double ar = (double)F.in[I_ARE][i], ai = (double)F.in[I_AIM][i];
        const double mag = exp_d(ar * dt); double s, c; sincos_d(ai * dt, s, c);
        const double are = mag * c, aim = mag * s;
        const double nr = are - 1.0, ni = aim, den = ar * ar + ai * ai;
        const double cr = (nr * ar + ni * ai) / den, ci = (ni * ar - nr * ai) / den;
        abr[i] = (float)are; abi[i] = (float)aim;
        for (int h = 0; h < 16; ++h) { const double br = (double)F.in[I_BRE][i * 16 + h], bi = (double)F.in[I_BIM][i * 16 + h];
            bbr[i * 16 + h] = (float)(cr * br - ci * bi); bbi[i * 16 + h] = (float)(cr * bi + ci * br); }
    }
}
__device__ __forceinline__ int pos_index(int r) { return r < MP ? (r & 4095) + 16 : (r < MR ? 4112 + ((r - MP) & 3) : r - MR); }
__device__ __forceinline__ void p2_rope(Frame& F) {
    const int gt = F.vcu * (NWAVES * 64) + F.tid, NT = F.G * NWAVES * 64;
    bf16* P = (bf16*)(F.ws + WS_P); const float* ropeC = (const float*)(F.ws + WS_ROPEC); const float* ropeS = (const float*)(F.ws + WS_ROPES);
    for (int it = gt; it < (MR + NMETA) * 80; it += NT) {
        const int r = it / 80, rem = it - r * 80, hh = rem >> 3, fi = rem & 7;
        bf16* p = P + (size_t)r * DIN + hh * 64 + fi;
        const float x1 = bf1(p[0]), x2 = bf1(p[8]);
        const int pi = pos_index(r) * 8 + fi; const float c = ropeC[pi], s = ropeS[pi];
        p[0] = (bf16)f2bf(x1 * c - x2 * s); p[8] = (bf16)f2bf(x2 * c + x1 * s);
    }
}
__device__ __forceinline__ void p3_ssm_naive(Frame& F) {
    LAS float* hs = (LAS float*)(F.lds + F.wave * 16384);
    const int gw = F.vcu * NWAVES + F.wave, NGW = F.G * NWAVES, lane = F.lane;
    const bf16* P = (const bf16*)(F.ws + WS_P); bf16* Z = (bf16*)(F.ws + WS_Z);
    const float* abr = (const float*)(F.ws + WS_ABR); const float* abi = (const float*)(F.ws + WS_ABI); const float* bbr = (const float*)(F.ws + WS_BBR); const float* bbi = (const float*)(F.ws + WS_BBI);
    for (int task = gw; task < (4 + 128) * 32; task += NGW) {
        const int seq = task >> 5, g = task & 31, gp = g * 64 + lane;
        const float are = abr[gp], aim = abi[gp];
        float br[16], bi[16];
#pragma unroll
        for (int h = 0; h < 16; ++h) { br[h] = bbr[gp * 16 + h]; bi[h] = bbi[gp * 16 + h]; }
        const int ho = lane & 15, qq = lane >> 4;
        float cr[16], ci[16];
#pragma unroll
        for (int j = 0; j < 16; ++j) { cr[j] = F.in[I_CRE][(g * 16 + ho) * 64 + qq * 16 + j]; ci[j] = F.in[I_CIM][(g * 16 + ho) * 64 + qq * 16 + j]; }
        const float dd = F.in[I_DD][g * 16 + ho];
        float hr, hi; int nsteps;
        if (seq < 4) { hr = 0.f; hi = 0.f; nsteps = 4112; }
        else { const int db = seq - 4; hr = F.in[I_SRE][(db * 32 + g) * 64 + lane]; hi = F.in[I_SIM][(db * 32 + g) * 64 + lane]; nsteps = 4; }
        for (int st = 0; st < nsteps; ++st) {
            int row; bool wr_out;
            if (seq < 4) { if (st < 16) { row = MR + st; wr_out = false; } else { row = seq * 4096 + st - 16; wr_out = true; } }
            else { row = MP + (seq - 4) * 4 + st; wr_out = true; }
            const v4u* up = (const v4u*)(P + (size_t)row * DIN + 768 + g * 16);
            const v4u u0 = up[0], u1 = up[1];
            float u[16];
            u[0] = bflo(u0.x); u[1] = bfhi(u0.x); u[2] = bflo(u0.y); u[3] = bfhi(u0.y); u[4] = bflo(u0.z); u[5] = bfhi(u0.z); u[6] = bflo(u0.w); u[7] = bfhi(u0.w);
            u[8] = bflo(u1.x); u[9] = bfhi(u1.x); u[10] = bflo(u1.y); u[11] = bfhi(u1.y); u[12] = bflo(u1.z); u[13] = bfhi(u1.z); u[14] = bflo(u1.w); u[15] = bfhi(u1.w);
            float bur = 0.f, bui = 0.f;
#pragma unroll
            for (int h = 0; h < 16; ++h) { bur += br[h] * u[h]; bui += bi[h] * u[h]; }
            const float nhr = are * hr - aim * hi + bur, nhi = are * hi + aim * hr + bui;
            hr = nhr; hi = nhi;
            if (wr_out) {
                hs[lane] = hr; hs[64 + lane] = hi;
                LDS_WAIT(); asm volatile("" ::: "memory");
                float y = 0.f;
#pragma unroll
                for (int j = 0; j < 16; ++j) y += cr[j] * hs[qq * 16 + j] - ci[j] * hs[64 + qq * 16 + j];
                y += __shfl_xor(y, 16); y += __shfl_xor(y, 32);
                float uo = u[0];
#pragma unroll
                for (int h = 1; h < 16; ++h) uo = (ho == h) ? u[h] : uo;
                y += dd * uo;
                const float z = gelu_tanh(y);
                if (lane < 16) Z[(size_t)row * SW + g * 16 + ho] = (bf16)f2bf(z);
                LDS_WAIT(); asm volatile("" ::: "memory");
            }
        }
        if (seq < 4) { F.out[O_SRP + (seq * 32 + g) * 64 + lane] = hr; F.out[O_SIP + (seq * 32 + g) * 64 + lane] = hi; }
        else { F.out[O_SRS + ((seq - 4) * 32 + g) * 64 + lane] = hr; F.out[O_SIS + ((seq - 4) * 32 + g) * 64 + lane] = hi; }
    }
}
__device__ __forceinline__ float dot64_bf16(const LAS float* qf, const bf16* kp) {
    float s = 0.f;
#pragma unroll 2
    for (int i = 0; i < 8; ++i) { const v4u k = ((const v4u*)kp)[i]; const f32x4 a = ((const LAS f32x4*)qf)[2 * i], b = ((const LAS f32x4*)qf)[2 * i + 1];
        s += a.x * bflo(k.x) + a.y * bfhi(k.x) + a.z * bflo(k.y) + a.w * bfhi(k.y) + b.x * bflo(k.z) + b.y * bfhi(k.z) + b.z * bflo(k.w) + b.w * bfhi(k.w); }
    return s;
}
__device__ __forceinline__ float dot64_f32(const LAS float* qf, const float* kp) {
    float s = 0.f;
#pragma unroll 2
    for (int i = 0; i < 16; ++i) { const f32x4 k = ((const f32x4*)kp)[i]; const f32x4 a = ((const LAS f32x4*)qf)[i];
        s += a.x * k.x + a.y * k.y + a.z * k.z + a.w * k.w; }
    return s;
}
__device__ __forceinline__ void p3_attn_naive(Frame& F) {
    LAS float* pw = (LAS float*)(F.lds + F.wave * 16384 + 1024);
    LAS float* qf = (LAS float*)(F.lds + F.wave * 16384 + 2048);
    const int gw = F.vcu * NWAVES + F.wave, NGW = F.G * NWAVES, lane = F.lane;
    const bf16* P = (const bf16*)(F.ws + WS_P); bf16* ATT = (bf16*)(F.ws + WS_ATT);
    const float NEG = -1e30f;
#pragma unroll 1
    for (int task = gw; task < MR * 8; task += NGW) {
        const int r = task >> 3, h = task & 7, kvh = h >> 2;
        qf[lane] = bf1(P[(size_t)r * DIN + h * 64 + lane]);
        LDS_WAIT(); asm volatile("" ::: "memory");
        const float sink = F.in[I_SINK][h];
        float l0, l1, l2 = NEG; bool v0, v1, v2 = false;
        if (r < MP) {
            const int b = r >> 12, s = r & 4095, pos = s + 16;
            const int kp0 = pos - 127 + lane, kp1 = kp0 + 64;
            v0 = kp0 >= 0; v1 = kp1 >= 0;
            const int kr0 = kp0 >= 16 ? b * 4096 + kp0 - 16 : MR + (kp0 < 0 ? 0 : kp0);
            const int kr1 = kp1 >= 16 ? b * 4096 + kp1 - 16 : MR + (kp1 < 0 ? 0 : kp1);
            l0 = dot64_bf16(qf, P + (size_t)kr0 * DIN + 512 + kvh * 64) * 0.125f;
            l1 = dot64_bf16(qf, P + (size_t)kr1 * DIN + 512 + kvh * 64) * 0.125f;
        } else {
            const int db = (r - MP) >> 2, t = (r - MP) & 3;
            v0 = lane >= t + 1; v1 = true;
            l0 = dot64_f32(qf, F.in[I_CK] + ((size_t)(db * 128 + lane) * 2 + kvh) * 64) * 0.125f;
            l1 = dot64_f32(qf, F.in[I_CK] + ((size_t)(db * 128 + lane + 64) * 2 + kvh) * 64) * 0.125f;
            v2 = lane <= t;
            const int tr = lane < 4 ? lane : 0;
            l2 = dot64_bf16(qf, P + (size_t)(MP + db * 4 + tr) * DIN + 512 + kvh * 64) * 0.125f;
        }
        l0 = v0 ? l0 : NEG; l1 = v1 ? l1 : NEG; l2 = v2 ? l2 : NEG;
        float m = wave_max(fmaxf(fmaxf(l0, l1), l2)); m = fmaxf(m, sink);
        const float e0 = v0 ? __expf(l0 - m) : 0.f, e1 = v1 ? __expf(l1 - m) : 0.f, e2 = v2 ? __expf(l2 - m) : 0.f;
        const float den = wave_sum(e0 + e1 + e2) + __expf(sink - m);
        const float inv = 1.0f / den;
        pw[lane] = e0 * inv; pw[64 + lane] = e1 * inv; pw[128 + lane] = e2 * inv;
        LDS_WAIT(); asm volatile("" ::: "memory");
        float o = 0.f;
        if (r < MP) {
            const int b = r >> 12, s = r & 4095, pos = s + 16;
#pragma unroll 1
            for (int j = 0; j < 128; ++j) { const int kp = pos - 127 + j; if (kp < 0) continue;
                const int kr = kp >= 16 ? b * 4096 + kp - 16 : MR + kp;
                o += pw[j] * bf1(P[(size_t)kr * DIN + 640 + kvh * 64 + lane]); }
        } else {
            const int db = (r - MP) >> 2, t = (r - MP) & 3;
#pragma unroll 1
            for (int j = t + 1; j < 128; ++j) o += pw[j] * F.in[I_CV][((size_t)(db * 128 + j) * 2 + kvh) * 64 + lane];
#pragma unroll 1
            for (int j = 0; j <= t; ++j) o += pw[128 + j] * bf1(P[(size_t)(MP + db * 4 + j) * DIN + 640 + kvh * 64 + lane]);
        }
        ATT[(size_t)r * AW + h * 64 + lane] = (bf16)f2bf(o);
        LDS_WAIT(); asm volatile("" ::: "memory");
    }
}
__device__ __forceinline__ void p3_windows(Frame& F) {
    const int gt = F.vcu * (NWAVES * 64) + F.tid, NT = F.G * NWAVES * 64;
    const bf16* P = (const bf16*)(F.ws + WS_P);
    for (int e = gt; e < 65536; e += NT) { const int b = e >> 14, j = (e >> 7) & 127, c = e & 127; const size_t base = (size_t)(b * 4096 + 3968 + j) * DIN;
        F.out[O_KP + e] = bf1(P[base + 512 + c]); F.out[O_VP + e] = bf1(P[base + 640 + c]); }
    for (int e = gt; e < 2097152; e += NT) { const int db = e >> 14, j = (e >> 7) & 127, c = e & 127;
        float kv, vv;
        if (j < 124) { kv = F.in[I_CK][(size_t)(db * 128 + j + 4) * 128 + c]; vv = F.in[I_CV][(size_t)(db * 128 + j + 4) * 128 + c]; }
        else { const size_t base = (size_t)(MP + db * 4 + j - 124) * DIN; kv = bf1(P[base + 512 + c]); vv = bf1(P[base + 640 + c]); }
        F.out[O_KS + e] = kv; F.out[O_VS + e] = vv; }
}
__device__ __forceinline__ void unpack8(const v4u w, float (&f)[8]) { f[0] = bflo(w.x); f[1] = bfhi(w.x); f[2] = bflo(w.y); f[3] = bfhi(w.y); f[4] = bflo(w.z); f[5] = bfhi(w.z); f[6] = bflo(w.w); f[7] = bfhi(w.w); }
__device__ __forceinline__ v4u pack8(const float (&f)[8]) { v4u w; w.x = pk2(f[0], f[1]); w.y = pk2(f[2], f[3]); w.z = pk2(f[4], f[5]); w.w = pk2(f[6], f[7]); return w; }
__device__ __forceinline__ void p5_mixnorm(Frame& F) {
    const int gw = F.vcu * NWAVES + F.wave, NGW = F.G * NWAVES, lane = F.lane;
    const bf16* ATT = (const bf16*)(F.ws + WS_ATT); const bf16* Z = (const bf16*)(F.ws + WS_Z); const bf16* GL = (const bf16*)(F.ws + WS_GL); bf16* CAT = (bf16*)(F.ws + WS_CAT);
    for (int r = gw; r < MR; r += NGW) {
        float a[8], z[8], gt[8], o[8];
        unpack8(*(const v4u*)(ATT + (size_t)r * AW + lane * 8), a); unpack8(*(const v4u*)(Z + (size_t)r * SW + lane * 8), z); unpack8(*(const v4u*)(GL + (size_t)r * SW + lane * 8), gt);
        float sa = 0.f, so = 0.f;
#pragma unroll
        for (int i = 0; i < 8; ++i) { o[i] = z[i] * sigmoidf_(gt[i]); sa += a[i] * a[i]; so += o[i] * o[i]; }
        const float ra = 1.0f / sqrtf(wave_sum(sa) * (1.f / 512.f) + EPS), ro = 1.0f / sqrtf(wave_sum(so) * (1.f / 512.f) + EPS);
#pragma unroll
        for (int i = 0; i < 8; ++i) { a[i] = a[i] * ra * F.in[I_GATT][lane * 8 + i]; o[i] = o[i] * ro * F.in[I_GSSM][lane * 8 + i]; }
        *(v4u*)(CAT + (size_t)r * D + lane * 8) = pack8(a); *(v4u*)(CAT + (size_t)r * D + 512 + lane * 8) = pack8(o);
    }
}
__device__ __forceinline__ void p7_mid(Frame& F) {
    const int gw = F.vcu * NWAVES + F.wave, NGW = F.G * NWAVES, lane = F.lane;
    const bf16* O1 = (const bf16*)(F.ws + WS_O); bf16* XN2 = (bf16*)(F.ws + WS_XN);
    for (int r = gw; r < MR; r += NGW) {
        float o[16], x[16];
        { float t[8]; unpack8(*(const v4u*)(O1 + (size_t)r * D + lane * 8), t);
#pragma unroll
          for (int i = 0; i < 8; ++i) o[i] = t[i];
          unpack8(*(const v4u*)(O1 + (size_t)r * D + 512 + lane * 8), t);
#pragma unroll
          for (int i = 0; i < 8; ++i) o[8 + i] = t[i]; }
        const float* xr = x_row_ptr(F, r);
#pragma unroll
        for (int hf = 0; hf < 2; ++hf) { const f32x4 a = *(const f32x4*)(xr + hf * 512 + lane * 8), b = *(const f32x4*)(xr + hf * 512 + lane * 8 + 4);
            x[hf * 8 + 0] = a.x; x[hf * 8 + 1] = a.y; x[hf * 8 + 2] = a.z; x[hf * 8 + 3] = a.w; x[hf * 8 + 4] = b.x; x[hf * 8 + 5] = b.y; x[hf * 8 + 6] = b.z; x[hf * 8 + 7] = b.w; }
        float ss = 0.f;
#pragma unroll
        for (int i = 0; i < 16; ++i) ss += o[i] * o[i];
        const float r1 = 1.0f / sqrtf(wave_sum(ss) * (1.f / 1024.f) + EPS);
        float s2 = 0.f;
#pragma unroll
        for (int i = 0; i < 16; ++i) { const int col = (i >> 3) * 512 + lane * 8 + (i & 7); x[i] = x[i] + o[i] * r1 * F.in[I_GPOST][col]; s2 += x[i] * x[i]; }
        const float r2 = 1.0f / sqrtf(wave_sum(s2) * (1.f / 1024.f) + EPS);
        float* yo = F.out + (size_t)r * D;
#pragma unroll
        for (int hf = 0; hf < 2; ++hf) {
            *(f32x4*)(yo + hf * 512 + lane * 8) = (f32x4){x[hf * 8 + 0], x[hf * 8 + 1], x[hf * 8 + 2], x[hf * 8 + 3]};
            *(f32x4*)(yo + hf * 512 + lane * 8 + 4) = (f32x4){x[hf * 8 + 4], x[hf * 8 + 5], x[hf * 8 + 6], x[hf * 8 + 7]};
            float n[8];
#pragma unroll
            for (int i = 0; i < 8; ++i) n[i] = x[hf * 8 + i] * r2 * F.in[I_GMLP][hf * 512 + lane * 8 + i];
            *(v4u*)(XN2 + (size_t)r * D + hf * 512 + lane * 8) = pack8(n);
        }
    }
}
__device__ __forceinline__ void p10_final(Frame& F) {
    const int gw = F.vcu * NWAVES + F.wave, NGW = F.G * NWAVES, lane = F.lane;
    const bf16* O2 = (const bf16*)(F.ws + WS_O);
    for (int r = gw; r < MR; r += NGW) {
        float o[16];
        if (r < MP) { float t[8]; unpack8(*(const v4u*)(O2 + (size_t)r * D + lane * 8), t);
#pragma unroll
          for (int i = 0; i < 8; ++i) o[i] = t[i];
          unpack8(*(const v4u*)(O2 + (size_t)r * D + 512 + lane * 8), t);
#pragma unroll
          for (int i = 0; i < 8; ++i) o[8 + i] = t[i]; }
        else {
#pragma unroll
            for (int i = 0; i < 16; ++i) o[i] = 0.f;
            const float* sl = (const float*)(F.ws + WS_XN) + (size_t)(r - MP) * D + lane * 8;
#pragma unroll 1
            for (int kq = 0; kq < 8; ++kq) {
#pragma unroll
                for (int hf = 0; hf < 2; ++hf) { const f32x4 a = *(const f32x4*)(sl + (size_t)kq * MS * D + hf * 512), b = *(const f32x4*)(sl + (size_t)kq * MS * D + hf * 512 + 4);
                    o[hf * 8 + 0] += a.x; o[hf * 8 + 1] += a.y; o[hf * 8 + 2] += a.z; o[hf * 8 + 3] += a.w; o[hf * 8 + 4] += b.x; o[hf * 8 + 5] += b.y; o[hf * 8 + 6] += b.z; o[hf * 8 + 7] += b.w; } } }
        float ss = 0.f;
#pragma unroll
        for (int i = 0; i < 16; ++i) ss += o[i] * o[i];
        const float r1 = 1.0f / sqrtf(wave_sum(ss) * (1.f / 1024.f) + EPS);
        float* yo = F.out + (size_t)r * D;
#pragma unroll
        for (int hf = 0; hf < 2; ++hf) {
            f32x4 a = *(const f32x4*)(yo + hf * 512 + lane * 8), b = *(const f32x4*)(yo + hf * 512 + lane * 8 + 4);
            const float* g = F.in[I_GMLPP] + hf * 512 + lane * 8;
            a.x += o[hf * 8 + 0] * r1 * g[0]; a.y += o[hf * 8 + 1] * r1 * g[1]; a.z += o[hf * 8 + 2] * r1 * g[2]; a.w += o[hf * 8 + 3] * r1 * g[3];
            b.x += o[hf * 8 + 4] * r1 * g[4]; b.y += o[hf * 8 + 5] * r1 * g[5]; b.z += o[hf * 8 + 6] * r1 * g[6]; b.w += o[hf * 8 + 7] * r1 * g[7];
            *(f32x4*)(yo + hf * 512 + lane * 8) = a; *(f32x4*)(yo + hf * 512 + lane * 8 + 4) = b;
        }
    }
}

typedef short bf16x8 __attribute__((ext_vector_type(8)));
constexpr int KC_PER_G = 33 * 256;
struct ZohD { double adt_r, adt_i, cr, ci; };
__device__ __forceinline__ ZohD zoh_d(const Frame& F, int gp) {
    const int g = gp >> 6;
    const double dt = exp_d((double)F.in[I_LDT][g]); const double ar = (double)F.in[I_ARE][gp], ai = (double)F.in[I_AIM][gp];
    ZohD z; z.adt_r = ar * dt; z.adt_i = ai * dt;
    const double mag = exp_d(z.adt_r); double s, c; sincos_d(z.adt_i, s, c);
    const double nr = mag * c - 1.0, ni = mag * s, den = ar * ar + ai * ai;
    z.cr = (nr * ar + ni * ai) / den; z.ci = (ni * ar - nr * ai) / den; return z;
}
__device__ __forceinline__ void abar_pow(const ZohD& z, int m, double& wr, double& wi) { const double mag = exp_d(z.adt_r * (double)m); double s, c; sincos_d(z.adt_i * (double)m, s, c); wr = mag * c; wi = mag * s; }

__device__ __forceinline__ void p0_ssm_tables(Frame& F) {
    const int gt = F.vcu * (NWAVES * 64) + F.tid, NT = F.G * NWAVES * 64;
    bf16* VT = (bf16*)(F.ws + WS_VT); bf16* QT = (bf16*)(F.ws + WS_QT); bf16* KC = (bf16*)(F.ws + WS_KC); float* A32 = (float*)(F.ws + WS_A32);
    for (int i = gt; i < 2048; i += NT) { const ZohD z = zoh_d(F, i); double wr, wi; abar_pow(z, 32, wr, wi); A32[2 * i] = (float)wr; A32[2 * i + 1] = (float)wi; }
    for (int it = gt; it < 65536; it += NT) {
        const int gp = it >> 5, s = it & 31, g = gp >> 6, p = gp & 63;
        const ZohD z = zoh_d(F, gp); double wr, wi; abar_pow(z, 31 - s, wr, wi);
        const float er = (float)(wr * z.cr - wi * z.ci), ei = (float)(wr * z.ci + wi * z.cr);
        float re[16], im[16];
#pragma unroll
        for (int h = 0; h < 16; ++h) { const float br = F.in[I_BRE][gp * 16 + h], bi = F.in[I_BIM][gp * 16 + h]; re[h] = er * br - ei * bi; im[h] = er * bi + ei * br; }
        bf16* d0 = VT + (size_t)g * 65536 + (size_t)(2 * p) * 512 + 16 * s; bf16* d1 = d0 + 512;
        v4u w;
        w.x = pk2(re[0], re[1]); w.y = pk2(re[2], re[3]); w.z = pk2(re[4], re[5]); w.w = pk2(re[6], re[7]); ((v4u*)d0)[0] = w;
        w.x = pk2(re[8], re[9]); w.y = pk2(re[10], re[11]); w.z = pk2(re[12], re[13]); w.w = pk2(re[14], re[15]); ((v4u*)d0)[1] = w;
        w.x = pk2(im[0], im[1]); w.y = pk2(im[2], im[3]); w.z = pk2(im[4], im[5]); w.w = pk2(im[6], im[7]); ((v4u*)d1)[0] = w;
        w.x = pk2(im[8], im[9]); w.y = pk2(im[10], im[11]); w.z = pk2(im[12], im[13]); w.w = pk2(im[14], im[15]); ((v4u*)d1)[1] = w;
    }
    for (int it = gt; it < 65536; it += NT) {
        const int gp = it >> 5, t = it & 31, g = gp >> 6, p = gp & 63;
        const ZohD z = zoh_d(F, gp); double wrd, wid; abar_pow(z, t + 1, wrd, wid); const float wr = (float)wrd, wi = (float)wid;
        unsigned* d = (unsigned*)(QT + (size_t)g * 65536 + (size_t)(16 * t) * 128 + 2 * p);
#pragma unroll
        for (int ho = 0; ho < 16; ++ho) { const float cr = F.in[I_CRE][(g * 16 + ho) * 64 + p], ci = F.in[I_CIM][(g * 16 + ho) * 64 + p];
            d[ho * 64] = pk2(cr * wr - ci * wi, -(cr * wi + ci * wr)); }
    }
    LAS float* E = (LAS float*)(F.lds + 131072);
    for (int bt = F.vcu; bt < 1024; bt += F.G) {
        const int g = bt >> 5, tau = bt & 31;
        if (F.tid < 64) { const int gp = g * 64 + F.tid; const ZohD z = zoh_d(F, gp); double wr, wi; abar_pow(z, tau, wr, wi);
            E[F.tid] = (float)(wr * z.cr - wi * z.ci); E[64 + F.tid] = (float)(wr * z.ci + wi * z.cr); }
        __syncthreads();
        if (F.tid < 256) { const int ho = F.tid >> 4, hi = F.tid & 15; float acc = 0.f;
            for (int p = 0; p < 64; ++p) { const float cr = F.in[I_CRE][(g * 16 + ho) * 64 + p], ci = F.in[I_CIM][(g * 16 + ho) * 64 + p];
                const float br = F.in[I_BRE][(g * 64 + p) * 16 + hi], bi = F.in[I_BIM][(g * 64 + p) * 16 + hi];
                const float er = E[p], ei = E[64 + p];
                acc += cr * (er * br - ei * bi) - ci * (er * bi + ei * br); }
            if (tau == 0 && ho == hi) acc += F.in[I_DD][g * 16 + ho];
            KC[(size_t)g * KC_PER_G + (tau + 1) * 256 + F.tid] = (bf16)f2bf(acc);
        } else if (tau == 0) { KC[(size_t)g * KC_PER_G + (F.tid - 256)] = (bf16)0; }
        __syncthreads();
    }
}
__device__ __forceinline__ void stage_rows(LAS unsigned char* dst, const unsigned char* src, int nrows, int cshift, int dst_stride, int tid) {
    const int total = nrows << cshift;
    for (int c = tid; c < total; c += NWAVES * 64) { const int row = c >> cshift, col = c & ((1 << cshift) - 1);
        const v4u v = *(const v4u*)(src + ((size_t)c << 4)); *(LAS v4u*)(dst + row * dst_stride + col * 16) = v; }
}
#define MFMA16(a, b, c) __builtin_amdgcn_mfma_f32_16x16x32_bf16((a), (b), (c), 0, 0, 0)
constexpr int VT_STRIDE = 1040, QT_STRIDE = 272, LDS_KC_OFF = 512 * QT_STRIDE;
static_assert(LDS_KC_OFF + KC_PER_G * 2 <= LDSCTL_OFF && 128 * VT_STRIDE <= LDSCTL_OFF, "SSM LDS images");
__device__ __forceinline__ void s1_hloc(Frame& F) {
    const bf16* P = (const bf16*)(F.ws + WS_P); const bf16* VT = (const bf16*)(F.ws + WS_VT); float* HL = (float*)(F.ws + WS_HL);
    const int lane = F.lane;
    for (int bt = F.vcu; bt < 256; bt += F.G) {
        const int g = bt >> 3, sub = bt & 7;
        __syncthreads();
        stage_rows(F.lds, (const unsigned char*)(VT + (size_t)g * 65536), 128, 6, VT_STRIDE, F.tid);
        __syncthreads();
        const int ntile = 4 * sub + (F.wave >> 1), half = F.wave & 1;
        const int n = ntile * 16 + (lane & 15), b = n >> 7, c = n & 127, row0 = b * 4096 + 32 * c;
        const bf16* up = P + (size_t)(row0 + (lane >> 5)) * DIN + 768 + g * 16 + 8 * ((lane >> 4) & 1);
        bf16x8 U[16];
#pragma unroll
        for (int ks = 0; ks < 16; ++ks) U[ks] = *(const bf16x8*)(up + (size_t)(2 * ks) * DIN);
#pragma unroll
        for (int mi = 0; mi < 4; ++mi) {
            const int mf = 4 * half + mi;
            const LAS unsigned char* ap = F.lds + (16 * mf + (lane & 15)) * VT_STRIDE + 16 * (lane >> 4);
            f32x4 acc = (f32x4){0.f, 0.f, 0.f, 0.f};
#pragma unroll
            for (int ks = 0; ks < 16; ++ks) acc = MFMA16(*(const LAS bf16x8*)(ap + 64 * ks), U[ks], acc);
            *(f32x4*)(HL + ((size_t)n * 32 + g) * 128 + 16 * mf + 4 * (lane >> 4)) = acc;
        }
    }
}
__device__ __forceinline__ void s1_small_seqs(Frame& F) {
    LAS float* hs = (LAS float*)(F.lds + 133120 + F.wave * 512);
    const int gw = F.vcu * NWAVES + F.wave, NGW = F.G * NWAVES, lane = F.lane;
    const bf16* P = (const bf16*)(F.ws + WS_P); bf16* Z = (bf16*)(F.ws + WS_Z); float* HM = (float*)(F.ws + WS_HM);
    const float* abr = (const float*)(F.ws + WS_ABR); const float* abi = (const float*)(F.ws + WS_ABI); const float* bbr = (const float*)(F.ws + WS_BBR); const float* bbi = (const float*)(F.ws + WS_BBI);
#pragma unroll 1
    for (int task = gw; task < 32 + 128 * 32; task += NGW) {
        const bool meta = task < 32; const int g = meta ? task : ((task - 32) & 31), db = meta ? 0 : ((task - 32) >> 5), gp = g * 64 + lane;
        const float are = abr[gp], aim = abi[gp];
        float br[16], bi[16];
#pragma unroll
        for (int h = 0; h < 16; ++h) { br[h] = bbr[gp * 16 + h]; bi[h] = bbi[gp * 16 + h]; }
        const int ho = lane & 15, qq = lane >> 4;
        float cr[16], ci[16];
#pragma unroll
        for (int j = 0; j < 16; ++j) { cr[j] = F.in[I_CRE][(g * 16 + ho) * 64 + qq * 16 + j]; ci[j] = F.in[I_CIM][(g * 16 + ho) * 64 + qq * 16 + j]; }
        const float dd = F.in[I_DD][g * 16 + ho];
        float hr = 0.f, hi = 0.f;
        if (!meta) { hr = F.in[I_SRE][(db * 32 + g) * 64 + lane]; hi = F.in[I_SIM][(db * 32 + g) * 64 + lane]; }
        const int nsteps = meta ? 16 : 4;
#pragma unroll 1
        for (int st = 0; st < nsteps; ++st) {
            const int row = meta ? MR + st : MP + db * 4 + st;
            const v4u* up = (const v4u*)(P + (size_t)row * DIN + 768 + g * 16);
            const v4u u0 = up[0], u1 = up[1];
            float u[16];
            u[0] = bflo(u0.x); u[1] = bfhi(u0.x); u[2] = bflo(u0.y); u[3] = bfhi(u0.y); u[4] = bflo(u0.z); u[5] = bfhi(u0.z); u[6] = bflo(u0.w); u[7] = bfhi(u0.w);
            u[8] = bflo(u1.x); u[9] = bfhi(u1.x); u[10] = bflo(u1.y); u[11] = bfhi(u1.y); u[12] = bflo(u1.z); u[13] = bfhi(u1.z); u[14] = bflo(u1.w); u[15] = bfhi(u1.w);
            float bur = 0.f, bui = 0.f;
#pragma unroll
            for (int h = 0; h < 16; ++h) { bur += br[h] * u[h]; bui += bi[h] * u[h]; }
            const float nhr = are * hr - aim * hi + bur, nhi = are * hi + aim * hr + bui;
            hr = nhr; hi = nhi;
            if (!meta) {
                hs[lane] = hr; hs[64 + lane] = hi;
                LDS_WAIT(); asm volatile("" ::: "memory");
                float y = 0.f;
#pragma unroll
                for (int j = 0; j < 16; ++j) y += cr[j] * hs[qq * 16 + j] - ci[j] * hs[64 + qq * 16 + j];
                y += __shfl_xor(y, 16); y += __shfl_xor(y, 32);
                float uo = u[0];
#pragma unroll
                for (int h = 1; h < 16; ++h) uo = (ho == h) ? u[h] : uo;
                y += dd * uo;
                const float z = gelu_tanh(y);
                if (lane < 16) Z[(size_t)row * SW + g * 16 + ho] = (bf16)f2bf(z);
                LDS_WAIT(); asm volatile("" ::: "memory");
            }
        }
        if (meta) { HM[g * 128 + 2 * lane] = hr; HM[g * 128 + 2 * lane + 1] = hi; }
        else { F.out[O_SRS + (db * 32 + g) * 64 + lane] = hr; F.out[O_SIS + (db * 32 + g) * 64 + lane] = hi; }
    }
}
__device__ __forceinline__ void s2_scan(Frame& F) {
    const int gt = F.vcu * (NWAVES * 64) + F.tid;
    if (gt < 8192) {
        const int b = gt >> 11, gp = gt & 2047, g = gp >> 6, p = gp & 63;
        const float* A32 = (const float*)(F.ws + WS_A32); const float* HM = (const float*)(F.ws + WS_HM);
        const float ar = A32[2 * gp], ai = A32[2 * gp + 1];
        float hr = HM[g * 128 + 2 * p], hi = HM[g * 128 + 2 * p + 1];
        const float* hl = (const float*)(F.ws + WS_HL) + ((size_t)(b * 128) * 32 + g) * 128 + 2 * p;
        unsigned* hin = (unsigned*)((bf16*)(F.ws + WS_HIN) + ((size_t)(b * 128) * 32 + g) * 128 + 2 * p);
#pragma unroll 1
        for (int c0 = 0; c0 < 128; c0 += 16) {
            float vr[16], vi[16];
#pragma unroll
            for (int j = 0; j < 16; ++j) { const float* q = hl + (size_t)(c0 + j) * 4096; vr[j] = q[0]; vi[j] = q[1]; }
#pragma unroll
            for (int j = 0; j < 16; ++j) { hin[(size_t)(c0 + j) * 2048] = pk2(hr, hi);
                const float nr = ar * hr - ai * hi + vr[j], ni = ar * hi + ai * hr + vi[j]; hr = nr; hi = ni; }
        }
        F.out[O_SRP + (b * 32 + g) * 64 + p] = hr; F.out[O_SIP + (b * 32 + g) * 64 + p] = hi;
    }
}
__device__ __forceinline__ void s3_y(Frame& F) {
    const bf16* P = (const bf16*)(F.ws + WS_P); const bf16* QT = (const bf16*)(F.ws + WS_QT); const bf16* KC = (const bf16*)(F.ws + WS_KC); const bf16* HIN = (const bf16*)(F.ws + WS_HIN); bf16* Z = (bf16*)(F.ws + WS_Z);
    const int lane = F.lane;
    for (int bt = F.vcu; bt < 256; bt += F.G) {
        const int g = bt >> 3, sub = bt & 7;
        __syncthreads();
        stage_rows(F.lds, (const unsigned char*)(QT + (size_t)g * 65536), 512, 4, QT_STRIDE, F.tid);
        stage_rows(F.lds + LDS_KC_OFF, (const unsigned char*)(KC + (size_t)g * KC_PER_G), 33, 5, 512, F.tid);
        __syncthreads();
        const int ntile = 4 * sub + (F.wave >> 1), half = F.wave & 1;
        const int n = ntile * 16 + (lane & 15), b = n >> 7, c = n & 127, row0 = b * 4096 + 32 * c;
        const bf16* up = P + (size_t)(row0 + (lane >> 5)) * DIN + 768 + g * 16 + 8 * ((lane >> 4) & 1);
        bf16x8 U[16], H[4];
#pragma unroll
        for (int ks = 0; ks < 16; ++ks) U[ks] = *(const bf16x8*)(up + (size_t)(2 * ks) * DIN);
        const bf16* hp = HIN + ((size_t)n * 32 + g) * 128 + 8 * (lane >> 4);
#pragma unroll
        for (int kk = 0; kk < 4; ++kk) H[kk] = *(const bf16x8*)(hp + 32 * kk);
        const LAS unsigned char* qp = F.lds + (16 * half + (lane & 15)) * QT_STRIDE + 16 * (lane >> 4);
        const LAS unsigned char* kp = F.lds + LDS_KC_OFF + (half - (lane >> 5) + 1) * 512 + (lane & 15) * 32 + 16 * ((lane >> 4) & 1);
        bf16* zp = Z + (size_t)(row0 + half) * SW + g * 16 + 4 * (lane >> 4);
#pragma unroll
        for (int i = 0; i < 16; ++i) {
            f32x4 acc = (f32x4){0.f, 0.f, 0.f, 0.f};
#pragma unroll
            for (int kk = 0; kk < 4; ++kk) acc = MFMA16(*(const LAS bf16x8*)(qp + i * 32 * QT_STRIDE + kk * 64), H[kk], acc);
#pragma unroll
            for (int ks = 0; ks < 16; ++ks) if (ks <= i) acc = MFMA16(*(const LAS bf16x8*)(kp + (2 * i - 2 * ks) * 512), U[ks], acc);
            v2u w; w.x = pk2(gelu_tanh(acc[0]), gelu_tanh(acc[1])); w.y = pk2(gelu_tanh(acc[2]), gelu_tanh(acc[3]));
            *(v2u*)(zp + (size_t)(2 * i) * SW) = w;
        }
    }
}
typedef float f32x16 __attribute__((ext_vector_type(16)));
#define MFMA32(a, b, c) __builtin_amdgcn_mfma_f32_32x32x16_bf16((a), (b), (c), 0, 0, 0)
__device__ __forceinline__ int crow(int r, int hl) { return (r & 3) + 8 * (r >> 2) + 4 * hl; }
constexpr float LOG2E = 1.4426950408889634f, QK_C2 = 0.125f * 1.4426950408889634f;
constexpr int AK_STRIDE = 144;
template <class MaskF>
__device__ __forceinline__ void attn_qblock(const LAS unsigned char* Kl, const LAS unsigned char* Vl, int vstride, const bf16x8 (&qf)[4], int kb0, float sink2, const MaskF& valid, LAS float* wsf, f32x16 (&O)[2], int lane) {
    const int i = lane & 31, hl = lane >> 5;
    f32x16 S[5];
#pragma unroll
    for (int kbi = 0; kbi < 5; ++kbi) {
        const LAS unsigned char* kp = Kl + (32 * (kb0 + kbi) + i) * AK_STRIDE + 16 * hl;
        f32x16 acc = (f32x16){0.f, 0.f, 0.f, 0.f, 0.f, 0.f, 0.f, 0.f, 0.f, 0.f, 0.f, 0.f, 0.f, 0.f, 0.f, 0.f};
#pragma unroll
        for (int kd = 0; kd < 4; ++kd) acc = MFMA32(*(const LAS bf16x8*)(kp + 32 * kd), qf[kd], acc);
        S[kbi] = acc;
    }
    float m = -1e30f;
#pragma unroll
    for (int kbi = 0; kbi < 5; ++kbi)
#pragma unroll
        for (int r = 0; r < 16; ++r) { const int kk = 32 * (kb0 + kbi) + crow(r, hl); const float t = valid(kk, i) ? S[kbi][r] * QK_C2 : -1e30f; S[kbi][r] = t; m = fmaxf(m, t); }
    m = fmaxf(m, __shfl_xor(m, 32)); m = fmaxf(m, sink2);
    float sum = 0.f;
#pragma unroll
    for (int kbi = 0; kbi < 5; ++kbi)
#pragma unroll
        for (int r = 0; r < 16; ++r) { const float p = __builtin_amdgcn_exp2f(S[kbi][r] - m); S[kbi][r] = p; sum += p; }
    sum += __shfl_xor(sum, 32); sum += __builtin_amdgcn_exp2f(sink2 - m);
    wsf[i] = 1.0f / sum;
    O[0] = (f32x16){0.f, 0.f, 0.f, 0.f, 0.f, 0.f, 0.f, 0.f, 0.f, 0.f, 0.f, 0.f, 0.f, 0.f, 0.f, 0.f}; O[1] = O[0];
#pragma unroll
    for (int kbi = 0; kbi < 5; ++kbi)
#pragma unroll
        for (int s = 0; s < 2; ++s) {
            v4u pw; pw.x = pg8::cvt_pk_bf16(S[kbi][8 * s + 0], S[kbi][8 * s + 1]); pw.y = pg8::cvt_pk_bf16(S[kbi][8 * s + 2], S[kbi][8 * s + 3]); pw.z = pg8::cvt_pk_bf16(S[kbi][8 * s + 4], S[kbi][8 * s + 5]); pw.w = pg8::cvt_pk_bf16(S[kbi][8 * s + 6], S[kbi][8 * s + 7]);
            const bf16x8 pf = __builtin_bit_cast(bf16x8, pw);
#pragma unroll
            for (int dt = 0; dt < 2; ++dt) {
                const LAS unsigned char* vp = Vl + (32 * dt + i) * vstride + (32 * (kb0 + kbi) + 16 * s + 4 * hl) * 2;
                const v2u lo = *(const LAS v2u*)vp, hi = *(const LAS v2u*)(vp + 16);
                v4u vw; vw.x = lo.x; vw.y = lo.y; vw.z = hi.x; vw.w = hi.y;
                O[dt] = MFMA32(pf, __builtin_bit_cast(bf16x8, vw), O[dt]);
            }
        }
    LDS_WAIT(); asm volatile("" ::: "memory");
}
constexpr int AP_KEYS = 192, AP_VSTRIDE = 392, AP_LDS_V = 2 * AP_KEYS * AK_STRIDE, AP_LDS_W = AP_LDS_V + 2 * 64 * AP_VSTRIDE;
static_assert(AP_LDS_W + 8 * 128 <= LDSCTL_OFF, "attention LDS");
struct MaskPrompt { int lo0, hi0, kvmin; __device__ __forceinline__ bool operator()(int kk, int i) const { return kk >= lo0 + i && kk <= hi0 + i && kk >= kvmin; } };
__device__ __forceinline__ void attn_prompt(Frame& F) {
    const bf16* P = (const bf16*)(F.ws + WS_P); bf16* ATT = (bf16*)(F.ws + WS_ATT);
    const int lane = F.lane, i = lane & 31, hl = lane >> 5;
    LAS float* wsf = (LAS float*)(F.lds + AP_LDS_W + F.wave * 128);
    for (int u = F.vcu; u < 256; u += F.G) {
        const int b = u >> 6, j = u & 63, s0 = 64 * j - 128;
        __syncthreads();
        for (int c = F.tid; c < AP_KEYS * 32; c += NWAVES * 64) {
            const int key = c >> 5, cc = c & 31, sk = s0 + key;
            const int row = sk >= 0 ? b * 4096 + sk : (sk >= -16 ? MR + 16 + sk : MR);
            const v4u v = *(const v4u*)(P + (size_t)row * DIN + 512 + cc * 8);
            if (cc < 16) { *(LAS v4u*)(F.lds + ((cc >> 3) * AP_KEYS + key) * AK_STRIDE + (cc & 7) * 16) = v; }
            else { const int c2 = cc - 16; LAS bf16* vt = (LAS bf16*)(F.lds + AP_LDS_V + ((c2 >> 3) * 64 + (c2 & 7) * 8) * AP_VSTRIDE + key * 2);
                vt[0 * (AP_VSTRIDE / 2)] = (bf16)(v.x & 0xffffu); vt[1 * (AP_VSTRIDE / 2)] = (bf16)(v.x >> 16); vt[2 * (AP_VSTRIDE / 2)] = (bf16)(v.y & 0xffffu); vt[3 * (AP_VSTRIDE / 2)] = (bf16)(v.y >> 16);
                vt[4 * (AP_VSTRIDE / 2)] = (bf16)(v.z & 0xffffu); vt[5 * (AP_VSTRIDE / 2)] = (bf16)(v.z >> 16); vt[6 * (AP_VSTRIDE / 2)] = (bf16)(v.w & 0xffffu); vt[7 * (AP_VSTRIDE / 2)] = (bf16)(v.w >> 16); }
        }
        __syncthreads();
        const int h = F.wave, kvh = h >> 2;
        const float sink2 = F.in[I_SINK][h] * LOG2E;
        const LAS unsigned char* Kl = F.lds + kvh * AP_KEYS * AK_STRIDE; const LAS unsigned char* Vl = F.lds + AP_LDS_V + kvh * 64 * AP_VSTRIDE;
#pragma unroll 1
        for (int qh = 0; qh < 2; ++qh) {
            const int qrow0 = b * 4096 + 64 * j + 32 * qh;
            const bf16* qp = P + (size_t)(qrow0 + i) * DIN + h * 64 + 8 * hl;
            bf16x8 qf[4];
#pragma unroll
            for (int kd = 0; kd < 4; ++kd) qf[kd] = *(const bf16x8*)(qp + 16 * kd);
            const MaskPrompt mk{32 * qh + 1, 128 + 32 * qh, 112 - 64 * j};
            f32x16 O[2];
            attn_qblock(Kl, Vl, AP_VSTRIDE, qf, qh, sink2, mk, wsf, O, lane);
#pragma unroll
            for (int r = 0; r < 16; ++r) { const int q = crow(r, hl); const float inv = wsf[q];
                bf16* op = ATT + (size_t)(qrow0 + q) * AW + h * 64 + i;
                op[0] = (bf16)f2bf(O[0][r] * inv); op[32] = (bf16)f2bf(O[1][r] * inv); }
            LDS_WAIT(); asm volatile("" ::: "memory");
        }
    }
    __syncthreads();
}
constexpr int AS_KEYS = 160, AS_VSTRIDE = 328, AS_LDS_V = 2 * AS_KEYS * AK_STRIDE, AS_LDS_W = AS_LDS_V + 2 * 64 * AS_VSTRIDE;
struct MaskSample { __device__ __forceinline__ bool operator()(int kk, int i) const { const int t = i & 3; return kk < 128 ? kk >= t + 1 : (kk < 132 && kk - 128 <= t); } };
__device__ __forceinline__ void attn_sample(Frame& F) {
    const bf16* P = (const bf16*)(F.ws + WS_P); bf16* ATT = (bf16*)(F.ws + WS_ATT);
    const int lane = F.lane, i = lane & 31, hl = lane >> 5;
    LAS float* wsf = (LAS float*)(F.lds + AS_LDS_W + F.wave * 128);
    for (int db = F.vcu; db < 128; db += F.G) {
        __syncthreads();
        for (int c = F.tid; c < AS_KEYS * 32; c += NWAVES * 64) {
            const int key = c >> 5, cc = c & 31, c2 = cc & 15, kvh = c2 >> 3, d0 = (c2 & 7) * 8;
            float f[8];
            if (key < 128) { const float* src = (cc < 16 ? F.in[I_CK] : F.in[I_CV]) + ((size_t)(db * 128 + key) * 2 + kvh) * 64 + d0;
                const f32x4 a = *(const f32x4*)src, bq = *(const f32x4*)(src + 4); f[0] = a.x; f[1] = a.y; f[2] = a.z; f[3] = a.w; f[4] = bq.x; f[5] = bq.y; f[6] = bq.z; f[7] = bq.w; }
            else if (key < 132) { unpack8(*(const v4u*)(P + (size_t)(MP + db * 4 + key - 128) * DIN + (cc < 16 ? 512 : 640) + kvh * 64 + d0), f); }
            else {
#pragma unroll
                for (int e = 0; e < 8; ++e) f[e] = 0.f; }
            if (cc < 16) { *(LAS v4u*)(F.lds + (kvh * AS_KEYS + key) * AK_STRIDE + d0 * 2) = pack8(f); }
            else { LAS bf16* vt = (LAS bf16*)(F.lds + AS_LDS_V + (kvh * 64 + d0) * AS_VSTRIDE + key * 2);
#pragma unroll
                for (int e = 0; e < 8; ++e) vt[e * (AS_VSTRIDE / 2)] = (bf16)f2bf(f[e]); }
        }
        __syncthreads();
        if (F.wave < 2) {
            const int kvh = F.wave, t = i & 3, gq = (i >> 2) & 3, h = kvh * 4 + gq;
            const float sink2 = F.in[I_SINK][h] * LOG2E;
            const bf16* qp = P + (size_t)(MP + db * 4 + t) * DIN + h * 64 + 8 * hl;
            bf16x8 qf[4];
#pragma unroll
            for (int kd = 0; kd < 4; ++kd) qf[kd] = *(const bf16x8*)(qp + 16 * kd);
            const MaskSample mk{};
            f32x16 O[2];
            attn_qblock(F.lds + kvh * AS_KEYS * AK_STRIDE, F.lds + AS_LDS_V + kvh * 64 * AS_VSTRIDE, AS_VSTRIDE, qf, 0, sink2, mk, wsf, O, lane);
#pragma unroll
            for (int r = 0; r < 16; ++r) { const int q = crow(r, hl);
                if (q < 16) { const float inv = wsf[q];
                    bf16* op = ATT + (size_t)(MP + db * 4 + (q & 3)) * AW + (kvh * 4 + (q >> 2)) * 64 + i;
                    op[0] = (bf16)f2bf(O[0][r] * inv); op[32] = (bf16)f2bf(O[1][r] * inv); } }
            LDS_WAIT(); asm volatile("" ::: "memory");
        }
    }
    __syncthreads();
}
constexpr int SG_STAGE = 40960, SG_B_OFF = 8192;
template <class Epi>
__device__ __forceinline__ void small_unit(Frame& F, const bf16* A, int lda, const bf16* Bt, int ldb, int m0, int n0, int k0, int klen, const Epi& E) {
    const int tid = F.tid, lane = F.lane, w = F.wave;
    const int lrow = tid >> 3, lch = tid & 7;
    const bf16* ag = A + (size_t)(m0 + lrow) * lda + k0 + lch * 8;
    const bf16* bg = Bt + (size_t)(n0 + lrow) * ldb + k0 + lch * 8;
    const int a_dst = lrow * 128 + ((lch ^ (lrow & 7)) << 4);
    v4u ra, rb[4];
    ra = *(const v4u*)ag;
#pragma unroll
    for (int q = 0; q < 4; ++q) rb[q] = *(const v4u*)(bg + (size_t)(64 * q) * ldb);
    __syncthreads();
    *(LAS v4u*)(F.lds + a_dst) = ra;
#pragma unroll
    for (int q = 0; q < 4; ++q) *(LAS v4u*)(F.lds + SG_B_OFF + q * 8192 + a_dst) = rb[q];
    __syncthreads();
    f32x4 acc[4][2];
#pragma unroll
    for (int m = 0; m < 4; ++m)
#pragma unroll
        for (int n = 0; n < 2; ++n) acc[m][n] = (f32x4){0.f, 0.f, 0.f, 0.f};
    const int nk = klen >> 6, fr = lane & 15, fq = lane >> 4;
#pragma unroll 1
    for (int t = 0; t < nk; ++t) {
        const bool more = t + 1 < nk;
        if (more) { ra = *(const v4u*)(ag + (size_t)(t + 1) * 64);
#pragma unroll
            for (int q = 0; q < 4; ++q) rb[q] = *(const v4u*)(bg + (size_t)(64 * q) * ldb + (size_t)(t + 1) * 64); }
        const LAS unsigned char* sa = F.lds + (t & 1) * SG_STAGE; const LAS unsigned char* sb = sa + SG_B_OFF;
#pragma unroll
        for (int ks = 0; ks < 2; ++ks) {
            bf16x8 af[4], bfr[2];
#pragma unroll
            for (int m = 0; m < 4; ++m) { const int row = 16 * m + fr; af[m] = *(const LAS bf16x8*)(sa + row * 128 + (((4 * ks + fq) ^ (row & 7)) << 4)); }
#pragma unroll
            for (int n = 0; n < 2; ++n) { const int row = 32 * w + 16 * n + fr; bfr[n] = *(const LAS bf16x8*)(sb + row * 128 + (((4 * ks + fq) ^ (row & 7)) << 4)); }
#pragma unroll
            for (int m = 0; m < 4; ++m)
#pragma unroll
                for (int n = 0; n < 2; ++n) acc[m][n] = MFMA16(bfr[n], af[m], acc[m][n]);
        }
        if (more) { LAS unsigned char* da = F.lds + ((t + 1) & 1) * SG_STAGE;
            *(LAS v4u*)(da + a_dst) = ra;
#pragma unroll
            for (int q = 0; q < 4; ++q) *(LAS v4u*)(da + SG_B_OFF + q * 8192 + a_dst) = rb[q]; }
        __syncthreads();
    }
    E(acc, m0, n0 + 32 * w, fr, fq);
}
template <int ACT> struct SEpiBf16 { bf16* O; int ldc;
    __device__ __forceinline__ void operator()(const f32x4 (&acc)[4][2], int m0, int c0, int fr, int fq) const {
#pragma unroll
        for (int m = 0; m < 4; ++m)
#pragma unroll
            for (int n = 0; n < 2; ++n) { f32x4 v = acc[m][n];
                if (ACT == 2) {
#pragma unroll
                    for (int e = 0; e < 4; ++e) { const float a = fmaxf(v[e], 0.f); v[e] = a * a; } }
                v2u wv; wv.x = pg8::cvt_pk_bf16(v[0], v[1]); wv.y = pg8::cvt_pk_bf16(v[2], v[3]);
                *(v2u*)(O + (size_t)(m0 + 16 * m + fr) * ldc + c0 + 16 * n + 4 * fq) = wv; }
    } };
struct SEpiF32 { float* O; int ldc;
    int row_off;
    __device__ __forceinline__ void operator()(const f32x4 (&acc)[4][2], int m0, int c0, int fr, int fq) const {
#pragma unroll
        for (int m = 0; m < 4; ++m)
#pragma unroll
            for (int n = 0; n < 2; ++n) *(f32x4*)(O + (size_t)(m0 - row_off + 16 * m + fr) * ldc + c0 + 16 * n + 4 * fq) = acc[m][n];
    } };
template <int ACT>
__device__ __forceinline__ void small_phase(Frame& F, const bf16* A, int lda, const bf16* Bt, int K, int N, int row0, int nmt, bf16* O, int ldc, int shift) {
    const int nnt = N >> 8, nsu = nmt * nnt;
    const SEpiBf16<ACT> E{O, ldc};
    for (int su = ((int)blockIdx.x - shift + 2 * F.G) % F.G; su < nsu; su += F.G) { const int mt = su / nnt, nt = su - mt * nnt;
        small_unit(F, A, lda, Bt, K, row0 + 64 * mt, 256 * nt, 0, K, E); }
}
#ifndef MK_N_LAUNCHES
#define MK_N_LAUNCHES 1
#endif
constexpr int N_PHASES = 13;
struct Args { const float* in[27]; float* out; unsigned char* ws; int ph_lo, ph_hi; };
__global__ void __launch_bounds__(NWAVES * 64, 2) hymba_fwd(Args args) {
    extern __shared__ __attribute__((aligned(16))) unsigned char lds[];
    Frame F;
    F.lds = (LAS unsigned char*)lds;
    F.MISC = (volatile LAS unsigned*)(F.lds + MISC_OFF);
    F.tid = threadIdx.x; F.lane = F.tid & 63; F.wave = __builtin_amdgcn_readfirstlane(F.tid >> 6);
    F.G = gridDim.x; { const int bx = blockIdx.x; F.vcu = (F.G % 8 == 0) ? (bx % 8) * (F.G / 8) + bx / 8 : bx; }
#pragma unroll
    for (int i = 0; i < 27; ++i) F.in[i] = args.in[i];
    F.out = args.out; F.ws = args.ws; F.ctl = (gu32*)(args.ws + WS_CTL);
    for (int u = F.tid; u < (LDS_BYTES - LDSCTL_OFF) / 4; u += NWAVES * 64) ((LAS unsigned*)(F.lds + LDSCTL_OFF))[u] = 0u;
    __syncthreads();
    const int lo = args.ph_lo, hi = args.ph_hi;
    const bool one = (hi - lo) > 1;
    XcdBarrier bar; bar.bar = (unsigned*)(F.ctl + CW_BAR); bar.x = 0; bar.st = nullptr;
    if (one) bar = xcd_barrier_post((unsigned*)(F.ctl + CW_BAR), F.MISC + 8);
#define IN(k) (lo <= (k) && (k) < hi)
#define SEAM(k) do { if (IN(k) && IN((k) + 1)) xcd_barrier(bar); } while (0)
    bf16* const XN = (bf16*)(F.ws + WS_XN); bf16* const OB = (bf16*)(F.ws + WS_O); bf16* const PB = (bf16*)(F.ws + WS_P);
    if (IN(0)) { p0_prologue(F); p0_ssm_tables(F); } SEAM(0);
    if (IN(1)) { pg8::Gemm g{XN, (const bf16*)(F.ws + WS_WIN), MP, DIN, D}; pg8::StaticOrder S; S.init(MP, DIN, F.G, (int)blockIdx.x);
        pg8::EpiBf16<0> E{PB, DIN}; pg8::gemm_phase<pg8::EpiBf16<0>, pg8::StaticOrder, true, true>(F.lds, g, S, E);
        small_phase<0>(F, XN, D, (const bf16*)(F.ws + WS_WIN), D, DIN, MP, 9, PB, DIN, 64); } SEAM(1);
    if (IN(2)) { p2_rope(F); } SEAM(2);
    if (IN(3)) { s1_hloc(F); __syncthreads(); s1_small_seqs(F); attn_prompt(F); attn_sample(F); p3_windows(F); } SEAM(3);
    if (IN(4)) { s2_scan(F); } SEAM(4);
    if (IN(5)) { s3_y(F); } SEAM(5);
    if (IN(6)) { pg8::Gemm g{(const bf16*)(F.ws + WS_Z), (const bf16*)(F.ws + WS_WGLU), MP, SW, SW}; pg8::StaticOrder S; S.init(MP, SW, F.G, (int)blockIdx.x);
        pg8::EpiBf16<0> E{(bf16*)(F.ws + WS_GL), SW}; pg8::gemm_phase<pg8::EpiBf16<0>, pg8::StaticOrder, true, true>(F.lds, g, S, E);
        small_phase<0>(F, (const bf16*)(F.ws + WS_Z), SW, (const bf16*)(F.ws + WS_WGLU), SW, SW, MP, 8, (bf16*)(F.ws + WS_GL), SW, 128); } SEAM(6);
    if (IN(7)) { p5_mixnorm(F); } SEAM(7);
    if (IN(8)) { pg8::Gemm g{(const bf16*)(F.ws + WS_CAT), (const bf16*)(F.ws + WS_WOUT), MP, D, D}; pg8::StaticOrder S; S.init(MP, D, F.G, (int)blockIdx.x);
        pg8::EpiBf16<0> E{OB, D}; pg8::gemm_phase<pg8::EpiBf16<0>, pg8::StaticOrder, true, true>(F.lds, g, S, E);
        small_phase<0>(F, (const bf16*)(F.ws + WS_CAT), D, (const bf16*)(F.ws + WS_WOUT), D, D, MP, 8, OB, D, 0); } SEAM(8);
    if (IN(9)) { p7_mid(F); } SEAM(9);
    if (IN(10)) { pg8::Gemm g{XN, (const bf16*)(F.ws + WS_WUP), MP, DFF, D}; pg8::StaticOrder S; S.init(MP, DFF, F.G, (int)blockIdx.x);
        pg8::EpiBf16<2> E{(bf16*)(F.ws + WS_H), DFF}; pg8::gemm_phase<pg8::EpiBf16<2>, pg8::StaticOrder, true, true>(F.lds, g, S, E);
        small_phase<2>(F, XN, D, (const bf16*)(F.ws + WS_WUP), D, DFF, MP, 8, (bf16*)(F.ws + WS_H), DFF, 0); } SEAM(10);
    if (IN(11)) { pg8::Gemm g{(const bf16*)(F.ws + WS_H), (const bf16*)(F.ws + WS_WDN), MP, D, DFF}; pg8::StaticOrder S; S.init(MP, D, F.G, (int)blockIdx.x);
        pg8::EpiBf16<0> E{OB, D}; pg8::gemm_phase<pg8::EpiBf16<0>, pg8::StaticOrder, true, true>(F.lds, g, S, E);
        for (int su = (int)blockIdx.x; su < 256; su += F.G) { const int kq = su & 7, nt = (su >> 3) & 3, mt = su >> 5;
            const SEpiF32 E2{(float*)(F.ws + WS_XN) + (size_t)kq * MS * D, D, MP};
            small_unit(F, (const bf16*)(F.ws + WS_H), DFF, (const bf16*)(F.ws + WS_WDN), DFF, MP + 64 * mt, 256 * nt, 512 * kq, 512, E2); } } SEAM(11);
    if (IN(12)) { p10_final(F); }
#undef IN
#undef SEAM
}

extern "C" void kernel_launch(void* const* d_in, const int* in_sizes, int n_in, void* d_out, int out_size, void* d_ws, size_t ws_size, hipStream_t stream) {
    static int grid = 0;
    if (grid == 0) {
        if (n_in != 27 || ws_size < WS_TOP) { fprintf(stderr, "kernel_launch: unexpected n_in %d / ws %zu\n", n_in, ws_size); grid = -1; return; }
        int dev = 0, cus = 0, per_cu = 0;
        if (hipGetDevice(&dev) != hipSuccess || hipDeviceGetAttribute(&cus, hipDeviceAttributeMultiprocessorCount, dev) != hipSuccess) { grid = -1; return; }
        if (hipFuncSetAttribute((const void*)hymba_fwd, hipFuncAttributeMaxDynamicSharedMemorySize, LDS_BYTES) != hipSuccess) { fprintf(stderr, "kernel_launch: hipFuncSetAttribute failed\n"); grid = -1; return; }
        if (hipOccupancyMaxActiveBlocksPerMultiprocessor(&per_cu, (const void*)hymba_fwd, NWAVES * 64, LDS_BYTES) != hipSuccess || per_cu < 1) { fprintf(stderr, "kernel_launch: occupancy query says %d\n", per_cu); per_cu = 1; }
        (void)hipGetLastError();
        grid = cus;
    }
    if (grid < 0) return;
    (void)hipMemsetAsync((char*)d_ws + WS_CTL, 0, CTL_ZERO_BYTES, stream);
    Args a{};
    for (int i = 0; i < 27; ++i) a.in[i] = (const float*)d_in[i];
    a.out = (float*)d_out; a.ws = (unsigned char*)d_ws;
#if MK_N_LAUNCHES == 1
    a.ph_lo = 0; a.ph_hi = N_PHASES;
    void* kargs[] = {&a};
    hipError_t e = hipLaunchCooperativeKernel((const void*)hymba_fwd, dim3(grid), dim3(NWAVES * 64), kargs, LDS_BYTES, stream);
    if (e != hipSuccess) fprintf(stderr, "kernel_launch: cooperative launch failed: %s (grid %d)\n", hipGetErrorString(e), grid);
#else
    for (int p = 0; p < N_PHASES; ++p) { a.ph_lo = p; a.ph_hi = p + 1; hipLaunchKernelGGL(hymba_fwd, dim3(grid), dim3(NWAVES * 64), LDS_BYTES, stream, a); }
#endif
}
```

```cpp
#include <hip/hip_runtime.h>
#include <cstdio>
#include <cstdint>
namespace pg8 {
#define PG8_LAS __attribute__((address_space(3)))
typedef unsigned short bf16_t;
typedef short bf16x8 __attribute__((ext_vector_type(8)));
typedef float f32x4 __attribute__((ext_vector_type(4)));
typedef unsigned u32x4 __attribute__((ext_vector_type(4)));
constexpr int BM = 256, BK = 64, HALF = 128, HTB = HALF * BK * 2  , STAGE_BYTES = 8 * HTB, NXCD = 8, WGM = 8;

__host__ __device__ __forceinline__ int lds_byte(int r, int c) { const int st = (r >> 4) * 2 + (c >> 5), rr = r & 15, cc = c & 31, ob = rr * 64 + cc * 2; return st * 1024 + (ob ^ (((ob >> 9) & 1) << 5)); }
__host__ __device__ __forceinline__ void stage_rc(int b, int& R, int& C) { const int st = b / 1024, sb = b % 1024, swz = sb ^ (((sb >> 9) & 1) << 5); R = (st >> 1) * 16 + swz / 64; C = (st & 1) * 32 + (swz % 64) / 2; }
__host__ __device__ __forceinline__ int perm32(int rho) { const int n = rho >> 4, i = rho & 15; return 8 * (i >> 2) + 4 * n + (i & 3); }

struct Unit { int pm, pn; };
struct Gemm { const bf16_t* A; const bf16_t* Bt; int M, N, K; };

struct StaticOrder {
    int nM, nN, nwg, G, c;
    __host__ __device__ void init(int M, int N, int G_, int c_) { nM = M / BM; nN = N / BM; nwg = nM * nN; G = G_; c = c_; }
    __host__ __device__ bool next(int i, Unit& u) const {
        const long L = (long)i * G + c; if (L >= nwg) return false;
        int wgid = (int)L; { const int q = nwg / NXCD, r = nwg % NXCD, xcd = wgid % NXCD, off = wgid / NXCD; wgid = (xcd < r ? xcd * (q + 1) : r * (q + 1) + (xcd - r) * q) + off; }
        const int nig = WGM * nN, gid = wgid / nig, fm = gid * WGM, gsz = (nM - fm) < WGM ? (nM - fm) : WGM;
        u.pm = fm + ((wgid % nig) % gsz); u.pn = (wgid % nig) / gsz; return true;
    }
    __device__ __forceinline__ void a_ready(const Unit&) const {}
    __device__ __forceinline__ void done(const Unit&) const {}
};
__device__ __forceinline__ unsigned cvt_pk_bf16(float lo, float hi) { unsigned r; asm volatile("v_cvt_pk_bf16_f32 %0, %1, %2" : "=v"(r) : "v"(lo), "v"(hi)); return r; }
template <int ACT> struct EpiBf16 {
    static constexpr bool PERM = true, AFTER_DRAIN = false;
    bf16_t* O; int ldc;
    __device__ __forceinline__ void operator()(const f32x4 (&acc)[2][2][4][2], const Unit& u, int wr, int wc, int fr, int fq) const {
        const int row0 = u.pm * BM + wr * 64 + fr; const int col0 = u.pn * BM + wc * 32 + 8 * fq;
#pragma unroll
        for (int ai = 0; ai < 2; ++ai)
#pragma unroll
            for (int m = 0; m < 4; ++m) { bf16_t* rowp = O + (size_t)(row0 + ai * HALF + m * 16) * ldc + col0;
#pragma unroll
                for (int bj = 0; bj < 2; ++bj) { f32x4 v0 = acc[ai][bj][m][0], v1 = acc[ai][bj][m][1];
                    if (ACT == 2) {
#pragma unroll
                        for (int e = 0; e < 4; ++e) { const float a = fmaxf(v0[e], 0.f), b = fmaxf(v1[e], 0.f); v0[e] = a * a; v1[e] = b * b; } }
                    u32x4 w; w.x = cvt_pk_bf16(v0[0], v0[1]); w.y = cvt_pk_bf16(v0[2], v0[3]); w.z = cvt_pk_bf16(v1[0], v1[1]); w.w = cvt_pk_bf16(v1[2], v1[3]);
                    *(u32x4*)(rowp + bj * HALF) = w; } }
    }
};
struct EpiBf16Fin {
    static constexpr bool PERM = true, AFTER_DRAIN = false;
    bf16_t* O; int ldc; const PG8_LAS float* fin;
    __device__ __forceinline__ void operator()(const f32x4 (&acc)[2][2][4][2], const Unit& u, int wr, int wc, int fr, int fq) const {
        const int row0 = u.pm * BM + wr * 64 + fr; const int col0 = u.pn * BM + wc * 32 + 8 * fq;
#pragma unroll
        for (int ai = 0; ai < 2; ++ai)
#pragma unroll
            for (int m = 0; m < 4; ++m) { bf16_t* rowp = O + (size_t)(row0 + ai * HALF + m * 16) * ldc + col0; const float f = fin[ai * HALF + wr * 64 + m * 16 + fr];
#pragma unroll
                for (int bj = 0; bj < 2; ++bj) { const f32x4 v0 = acc[ai][bj][m][0] * f, v1 = acc[ai][bj][m][1] * f;
                    u32x4 w; w.x = cvt_pk_bf16(v0[0], v0[1]); w.y = cvt_pk_bf16(v0[2], v0[3]); w.z = cvt_pk_bf16(v1[0], v1[1]); w.w = cvt_pk_bf16(v1[2], v1[3]);
                    *(u32x4*)(rowp + bj * HALF) = w; } }
    }
};
struct EpiGlu {
    static constexpr bool PERM = true, AFTER_DRAIN = false;
    const bf16_t* Z; int ldz; bf16_t* O; int ldc; float* SS;
    __device__ __forceinline__ void operator()(const f32x4 (&acc)[2][2][4][2], const Unit& u, int wr, int wc, int fr, int fq) const {
        const int row0 = u.pm * BM + wr * 64 + fr; const int col0 = u.pn * BM + wc * 32 + 8 * fq;
#pragma unroll
        for (int ai = 0; ai < 2; ++ai)
#pragma unroll
            for (int m = 0; m < 4; ++m) { const int row = row0 + ai * HALF + m * 16; float ss = 0.f;
#pragma unroll
                for (int bj = 0; bj < 2; ++bj) { const u32x4 zw = *(const u32x4*)(Z + (size_t)row * ldz + col0 + bj * HALF);
                    const float z[8] = {__uint_as_float(zw.x << 16), __uint_as_float(zw.x & 0xffff0000u), __uint_as_float(zw.y << 16), __uint_as_float(zw.y & 0xffff0000u),
                                        __uint_as_float(zw.z << 16), __uint_as_float(zw.z & 0xffff0000u), __uint_as_float(zw.w << 16), __uint_as_float(zw.w & 0xffff0000u)};
                    float o[8];
#pragma unroll
                    for (int e = 0; e < 4; ++e) { o[e] = z[e] / (1.0f + __expf(-acc[ai][bj][m][0][e])); o[4 + e] = z[4 + e] / (1.0f + __expf(-acc[ai][bj][m][1][e])); }
#pragma unroll
                    for (int e = 0; e < 8; ++e) ss += o[e] * o[e];
                    u32x4 w; w.x = cvt_pk_bf16(o[0], o[1]); w.y = cvt_pk_bf16(o[2], o[3]); w.z = cvt_pk_bf16(o[4], o[5]); w.w = cvt_pk_bf16(o[6], o[7]);
                    *(u32x4*)(O + (size_t)row * ldc + col0 + bj * HALF) = w; }
                ss += __shfl_xor(ss, 16); ss += __shfl_xor(ss, 32);
                if (fq == 0) SS[(size_t)row * 32 + u.pn * 4 + wc] = ss; }
    }
};
template <class Epi, class Sched, bool ALIGN_EPI = false, bool SP2 = false, bool MID = false>
__device__ __forceinline__ void gemm_phase(PG8_LAS unsigned char* lds, const Gemm g, const Sched& S, const Epi& E) {
    const int tid = threadIdx.x, wid = __builtin_amdgcn_readfirstlane(tid >> 6), lane = tid & 63, wr = wid >> 2, wc = wid & 3, fr = lane & 15, fq = lane >> 4;
    const int K = g.K, nt = K / BK;
    unsigned voffA[2], voffB[2];
#pragma unroll
    for (int i = 0; i < 2; ++i) { int R, C; stage_rc(tid * 16 + i * 8192, R, C); const int Rb = Epi::PERM ? ((R & ~31) + perm32(R & 31)) : R;
        voffA[i] = (unsigned)(R * K + C) * 2u; voffB[i] = (unsigned)(Rb * K + C) * 2u; }
    const size_t kstep = (size_t)(BK * 2);
    const size_t hstep = (size_t)HALF * K * 2;
    const size_t tstep = 2 * hstep;
    const unsigned ldsw = (unsigned)wid * 1024u;
    const int aoff = lds_byte(wr * 64 + fr, fq * 8), boff = lds_byte(wc * 32 + fr, fq * 8);
#define PG8_SA(b, h) (((b) * 2 + (h)) * HTB)
#define PG8_SB(b, h) ((4 + (b) * 2 + (h)) * HTB)
#define PG8_STAGE(bufoff, gbase, voff) do { _Pragma("unroll") for (int _i = 0; _i < 2; ++_i) \
        __builtin_amdgcn_global_load_lds((const unsigned*)((const char*)(gbase) + (voff)[_i]), (PG8_LAS unsigned*)(lds + (bufoff) + ldsw + _i * 8192), 16, 0, 0); } while (0)
#define PG8_LDA(dst, b, h) do { _Pragma("unroll") for (int m = 0; m < 4; ++m) _Pragma("unroll") for (int k = 0; k < 2; ++k) dst[m][k] = *(const PG8_LAS bf16x8*)(lds + PG8_SA(b, h) + aoff + m * 2048 + k * 1024); } while (0)
#define PG8_LDB(dst, b, h) do { _Pragma("unroll") for (int n = 0; n < 2; ++n) _Pragma("unroll") for (int k = 0; k < 2; ++k) dst[n][k] = *(const PG8_LAS bf16x8*)(lds + PG8_SB(b, h) + boff + n * 2048 + k * 1024); } while (0)
#define PG8_MMA(ai, bj, At, Bt) do { __builtin_amdgcn_s_setprio(1); _Pragma("unroll") for (int m = 0; m < 4; ++m) _Pragma("unroll") for (int n = 0; n < 2; ++n) _Pragma("unroll") for (int k = 0; k < 2; ++k) \
        acc[ai][bj][m][n] = __builtin_amdgcn_mfma_f32_16x16x32_bf16(Bt[n][k], At[m][k], acc[ai][bj][m][n], 0, 0, 0); __builtin_amdgcn_s_setprio(0); } while (0)
#define PG8_WAIT_V(n) asm volatile("s_waitcnt vmcnt(" #n ")" ::: "memory")
#define PG8_WAIT_L(n) asm volatile("s_waitcnt lgkmcnt(" #n ")" ::: "memory")
#define PG8_BAR __builtin_amdgcn_s_barrier()
#define PG8_SCHED __builtin_amdgcn_sched_barrier(0)
    Unit cur, nxt; int ui = 0;
    if (!S.next(0, cur)) return;
    f32x4 acc[2][2][4][2];
#pragma unroll
    for (int a = 0; a < 2; ++a)
#pragma unroll
        for (int b = 0; b < 2; ++b)
#pragma unroll
            for (int m = 0; m < 4; ++m)
#pragma unroll
                for (int n = 0; n < 2; ++n) acc[a][b][m][n] = (f32x4){0.f, 0.f, 0.f, 0.f};
    bf16x8 At[4][2], B0[2][2], B1[2][2];
    const char* cA = (const char*)g.A + (size_t)cur.pm * tstep; const char* cB = (const char*)g.Bt + (size_t)cur.pn * tstep;
    S.a_ready(cur);
    if constexpr (SP2) {
        PG8_STAGE(PG8_SB(0, 0), cB, voffB); PG8_STAGE(PG8_SB(0, 1), cB + hstep, voffB); PG8_STAGE(PG8_SA(0, 0), cA, voffA); PG8_STAGE(PG8_SA(0, 1), cA + hstep, voffA);
        if (wr == 1) PG8_BAR;
        PG8_WAIT_V(2); PG8_BAR;
        PG8_STAGE(PG8_SB(1, 0), cB + kstep, voffB); PG8_STAGE(PG8_SA(1, 0), cA + kstep, voffA); PG8_STAGE(PG8_SB(1, 1), cB + hstep + kstep, voffB);
        PG8_WAIT_V(6); PG8_BAR;
    } else {
        PG8_STAGE(PG8_SB(0, 0), cB, voffB); PG8_STAGE(PG8_SA(0, 0), cA, voffA); PG8_STAGE(PG8_SB(0, 1), cB + hstep, voffB); PG8_STAGE(PG8_SA(0, 1), cA + hstep, voffA);
        if (wr == 1) PG8_BAR;
        PG8_WAIT_V(4); PG8_BAR;
        PG8_STAGE(PG8_SB(1, 0), cB + kstep, voffB); PG8_STAGE(PG8_SA(1, 0), cA + kstep, voffA); PG8_STAGE(PG8_SB(1, 1), cB + hstep + kstep, voffB);
        PG8_WAIT_V(6); PG8_BAR;
    }
    for (;;) {
        const bool has_next = S.next(ui + 1, nxt);
        const char* nA = has_next ? (const char*)g.A + (size_t)nxt.pm * tstep : cA; const char* nB = has_next ? (const char*)g.Bt + (size_t)nxt.pn * tstep : cB;
        for (int t = 0; t < nt; t += 2) {
            if constexpr (MID) { if (t == (nt >> 1)) {
                float rr[2][4];
#pragma unroll
                for (int ai = 0; ai < 2; ++ai)
#pragma unroll
                    for (int m = 0; m < 4; ++m) rr[ai][m] = *(const PG8_LAS float*)(lds + STAGE_BYTES + (ai * HALF + wr * 64 + m * 16 + fr) * 4);
                asm volatile("s_waitcnt lgkmcnt(0)" ::: "memory");
#pragma unroll
                for (int ai = 0; ai < 2; ++ai)
#pragma unroll
                    for (int bj = 0; bj < 2; ++bj)
#pragma unroll
                        for (int m = 0; m < 4; ++m)
#pragma unroll
                            for (int n = 0; n < 2; ++n) acc[ai][bj][m][n] *= rr[ai][m];
            } }
            const bool last = (t == nt - 2);
            const char* a1 = cA + (size_t)(t + 1) * kstep;
            const char* a2 = last ? nA : cA + (size_t)(t + 2) * kstep; const char* b2 = last ? nB : cB + (size_t)(t + 2) * kstep;
            const char* a3 = a2 + kstep; const char* b3 = b2 + kstep;
            if (last && has_next) S.a_ready(nxt);
            if constexpr (SP2) {
            PG8_LDB(B0, 0, 0); PG8_LDB(B1, 0, 1); PG8_SCHED; PG8_LDA(At, 0, 0); PG8_STAGE(PG8_SA(1, 1), a1 + hstep, voffA);
            PG8_WAIT_V(8); PG8_WAIT_L(0); PG8_BAR; PG8_MMA(0, 0, At, B0); PG8_MMA(0, 1, At, B1); PG8_BAR; PG8_SCHED;
            PG8_LDA(At, 0, 1); PG8_STAGE(PG8_SB(0, 0), b2, voffB); PG8_STAGE(PG8_SB(0, 1), b2 + hstep, voffB); PG8_STAGE(PG8_SA(0, 0), a2, voffA);
            PG8_WAIT_V(8); PG8_WAIT_L(0); PG8_BAR; PG8_MMA(1, 0, At, B0); PG8_MMA(1, 1, At, B1); PG8_BAR; PG8_SCHED;
            PG8_LDB(B0, 1, 0); PG8_LDB(B1, 1, 1); PG8_SCHED; PG8_LDA(At, 1, 0); PG8_STAGE(PG8_SA(0, 1), a2 + hstep, voffA);
            PG8_WAIT_V(8); PG8_WAIT_L(0); PG8_BAR; PG8_MMA(0, 0, At, B0); PG8_MMA(0, 1, At, B1); PG8_BAR; PG8_SCHED;
            PG8_LDA(At, 1, 1); PG8_STAGE(PG8_SB(1, 0), b3, voffB); PG8_STAGE(PG8_SB(1, 1), b3 + hstep, voffB); PG8_STAGE(PG8_SA(1, 0), a3, voffA);
            PG8_WAIT_V(8); PG8_WAIT_L(0); PG8_BAR; PG8_MMA(1, 0, At, B0); PG8_MMA(1, 1, At, B1); PG8_BAR; PG8_SCHED;
            } else {
            PG8_LDB(B0, 0, 0); PG8_SCHED; PG8_LDA(At, 0, 0); PG8_STAGE(PG8_SA(1, 1), a1 + hstep, voffA);
            PG8_WAIT_L(8); PG8_BAR; PG8_WAIT_L(0); PG8_MMA(0, 0, At, B0); PG8_BAR; PG8_SCHED;
            PG8_LDB(B1, 0, 1); PG8_STAGE(PG8_SB(0, 0), b2, voffB);
            PG8_BAR; PG8_WAIT_L(0); PG8_MMA(0, 1, At, B1); PG8_BAR;
            PG8_LDA(At, 0, 1); PG8_STAGE(PG8_SA(0, 0), a2, voffA);
            PG8_BAR; PG8_WAIT_L(0); PG8_MMA(1, 0, At, B0); PG8_BAR; PG8_SCHED;
            PG8_STAGE(PG8_SB(0, 1), b2 + hstep, voffB);
            PG8_WAIT_V(6); PG8_BAR; PG8_MMA(1, 1, At, B1); PG8_BAR;
            PG8_LDB(B0, 1, 0); PG8_SCHED; PG8_LDA(At, 1, 0); PG8_STAGE(PG8_SA(0, 1), a2 + hstep, voffA);
            PG8_WAIT_L(8); PG8_BAR; PG8_WAIT_L(0); PG8_MMA(0, 0, At, B0); PG8_BAR; PG8_SCHED;
            PG8_LDB(B1, 1, 1); PG8_STAGE(PG8_SB(1, 0), b3, voffB);
            PG8_BAR; PG8_WAIT_L(0); PG8_MMA(0, 1, At, B1); PG8_BAR;
            PG8_LDA(At, 1, 1); PG8_STAGE(PG8_SA(1, 0), a3, voffA);
            PG8_BAR; PG8_WAIT_L(0); PG8_MMA(1, 0, At, B0); PG8_BAR; PG8_SCHED;
            PG8_STAGE(PG8_SB(1, 1), b3 + hstep, voffB);
            PG8_WAIT_V(6); PG8_BAR; PG8_MMA(1, 1, At, B1); PG8_BAR;
            }
        }
        if constexpr (ALIGN_EPI) { if (wr == 0) PG8_BAR; }
        if constexpr (!Epi::AFTER_DRAIN) { E(acc, cur, wr, wc, fr, fq); S.done(cur); }
        if (!has_next) break;
#pragma unroll
        for (int a = 0; a < 2; ++a)
#pragma unroll
            for (int b = 0; b < 2; ++b)
#pragma unroll
                for (int m = 0; m < 4; ++m)
#pragma unroll
                    for (int n = 0; n < 2; ++n) acc[a][b][m][n] = (f32x4){0.f, 0.f, 0.f, 0.f};
        cur = nxt; cA = nA; cB = nB; ++ui;
        if constexpr (ALIGN_EPI) { if (wr == 1) PG8_BAR; }
    }
    PG8_WAIT_V(0);
    if constexpr (!ALIGN_EPI) { if (wr == 0) PG8_BAR; }
    PG8_BAR;
    if constexpr (Epi::AFTER_DRAIN) { E.fused(acc, cur, wr, wc, fr, fq, lds, wid, lane); S.done(cur); }
#undef PG8_SA
#undef PG8_SB
#undef PG8_STAGE
#undef PG8_LDA
#undef PG8_LDB
#undef PG8_MMA
#undef PG8_WAIT_V
#undef PG8_WAIT_L
#undef PG8_BAR
#undef PG8_SCHED
}
}

constexpr int NWAVES = 8;
constexpr int D = 1024, DIN = 1280, DFF = 4096, AW = 512, SW = 512;
constexpr int MP = 16384, MS = 512, MR = MP + MS;
constexpr int MMETA = MR, NMETA = 16, MIN_ROWS = 17152;
constexpr int NPOS = 4112 + 4;
constexpr float EPS = 1e-6f;
constexpr size_t O_YP = 0, O_YS = 16777216, O_KP = 17301504, O_VP = 17367040, O_SRP = 17432576, O_SIP = 17440768, O_KS = 17448960, O_VS = 19546112, O_SRS = 21643264, O_SIS = 21905408;
constexpr size_t MiB = 1u << 20;
constexpr size_t WS_CTL = 0, CTL_ZERO_BYTES = 1 * MiB;
constexpr size_t WS_ROPEC = 1 * MiB, WS_ROPES = WS_ROPEC + 160 * 1024, WS_ABR = WS_ROPES + 160 * 1024, WS_ABI = WS_ABR + 8192, WS_BBR = WS_ABI + 8192, WS_BBI = WS_BBR + 131072;
static_assert(WS_BBI + 131072 <= 2 * MiB && NPOS * 8 * 4 <= 160 * 1024, "tables");
constexpr size_t WS_WIN = 2 * MiB, WS_WGLU = 5 * MiB, WS_WOUT = 6 * MiB, WS_WUP = 8 * MiB, WS_WDN = 16 * MiB;
constexpr size_t WS_XN = 24 * MiB, WS_O = 58 * MiB, WS_P = 92 * MiB, WS_ATT = 134 * MiB, WS_Z = 151 * MiB, WS_GL = 168 * MiB, WS_CAT = 185 * MiB, WS_H = 92 * MiB, WS_END = 224 * MiB;
constexpr size_t WS_VT = 224 * MiB, WS_QT = 228 * MiB, WS_KC = 232 * MiB, WS_HL = 233 * MiB, WS_HIN = 241 * MiB, WS_HM = 245 * MiB, WS_A32 = WS_HM + 16384, WS_COEF = WS_A32 + 16384, WS_POW = WS_COEF + 16384, WS_SS = 246 * MiB, WS_TOP = 249 * MiB;
static_assert(WS_XN + (size_t)MIN_ROWS * D * 2 <= WS_O && WS_O + (size_t)MR * D * 2 <= WS_P && WS_P + (size_t)MIN_ROWS * DIN * 2 <= WS_ATT && WS_ATT + (size_t)MR * AW * 2 <= WS_Z && WS_Z + (size_t)MR * SW * 2 <= WS_GL &&
              WS_GL + (size_t)MR * SW * 2 <= WS_CAT && WS_CAT + (size_t)MR * D * 2 <= WS_END && WS_H + (size_t)MR * DFF * 2 <= WS_END, "d_ws map");
constexpr int CW_BAR = 4096;
constexpr int RING_BYTES = 131072, LDS_BYTES = 163840, LDSCTL_OFF = LDS_BYTES - 512, MISC_OFF = LDSCTL_OFF + 320;

#define GAS __attribute__((address_space(1)))
#define LAS __attribute__((address_space(3)))
typedef unsigned short bf16;
typedef unsigned v4u __attribute__((ext_vector_type(4)));
typedef unsigned v2u __attribute__((ext_vector_type(2)));
typedef float f32x4 __attribute__((ext_vector_type(4)));
typedef GAS unsigned gu32;
#define RLX_AGENT __ATOMIC_RELAXED, __HIP_MEMORY_SCOPE_AGENT
#define LDS_WAIT() asm volatile("s_waitcnt lgkmcnt(0)" ::: "memory")
#define VM_WAIT() asm volatile("s_waitcnt vmcnt(0)" ::: "memory")
__device__ __forceinline__ unsigned f2bf(float f) { unsigned u = __builtin_bit_cast(unsigned, f); return (u + 0x7fffu + ((u >> 16) & 1u)) >> 16; }
__device__ __forceinline__ unsigned pk2(float lo, float hi) { return f2bf(lo) | (f2bf(hi) << 16); }
__device__ __forceinline__ float bflo(unsigned w) { return __uint_as_float(w << 16); }
__device__ __forceinline__ float bfhi(unsigned w) { return __uint_as_float(w & 0xffff0000u); }
__device__ __forceinline__ float bf1(bf16 b) { return __uint_as_float((unsigned)b << 16); }

#define XB_TMO      128
#define XB_XCNT(j)  (256  + 64 * (j))
#define XB_XSUB(j)  (1280 + 64 * (j))
#define XB_XGEN(j)  (2304 + 64 * (j))
#define XB_TOP      3328
#define XB_TOPGEN   3392
#define XCD_BAR_WORDS 3456
#define XB_SPIN_CAP (1u << 18)
__device__ __forceinline__ unsigned xb_ld(unsigned* p)              { return __hip_atomic_load(p, __ATOMIC_RELAXED, __HIP_MEMORY_SCOPE_AGENT); }
__device__ __forceinline__ unsigned xb_add(unsigned* p, unsigned v) { return __hip_atomic_fetch_add(p, v, __ATOMIC_RELAXED, __HIP_MEMORY_SCOPE_AGENT); }
__device__ __forceinline__ unsigned xb_xcc_id() { return (unsigned)__builtin_amdgcn_s_getreg((3 << 11) | 20) & 0xFu; }
#define XB_SPIN(cond, bar) do { unsigned _sp = 0; while (cond) { __builtin_amdgcn_s_sleep(1); \
    if ((++_sp & 255u) == 0u) { if (xb_ld(&(bar)[XB_TMO])) break; if (_sp > XB_SPIN_CAP) { atomicAdd(&(bar)[XB_TMO], 1u); break; } } } } while (0)
struct XcdBarrier { unsigned* bar; unsigned x; volatile LAS unsigned* st; };
__device__ __forceinline__ XcdBarrier xcd_barrier_post(unsigned* bar, volatile LAS unsigned* st) {
    XcdBarrier b; b.bar = bar; b.x = xb_xcc_id(); b.st = st;
    if (threadIdx.x == 0) (void)xb_add(&bar[XB_XCNT(b.x)], 1u);
    return b;
}
__device__ __forceinline__ void xcd_barrier_complete(unsigned* bar, unsigned x, unsigned& nloc, unsigned& nx) {
    const unsigned G = gridDim.x * gridDim.y * gridDim.z;
    unsigned sum, cnt, mine, sp = 0u;
    for (;;) {
        sum = 0u; cnt = 0u; mine = 0u;
#pragma unroll
        for (unsigned j = 0; j < 16; ++j) { const unsigned c = xb_ld(&bar[XB_XCNT(j)]); sum += c; cnt += (c > 0u) ? 1u : 0u; mine = (j == x) ? c : mine; }
        if (sum == G) break;
        __builtin_amdgcn_s_sleep(1);
        if ((++sp & 255u) == 0u) { if (xb_ld(&bar[XB_TMO])) break; if (sp > XB_SPIN_CAP) { atomicAdd(&bar[XB_TMO], 1u); break; } }
    }
    nloc = mine > 0u ? mine : 1u; nx = cnt > 0u ? cnt : 1u;
}
__device__ __forceinline__ void xcd_barrier(const XcdBarrier& b) {
    asm volatile("s_waitcnt vmcnt(0)" ::: "memory");
    __syncthreads();
    if (threadIdx.x == 0) {
        unsigned* bar = b.bar;
        __builtin_amdgcn_s_waitcnt(0);
        unsigned nloc = b.st[0], nx = b.st[1];
        if (nloc == 0u) { xcd_barrier_complete(bar, b.x, nloc, nx); b.st[0] = nloc; b.st[1] = nx; }
        const unsigned old = xb_add(&bar[XB_XSUB(b.x)], 1u);
        const unsigned gen = old / nloc;
        if (old + 1u == (gen + 1u) * nloc) {
            __builtin_amdgcn_fence(__ATOMIC_RELEASE, "agent");
            asm volatile("s_waitcnt vmcnt(0)" ::: "memory");
            const unsigned og = xb_add(&bar[XB_TOP], 1u);
            const unsigned tg = og / nx;
            if (og + 1u == (tg + 1u) * nx) xb_add(&bar[XB_TOPGEN], 1u);
            else XB_SPIN(xb_ld(&bar[XB_TOPGEN]) == tg, bar);
            __builtin_amdgcn_fence(__ATOMIC_ACQUIRE, "agent");
            xb_add(&bar[XB_XGEN(b.x)], 1u);
            asm volatile("s_waitcnt vmcnt(0)" ::: "memory");
        } else {
            XB_SPIN(xb_ld(&bar[XB_XGEN(b.x)]) == gen, bar);
            __builtin_amdgcn_fence(__ATOMIC_ACQUIRE, "agent");
            asm volatile("s_waitcnt vmcnt(0)" ::: "memory");
        }
    }
    __syncthreads();
}

struct Frame {
    LAS unsigned char* lds;
    volatile LAS unsigned* MISC;
    gu32* ctl;
    int tid, lane, wave;
    int vcu, G;
    const float* in[27]; float* out; unsigned char* ws;
};
enum { I_XP = 0, I_XS, I_CK, I_CV, I_SRE, I_SIM, I_META, I_GPRE, I_WIN, I_SINK, I_ARE, I_AIM, I_LDT, I_BRE, I_BIM, I_CRE, I_CIM, I_DD, I_WGLU, I_GATT, I_GSSM, I_WOUT, I_GPOST, I_GMLP, I_WUP, I_WDN, I_GMLPP };

__device__ __forceinline__ float wave_sum(float v) {
#pragma unroll
    for (int o = 1; o < 64; o <<= 1) v += __shfl_xor(v, o);
    return v;
}
__device__ __forceinline__ float wave_max(float v) {
#pragma unroll
    for (int o = 1; o < 64; o <<= 1) v = fmaxf(v, __shfl_xor(v, o));
    return v;
}
__device__ __forceinline__ void sincos_d(double a, double& s, double& c) {
    const double k = __builtin_rint(a * 0.63661977236758134308);
    double r = __builtin_fma(-k, 1.57079632679489655800e+00, a);
    r = __builtin_fma(-k, 6.12323399573676603587e-17, r);
    const double r2 = r * r;
    double sp = 1.0 / 6227020800.0; sp = sp * r2 - 1.0 / 39916800.0; sp = sp * r2 + 1.0 / 362880.0; sp = sp * r2 - 1.0 / 5040.0; sp = sp * r2 + 1.0 / 120.0; sp = sp * r2 - 1.0 / 6.0; sp = sp * r2 + 1.0; sp = sp * r;
    double cp = -1.0 / 87178291200.0; cp = cp * r2 + 1.0 / 479001600.0; cp = cp * r2 - 1.0 / 3628800.0; cp = cp * r2 + 1.0 / 40320.0; cp = cp * r2 - 1.0 / 720.0; cp = cp * r2 + 1.0 / 24.0; cp = cp * r2 - 0.5; cp = cp * r2 + 1.0;
    const int q = ((int)k) & 3;
    s = (q == 0) ? sp : (q == 1) ? cp : (q == 2) ? -sp : -cp;
    c = (q == 0) ? cp : (q == 1) ? -sp : (q == 2) ? -cp : sp;
}
__device__ __forceinline__ double exp_d(double x) {
    const double k = __builtin_rint(x * 1.44269504088896340736);
    double r = __builtin_fma(-k, 6.93147180369123816490e-01, x); r = __builtin_fma(-k, 1.90821492927058770002e-10, r);
    double p = 1.0 / 6227020800.0; p = p * r + 1.0 / 479001600.0; p = p * r + 1.0 / 39916800.0; p = p * r + 1.0 / 3628800.0; p = p * r + 1.0 / 362880.0; p = p * r + 1.0 / 40320.0; p = p * r + 1.0 / 5040.0;
    p = p * r + 1.0 / 720.0; p = p * r + 1.0 / 120.0; p = p * r + 1.0 / 24.0; p = p * r + 1.0 / 6.0; p = p * r + 0.5; p = p * r + 1.0; p = p * r + 1.0;
    const long long bits = ((long long)(1023 + (int)k)) << 52;
    return p * __builtin_bit_cast(double, bits);
}
__device__ __forceinline__ float gelu_tanh(float x) {
    const float a = 0.7978845608028654f * (x + 0.044715f * x * x * x);
    const float e = __expf(2.0f * a);
    const float t = 1.0f - 2.0f / (e + 1.0f);
    return 0.5f * x * (1.0f + t);
}
__device__ __forceinline__ float sigmoidf_(float x) { return 1.0f / (1.0f + __expf(-x)); }

__device__ __forceinline__ void p0_transpose_item(const float* W, int K, int N, bf16* WT, LAS float* scr, int item, int lane, const float* kgain = nullptr) {
    const int nblk = N / 32, kb = item / nblk, nb = item % nblk, k0 = 64 * kb, n0 = 32 * nb;
#pragma unroll 8
    for (int i = 0; i < 32; ++i) { const int kk = 2 * i + (lane >> 5); const float gk = kgain ? kgain[k0 + kk] : 1.0f; scr[kk * 33 + (lane & 31)] = W[(size_t)(k0 + kk) * N + n0 + (lane & 31)] * gk; }
    LDS_WAIT(); asm volatile("" ::: "memory");
    const int c = lane & 7;
#pragma unroll
    for (int j = 0; j < 4; ++j) { const int n = (lane >> 3) + 8 * j; const LAS float* s = scr + (8 * c) * 33 + n;
        v4u o; o.x = pk2(s[0 * 33], s[1 * 33]); o.y = pk2(s[2 * 33], s[3 * 33]); o.z = pk2(s[4 * 33], s[5 * 33]); o.w = pk2(s[6 * 33], s[7 * 33]);
        *(GAS v4u*)(WT + (size_t)(n0 + n) * K + k0 + 8 * c) = o; }
    LDS_WAIT(); asm volatile("" ::: "memory");
}
__device__ __forceinline__ void rms_row_to_bf16(const float* xrow, const float* g, bf16* orow, int lane) {
    const GAS f32x4* xr = (const GAS f32x4*)xrow + lane;
    f32x4 v[4]; float s = 0.f;
#pragma unroll
    for (int j = 0; j < 4; ++j) { v[j] = xr[64 * j]; s += (v[j].x * v[j].x + v[j].y * v[j].y) + (v[j].z * v[j].z + v[j].w * v[j].w); }
    const float rs = 1.0f / sqrtf(wave_sum(s) * (1.f / 1024.f) + EPS);
    GAS unsigned long long* o8 = (GAS unsigned long long*)orow + lane;
#pragma unroll
    for (int j = 0; j < 4; ++j) { const f32x4 gg = ((const GAS f32x4*)g)[lane + 64 * j];
        o8[64 * j] = (unsigned long long)pk2(v[j].x * rs * gg.x, v[j].y * rs * gg.y) | ((unsigned long long)pk2(v[j].z * rs * gg.z, v[j].w * rs * gg.w) << 32); }
}
__device__ __forceinline__ const float* x_row_ptr(const Frame& F, int r) {
    return r < MP ? F.in[I_XP] + (size_t)r * D : (r < MR ? F.in[I_XS] + (size_t)(r - MP) * D : F.in[I_META] + (size_t)(r - MR) * D);
}
__device__ __forceinline__ void rms_rows4_to_bf16(const Frame& F, int m0, const float* g, bf16* XN, int lane) {
    f32x4 v[4][4]; float s[4];
#pragma unroll
    for (int q = 0; q < 4; ++q) { const GAS f32x4* xr = (const GAS f32x4*)x_row_ptr(F, m0 + q) + lane;
#pragma unroll
        for (int j = 0; j < 4; ++j) v[q][j] = xr[64 * j]; }
#pragma unroll
    for (int q = 0; q < 4; ++q) { float a = 0.f;
#pragma unroll
        for (int j = 0; j < 4; ++j) a += (v[q][j].x * v[q][j].x + v[q][j].y * v[q][j].y) + (v[q][j].z * v[q][j].z + v[q][j].w * v[q][j].w);
        s[q] = a; }
#pragma unroll
    for (int o = 1; o < 64; o <<= 1) {
#pragma unroll
        for (int q = 0; q < 4; ++q) s[q] += __shfl_xor(s[q], o); }
#pragma unroll
    for (int j = 0; j < 4; ++j) { const f32x4 gg = ((const GAS f32x4*)g)[lane + 64 * j];
#pragma unroll
        for (int q = 0; q < 4; ++q) { const float rs = 1.0f / sqrtf(s[q] * (1.f / 1024.f) + EPS);
            GAS unsigned long long* o8 = (GAS unsigned long long*)(XN + (size_t)(m0 + q) * D) + lane;
            o8[64 * j] = (unsigned long long)pk2(v[q][j].x * rs * gg.x, v[q][j].y * rs * gg.y) | ((unsigned long long)pk2(v[q][j].z * rs * gg.z, v[q][j].w * rs * gg.w) << 32); } }
}
constexpr int I_IN = (D / 64) * (DIN / 32), I_GL = (SW / 64) * (SW / 32), I_OU = (D / 64) * (D / 32), I_UP = (D / 64) * (DFF / 32), I_DN = (DFF / 64) * (D / 32);
__device__ __forceinline__ void p0_prologue(Frame& F) {
    LAS float* scr = (LAS float*)(F.lds + F.wave * 16384);
    const int gw = F.vcu * NWAVES + F.wave, NGW = F.G * NWAVES;
    bf16* XN = (bf16*)(F.ws + WS_XN);
    for (int it = NGW - 1 - gw; it < I_IN; it += NGW) p0_transpose_item(F.in[I_WIN], D, DIN, (bf16*)(F.ws + WS_WIN), scr, it, F.lane);
    for (int m4 = gw; m4 < MIN_ROWS / 4; m4 += NGW) {
        const int m = 4 * m4;
        if (m < MR + NMETA) rms_rows4_to_bf16(F, m, F.in[I_GPRE], XN, F.lane);
        else { for (int q = 0; q < 4; ++q) { GAS unsigned long long* o8 = (GAS unsigned long long*)(XN + (size_t)(m + q) * D) + F.lane;
#pragma unroll
            for (int j = 0; j < 4; ++j) o8[64 * j] = 0ull; } }
    }
    const int gt = F.vcu * (NWAVES * 64) + F.tid, NT = F.G * NWAVES * 64;
    float* ropeC = (float*)(F.ws + WS_ROPEC); float* ropeS = (float*)(F.ws + WS_ROPES);
    for (int i = gt; i < NPOS * 8; i += NT) {
        const int idx = i >> 3, fi = i & 7; const int pos = idx < 4112 ? idx : 8192 + (idx - 4112);
        const float inv = (float)exp_d(-(double)fi * 1.640295422175541);
        const float ang = (float)pos * inv;
        double s, c; sincos_d((double)ang, s, c);
        ropeC[i] = (float)c; ropeS[i] = (float)s;
    }
    float* abr = (float*)(F.ws + WS_ABR); float* abi = (float*)(F.ws + WS_ABI); float* bbr = (float*)(F.ws + WS_BBR); float* bbi = (float*)(F.ws + WS_BBI);
    for (int i = gt; i < 2048; i += NT) {
        const int g = i >> 6;
        const double dt = exp_d((double)F.in[I_LDT][g]); const double ar = (double)F.in[I_ARE][i], ai = (double)F.in[I_AIM][i];
        const double mag = exp_d(ar * dt); double s, c; sincos_d(ai * dt, s, c);
        const double are = mag * c, aim = mag * s;
        const double nr = are - 1.0, ni = aim, den = ar * ar + ai * ai;
        const double cr = (nr * ar + ni * ai) / den, ci = (ni * ar - nr * ai) / den;
        abr[i] = (float)are; abi[i] = (float)aim;
        for (int h = 0; h < 16; ++h) { const double br = (double)F.in[I_BRE][i * 16 + h], bi = (double)F.in[I_BIM][i * 16 + h];
            bbr[i * 16 + h] = (float)(cr * br - ci * bi); bbi[i * 16 + h] = (float)(cr * bi + ci * br); }
    }
}
__device__ __forceinline__ void p4_late_weights(Frame& F, int wi, int nw) {
    LAS float* scr = (LAS float*)(F.lds + F.wave * 16384);
    constexpr int NITEMS = I_GL + I_OU + I_UP + I_DN;
    for (int it = wi; it < NITEMS; it += nw) {
        int r = it;
        if (r < I_GL) { p0_transpose_item(F.in[I_WGLU], SW, SW, (bf16*)(F.ws + WS_WGLU), scr, r, F.lane); continue; } r -= I_GL;
        if (r < I_OU) { const int kb = r / (D / 32);
            p0_transpose_item(F.in[I_WOUT], D, D, (bf16*)(F.ws + WS_WOUT), scr, r, F.lane, kb < 8 ? F.in[I_GATT] : F.in[I_GSSM] - 512); continue; } r -= I_OU;
        if (r < I_UP) { p0_transpose_item(F.in[I_WUP], D, DFF, (bf16*)(F.ws + WS_WUP), scr, r, F.lane); continue; } r -= I_UP;
        p0_transpose_item(F.in[I_WDN], DFF, D, (bf16*)(F.ws + WS_WDN), scr, r, F.lane);
    }
}
__device__ __forceinline__ int pos_index(int r) { return r < MP ? (r & 4095) + 16 : (r < MR ? 4112 + ((r - MP) & 3) : r - MR); }
__device__ __forceinline__ void p2_rope(Frame& F) {
    const int gt = F.vcu * (NWAVES * 64) + F.tid, NT = F.G * NWAVES * 64;
    bf16* P = (bf16*)(F.ws + WS_P); const float* ropeC = (const float*)(F.ws + WS_ROPEC); const float* ropeS = (const float*)(F.ws + WS_ROPES);
    for (int it = gt; it < (MR + NMETA) * 80; it += NT) {
        const int r = it / 80, rem = it - r * 80, hh = rem >> 3, fi = rem & 7;
        bf16* p = P + (size_t)r * DIN + hh * 64 + fi;
        const float x1 = bf1(p[0]), x2 = bf1(p[8]);
        const int pi = pos_index(r) * 8 + fi; const float c = ropeC[pi], s = ropeS[pi];
        p[0] = (bf16)f2bf(x1 * c - x2 * s); p[8] = (bf16)f2bf(x2 * c + x1 * s);
    }
}
__device__ __forceinline__ void p3_ssm_naive(Frame& F) {
    LAS float* hs = (LAS float*)(F.lds + F.wave * 16384);
    const int gw = F.vcu * NWAVES + F.wave, NGW = F.G * NWAVES, lane = F.lane;
    const bf16* P = (const bf16*)(F.ws + WS_P); bf16* Z = (bf16*)(F.ws + WS_Z);
    const float* abr = (const float*)(F.ws + WS_ABR); const float* abi = (const float*)(F.ws + WS_ABI); const float* bbr = (const float*)(F.ws + WS_BBR); const float* bbi = (const float*)(F.ws + WS_BBI);
    for (int task = gw; task < (4 + 128) * 32; task += NGW) {
        const int seq = task >> 5, g = task & 31, gp = g * 64 + lane;
        const float are = abr[gp], aim = abi[gp];
        float br[16], bi[16];
#pragma unroll
        for (int h = 0; h < 16; ++h) { br[h] = bbr[gp * 16 + h]; bi[h] = bbi[gp * 16 + h]; }
        const int ho = lane & 15, qq = lane >> 4;
        float cr[16], ci[16];
#pragma unroll
        for (int j = 0; j < 16; ++j) { cr[j] = F.in[I_CRE][(g * 16 + ho) * 64 + qq * 16 + j]; ci[j] = F.in[I_CIM][(g * 16 + ho) * 64 + qq * 16 + j]; }
        const float dd = F.in[I_DD][g * 16 + ho];
        float hr, hi; int nsteps;
        if (seq < 4) { hr = 0.f; hi = 0.f; nsteps = 4112; }
        else { const int db = seq - 4; hr = F.in[I_SRE][(db * 32 + g) * 64 + lane]; hi = F.in[I_SIM][(db * 32 + g) * 64 + lane]; nsteps = 4; }
        for (int st = 0; st < nsteps; ++st) {
            int row; bool wr_out;
            if (seq < 4) { if (st < 16) { row = MR + st; wr_out = false; } else { row = seq * 4096 + st - 16; wr_out = true; } }
            else { row = MP + (seq - 4) * 4 + st; wr_out = true; }
            const v4u* up = (const v4u*)(P + (size_t)row * DIN + 768 + g * 16);
            const v4u u0 = up[0], u1 = up[1];
            float u[16];
            u[0] = bflo(u0.x); u[1] = bfhi(u0.x); u[2] = bflo(u0.y); u[3] = bfhi(u0.y); u[4] = bflo(u0.z); u[5] = bfhi(u0.z); u[6] = bflo(u0.w); u[7] = bfhi(u0.w);
            u[8] = bflo(u1.x); u[9] = bfhi(u1.x); u[10] = bflo(u1.y); u[11] = bfhi(u1.y); u[12] = bflo(u1.z); u[13] = bfhi(u1.z); u[14] = bflo(u1.w); u[15] = bfhi(u1.w);
            float bur = 0.f, bui = 0.f;
#pragma unroll
            for (int h = 0; h < 16; ++h) { bur += br[h] * u[h]; bui += bi[h] * u[h]; }
            const float nhr = are * hr - aim * hi + bur, nhi = are * hi + aim * hr + bui;
            hr = nhr; hi = nhi;
            if (wr_out) {
                hs[lane] = hr; hs[64 + lane] = hi;
                LDS_WAIT(); asm volatile("" ::: "memory");
                float y = 0.f;
#pragma unroll
                for (int j = 0; j < 16; ++j) y += cr[j] * hs[qq * 16 + j] - ci[j] * hs[64 + qq * 16 + j];
                y += __shfl_xor(y, 16); y += __shfl_xor(y, 32);
                float uo = u[0];
#pragma unroll
                for (int h = 1; h < 16; ++h) uo = (ho == h) ? u[h] : uo;
                y += dd * uo;
                const float z = gelu_tanh(y);
                if (lane < 16) Z[(size_t)row * SW + g * 16 + ho] = (bf16)f2bf(z);
                LDS_WAIT(); asm volatile("" ::: "memory");
            }
        }
        if (seq < 4) { F.out[O_SRP + (seq * 32 + g) * 64 + lane] = hr; F.out[O_SIP + (seq * 32 + g) * 64 + lane] = hi; }
        else { F.out[O_SRS + ((seq - 4) * 32 + g) * 64 + lane] = hr; F.out[O_SIS + ((seq - 4) * 32 + g) * 64 + lane] = hi; }
    }
}
__device__ __forceinline__ float dot64_bf16(const LAS float* qf, const bf16* kp) {
    float s = 0.f;
#pragma unroll 2
    for (int i = 0; i < 8; ++i) { const v4u k = ((const v4u*)kp)[i]; const f32x4 a = ((const LAS f32x4*)qf)[2 * i], b = ((const LAS f32x4*)qf)[2 * i + 1];
        s += a.x * bflo(k.x) + a.y * bfhi(k.x) + a.z * bflo(k.y) + a.w * bfhi(k.y) + b.x * bflo(k.z) + b.y * bfhi(k.z) + b.z * bflo(k.w) + b.w * bfhi(k.w); }
    return s;
}
__device__ __forceinline__ float dot64_f32(const LAS float* qf, const float* kp) {
    float s = 0.f;
#pragma unroll 2
    for (int i = 0; i < 16; ++i) { const f32x4 k = ((const f32x4*)kp)[i]; const f32x4 a = ((const LAS f32x4*)qf)[i];
        s += a.x * k.x + a.y * k.y + a.z * k.z + a.w * k.w; }
    return s;
}
__device__ __forceinline__ void p3_attn_naive(Frame& F) {
    LAS float* pw = (LAS float*)(F.lds + F.wave * 16384 + 1024);
    LAS float* qf = (LAS float*)(F.lds + F.wave * 16384 + 2048);
    const int gw = F.vcu * NWAVES + F.wave, NGW = F.G * NWAVES, lane = F.lane;
    const bf16* P = (const bf16*)(F.ws + WS_P); bf16* ATT = (bf16*)(F.ws + WS_ATT);
    const float NEG = -1e30f;
#pragma unroll 1
    for (int task = gw; task < MR * 8; task += NGW) {
        const int r = task >> 3, h = task & 7, kvh = h >> 2;
        qf[lane] = bf1(P[(size_t)r * DIN + h * 64 + lane]);
        LDS_WAIT(); asm volatile("" ::: "memory");
        const float sink = F.in[I_SINK][h];
        float l0, l1, l2 = NEG; bool v0, v1, v2 = false;
        if (r < MP) {
            const int b = r >> 12, s = r & 4095, pos = s + 16;
            const int kp0 = pos - 127 + lane, kp1 = kp0 + 64;
            v0 = kp0 >= 0; v1 = kp1 >= 0;
            const int kr0 = kp0 >= 16 ? b * 4096 + kp0 - 16 : MR + (kp0 < 0 ? 0 : kp0);
            const int kr1 = kp1 >= 16 ? b * 4096 + kp1 - 16 : MR + (kp1 < 0 ? 0 : kp1);
            l0 = dot64_bf16(qf, P + (size_t)kr0 * DIN + 512 + kvh * 64) * 0.125f;
            l1 = dot64_bf16(qf, P + (size_t)kr1 * DIN + 512 + kvh * 64) * 0.125f;
        } else {
            const int db = (r - MP) >> 2, t = (r - MP) & 3;
            v0 = lane >= t + 1; v1 = true;
            l0 = dot64_f32(qf, F.in[I_CK] + ((size_t)(db * 128 + lane) * 2 + kvh) * 64) * 0.125f;
            l1 = dot64_f32(qf, F.in[I_CK] + ((size_t)(db * 128 + lane + 64) * 2 + kvh) * 64) * 0.125f;
            v2 = lane <= t;
            const int tr = lane < 4 ? lane : 0;
            l2 = dot64_bf16(qf, P + (size_t)(MP + db * 4 + tr) * DIN + 512 + kvh * 64) * 0.125f;
        }
        l0 = v0 ? l0 : NEG; l1 = v1 ? l1 : NEG; l2 = v2 ? l2 : NEG;
        float m = wave_max(fmaxf(fmaxf(l0, l1), l2)); m = fmaxf(m, sink);
        const float e0 = v0 ? __expf(l0 - m) : 0.f, e1 = v1 ? __expf(l1 - m) : 0.f, e2 = v2 ? __expf(l2 - m) : 0.f;
        const float den = wave_sum(e0 + e1 + e2) + __expf(sink - m);
        const float inv = 1.0f / den;
        pw[lane] = e0 * inv; pw[64 + lane] = e1 * inv; pw[128 + lane] = e2 * inv;
        LDS_WAIT(); asm volatile("" ::: "memory");
        float o = 0.f;
        if (r < MP) {
            const int b = r >> 12, s = r & 4095, pos = s + 16;
#pragma unroll 1
            for (int j = 0; j < 128; ++j) { const int kp = pos - 127 + j; if (kp < 0) continue;
                const int kr = kp >= 16 ? b * 4096 + kp - 16 : MR + kp;
                o += pw[j] * bf1(P[(size_t)kr * DIN + 640 + kvh * 64 + lane]); }
        } else {
            const int db = (r - MP) >> 2, t = (r - MP) & 3;
#pragma unroll 1
            for (int j = t + 1; j < 128; ++j) o += pw[j] * F.in[I_CV][((size_t)(db * 128 + j) * 2 + kvh) * 64 + lane];
#pragma unroll 1
            for (int j = 0; j <= t; ++j) o += pw[128 + j] * bf1(P[(size_t)(MP + db * 4 + j) * DIN + 640 + kvh * 64 + lane]);
        }
        ATT[(size_t)r * AW + h * 64 + lane] = (bf16)f2bf(o);
        LDS_WAIT(); asm volatile("" ::: "memory");
    }
}
__device__ __forceinline__ void unpack8(const v4u w, float (&f)[8]) { f[0] = bflo(w.x); f[1] = bfhi(w.x); f[2] = bflo(w.y); f[3] = bfhi(w.y); f[4] = bflo(w.z); f[5] = bfhi(w.z); f[6] = bflo(w.w); f[7] = bfhi(w.w); }
__device__ __forceinline__ v4u pack8(const float (&f)[8]) { v4u w; w.x = pk2(f[0], f[1]); w.y = pk2(f[2], f[3]); w.z = pk2(f[4], f[5]); w.w = pk2(f[6], f[7]); return w; }
__device__ __forceinline__ void p3_windows(Frame& F) {
    const int gt = F.vcu * (NWAVES * 64) + F.tid, NT = F.G * NWAVES * 64;
    const bf16* P = (const bf16*)(F.ws + WS_P);
    constexpr int NQ = 128 * 3968;
#pragma unroll 1
    for (int q0 = gt; q0 < 2 * NQ; q0 += 4 * NT) {
        f32x4 v[4];
#pragma unroll
        for (int u = 0; u < 4; ++u) { const int q = q0 + u * NT; if (q < 2 * NQ) { const int t = q >= NQ ? 1 : 0, qq = q - t * NQ, db = qq / 3968, off = qq - db * 3968;
            v[u] = *(const f32x4*)((t ? F.in[I_CV] : F.in[I_CK]) + (size_t)db * 16384 + 512 + off * 4); } }
#pragma unroll
        for (int u = 0; u < 4; ++u) { const int q = q0 + u * NT; if (q < 2 * NQ) { const int t = q >= NQ ? 1 : 0, qq = q - t * NQ, db = qq / 3968, off = qq - db * 3968;
            *(f32x4*)(F.out + (t ? O_VS : O_KS) + (size_t)db * 16384 + off * 4) = v[u]; } }
    }
    for (int c = gt; c < 16384; c += NT) {
        int row; size_t dk, dv; const int ch = c & 15;
        if (c < 8192) { const int b = c >> 11, j = (c >> 4) & 127; row = b * 4096 + 3968 + j; dk = O_KP + (size_t)(b * 128 + j) * 128 + ch * 8; dv = dk + (O_VP - O_KP); }
        else { const int c2 = c - 8192, db = c2 >> 6, t = (c2 >> 4) & 3; row = MP + db * 4 + t; dk = O_KS + (size_t)(db * 128 + 124 + t) * 128 + ch * 8; dv = dk + (O_VS - O_KS); }
        float k[8], v[8];
        { v4u kw = *(const v4u*)(P + (size_t)row * DIN + 512 + ch * 8);
          v4u pw; pw.x = __shfl_xor(kw.x, 1); pw.y = __shfl_xor(kw.y, 1); pw.z = __shfl_xor(kw.z, 1); pw.w = __shfl_xor(kw.w, 1);
          if ((ch & 7) < 2) { const int pidx = pos_index(row); float a[8], bq[8]; unpack8(kw, a); unpack8(pw, bq);
              const float* c8 = (const float*)(F.ws + WS_ROPEC) + pidx * 8; const float* s8 = (const float*)(F.ws + WS_ROPES) + pidx * 8;
#pragma unroll
              for (int e = 0; e < 8; ++e) k[e] = (ch & 1) ? (a[e] * c8[e] + bq[e] * s8[e]) : (a[e] * c8[e] - bq[e] * s8[e]); }
          else unpack8(kw, k); }
        unpack8(*(const v4u*)(P + (size_t)row * DIN + 640 + ch * 8), v);
        *(f32x4*)(F.out + dk) = (f32x4){k[0], k[1], k[2], k[3]}; *(f32x4*)(F.out + dk + 4) = (f32x4){k[4], k[5], k[6], k[7]};
        *(f32x4*)(F.out + dv) = (f32x4){v[0], v[1], v[2], v[3]}; *(f32x4*)(F.out + dv + 4) = (f32x4){v[4], v[5], v[6], v[7]};
    }
}
__device__ __forceinline__ void p5_mixnorm(Frame& F) {
    const int gw = F.vcu * NWAVES + F.wave, NGW = F.G * NWAVES, lane = F.lane;
    const bf16* ATT = (const bf16*)(F.ws + WS_ATT); const bf16* Z = (const bf16*)(F.ws + WS_Z); const bf16* GL = (const bf16*)(F.ws + WS_GL); bf16* CAT = (bf16*)(F.ws + WS_CAT);
    for (int r = gw; r < MR; r += NGW) {
        float a[8], z[8], gt[8], o[8];
        unpack8(*(const v4u*)(ATT + (size_t)r * AW + lane * 8), a); unpack8(*(const v4u*)(Z + (size_t)r * SW + lane * 8), z); unpack8(*(const v4u*)(GL + (size_t)r * SW + lane * 8), gt);
        float sa = 0.f, so = 0.f;
#pragma unroll
        for (int i = 0; i < 8; ++i) { o[i] = z[i] * sigmoidf_(gt[i]); sa += a[i] * a[i]; so += o[i] * o[i]; }
        const float ra = 1.0f / sqrtf(wave_sum(sa) * (1.f / 512.f) + EPS), ro = 1.0f / sqrtf(wave_sum(so) * (1.f / 512.f) + EPS);
#pragma unroll
        for (int i = 0; i < 8; ++i) { a[i] = a[i] * ra * F.in[I_GATT][lane * 8 + i]; o[i] = o[i] * ro * F.in[I_GSSM][lane * 8 + i]; }
        *(v4u*)(CAT + (size_t)r * D + lane * 8) = pack8(a); *(v4u*)(CAT + (size_t)r * D + 512 + lane * 8) = pack8(o);
    }
}
__device__ __forceinline__ void p7_mid(Frame& F) {
    const int gw = F.vcu * NWAVES + F.wave, NGW = F.G * NWAVES, lane = F.lane;
    const bf16* O1 = (const bf16*)(F.ws + WS_O); bf16* XN2 = (bf16*)(F.ws + WS_XN);
    for (int r = gw; r < MR; r += NGW) {
        float o[16], x[16];
        { float t[8]; unpack8(*(const v4u*)(O1 + (size_t)r * D + lane * 8), t);
#pragma unroll
          for (int i = 0; i < 8; ++i) o[i] = t[i];
          unpack8(*(const v4u*)(O1 + (size_t)r * D + 512 + lane * 8), t);
#pragma unroll
          for (int i = 0; i < 8; ++i) o[8 + i] = t[i]; }
        const float* xr = x_row_ptr(F, r);
#pragma unroll
        for (int hf = 0; hf < 2; ++hf) { const f32x4 a = *(const f32x4*)(xr + hf * 512 + lane * 8), b = *(const f32x4*)(xr + hf * 512 + lane * 8 + 4);
            x[hf * 8 + 0] = a.x; x[hf * 8 + 1] = a.y; x[hf * 8 + 2] = a.z; x[hf * 8 + 3] = a.w; x[hf * 8 + 4] = b.x; x[hf * 8 + 5] = b.y; x[hf * 8 + 6] = b.z; x[hf * 8 + 7] = b.w; }
        float ss = 0.f;
#pragma unroll
        for (int i = 0; i < 16; ++i) ss += o[i] * o[i];
        const float r1 = 1.0f / sqrtf(wave_sum(ss) * (1.f / 1024.f) + EPS);
        float s2 = 0.f;
#pragma unroll
        for (int i = 0; i < 16; ++i) { const int col = (i >> 3) * 512 + lane * 8 + (i & 7); x[i] = x[i] + o[i] * r1 * F.in[I_GPOST][col]; s2 += x[i] * x[i]; }
        const float r2 = 1.0f / sqrtf(wave_sum(s2) * (1.f / 1024.f) + EPS);
        float* yo = F.out + (size_t)r * D;
#pragma unroll
        for (int hf = 0; hf < 2; ++hf) {
            { float hb[8];
#pragma unroll
              for (int i = 0; i < 8; ++i) hb[i] = x[hf * 8 + i];
              *(v4u*)((bf16*)yo + hf * 512 + lane * 8) = pack8(hb); }
            float n[8];
#pragma unroll
            for (int i = 0; i < 8; ++i) n[i] = x[hf * 8 + i] * r2 * F.in[I_GMLP][hf * 512 + lane * 8 + i];
            *(v4u*)(XN2 + (size_t)r * D + hf * 512 + lane * 8) = pack8(n);
        }
    }
}
__device__ __forceinline__ void p10_final(Frame& F) {
    const int gw = F.vcu * NWAVES + F.wave, NGW = F.G * NWAVES, lane = F.lane;
    const bf16* O2 = (const bf16*)(F.ws + WS_O);
    for (int r = gw; r < MR; r += NGW) {
        float o[16];
        if (r < MP) { float t[8]; unpack8(*(const v4u*)(O2 + (size_t)r * D + lane * 8), t);
#pragma unroll
          for (int i = 0; i < 8; ++i) o[i] = t[i];
          unpack8(*(const v4u*)(O2 + (size_t)r * D + 512 + lane * 8), t);
#pragma unroll
          for (int i = 0; i < 8; ++i) o[8 + i] = t[i]; }
        else {
#pragma unroll
            for (int i = 0; i < 16; ++i) o[i] = 0.f;
            const float* sl = (const float*)(F.ws + WS_XN) + (size_t)(r - MP) * D + lane * 8;
#pragma unroll 1
            for (int kq = 0; kq < 8; ++kq) {
#pragma unroll
                for (int hf = 0; hf < 2; ++hf) { const f32x4 a = *(const f32x4*)(sl + (size_t)kq * MS * D + hf * 512), b = *(const f32x4*)(sl + (size_t)kq * MS * D + hf * 512 + 4);
                    o[hf * 8 + 0] += a.x; o[hf * 8 + 1] += a.y; o[hf * 8 + 2] += a.z; o[hf * 8 + 3] += a.w; o[hf * 8 + 4] += b.x; o[hf * 8 + 5] += b.y; o[hf * 8 + 6] += b.z; o[hf * 8 + 7] += b.w; } } }
        float ss = 0.f;
#pragma unroll
        for (int i = 0; i < 16; ++i) ss += o[i] * o[i];
        const float r1 = 1.0f / sqrtf(wave_sum(ss) * (1.f / 1024.f) + EPS);
        float* yo = F.out + (size_t)r * D;
        float hp[16];
        { float t[8]; unpack8(*(const v4u*)((const bf16*)yo + lane * 8), t);
#pragma unroll
          for (int i = 0; i < 8; ++i) hp[i] = t[i];
          unpack8(*(const v4u*)((const bf16*)yo + 512 + lane * 8), t);
#pragma unroll
          for (int i = 0; i < 8; ++i) hp[8 + i] = t[i]; }
        asm volatile("s_waitcnt vmcnt(0)" ::: "memory");
#pragma unroll
        for (int hf = 0; hf < 2; ++hf) {
            f32x4 a = (f32x4){hp[hf * 8 + 0], hp[hf * 8 + 1], hp[hf * 8 + 2], hp[hf * 8 + 3]}, b = (f32x4){hp[hf * 8 + 4], hp[hf * 8 + 5], hp[hf * 8 + 6], hp[hf * 8 + 7]};
            const float* g = F.in[I_GMLPP] + hf * 512 + lane * 8;
            a.x += o[hf * 8 + 0] * r1 * g[0]; a.y += o[hf * 8 + 1] * r1 * g[1]; a.z += o[hf * 8 + 2] * r1 * g[2]; a.w += o[hf * 8 + 3] * r1 * g[3];
            b.x += o[hf * 8 + 4] * r1 * g[4]; b.y += o[hf * 8 + 5] * r1 * g[5]; b.z += o[hf * 8 + 6] * r1 * g[6]; b.w += o[hf * 8 + 7] * r1 * g[7];
            *(f32x4*)(yo + hf * 512 + lane * 8) = a; *(f32x4*)(yo + hf * 512 + lane * 8 + 4) = b;
        }
    }
}

typedef short bf16x8 __attribute__((ext_vector_type(8)));
constexpr int KC_PER_G = 33 * 256;
struct ZohD { double adt_r, adt_i, cr, ci; };
__device__ __forceinline__ ZohD zoh_d(const Frame& F, int gp) {
    const int g = gp >> 6;
    const double dt = exp_d((double)F.in[I_LDT][g]); const double ar = (double)F.in[I_ARE][gp], ai = (double)F.in[I_AIM][gp];
    ZohD z; z.adt_r = ar * dt; z.adt_i = ai * dt;
    const double mag = exp_d(z.adt_r); double s, c; sincos_d(z.adt_i, s, c);
    const double nr = mag * c - 1.0, ni = mag * s, den = ar * ar + ai * ai;
    z.cr = (nr * ar + ni * ai) / den; z.ci = (ni * ar - nr * ai) / den; return z;
}
__device__ __forceinline__ void abar_pow(const ZohD& z, int m, double& wr, double& wi) { const double mag = exp_d(z.adt_r * (double)m); double s, c; sincos_d(z.adt_i * (double)m, s, c); wr = mag * c; wi = mag * s; }

__device__ __forceinline__ void p0_ssm_pow(Frame& F) {
    const int gt = F.vcu * (NWAVES * 64) + F.tid, NT = F.G * NWAVES * 64;
    float* POW = (float*)(F.ws + WS_POW); float* COEF = (float*)(F.ws + WS_COEF); float* A32 = (float*)(F.ws + WS_A32);
    for (int it = gt; it < 2048 * 33; it += NT) { const int gp = it / 33, tau = it - gp * 33;
        const ZohD z = zoh_d(F, gp); double wr, wi; abar_pow(z, tau, wr, wi);
        POW[2 * it] = (float)wr; POW[2 * it + 1] = (float)wi;
        if (tau == 32) { A32[2 * gp] = (float)wr; A32[2 * gp + 1] = (float)wi; }
        if (tau == 0) { COEF[2 * gp] = (float)z.cr; COEF[2 * gp + 1] = (float)z.ci; } }
}
__device__ __forceinline__ void p1_vt(Frame& F, int bi, int nb) {
    const int gt = bi * (NWAVES * 64) + F.tid, NT = nb * NWAVES * 64;
    bf16* VT = (bf16*)(F.ws + WS_VT); bf16* QT = (bf16*)(F.ws + WS_QT); bf16* KC = (bf16*)(F.ws + WS_KC);
    const float* POW = (const float*)(F.ws + WS_POW); const float* COEF = (const float*)(F.ws + WS_COEF);
    for (int it = gt; it < 65536; it += NT) {
        const int gp = it >> 5, s = it & 31, g = gp >> 6, p = gp & 63;
        const float wr = POW[2 * (gp * 33 + 31 - s)], wi = POW[2 * (gp * 33 + 31 - s) + 1], cr = COEF[2 * gp], ci = COEF[2 * gp + 1];
        const float er = wr * cr - wi * ci, ei = wr * ci + wi * cr;
        float re[16], im[16];
#pragma unroll
        for (int h = 0; h < 16; ++h) { const float br = F.in[I_BRE][gp * 16 + h], bi_ = F.in[I_BIM][gp * 16 + h]; re[h] = er * br - ei * bi_; im[h] = er * bi_ + ei * br; }
        bf16* d0 = VT + (size_t)g * 65536 + (size_t)(2 * p) * 512 + 16 * s; bf16* d1 = d0 + 512;
        v4u w;
        w.x = pk2(re[0], re[1]); w.y = pk2(re[2], re[3]); w.z = pk2(re[4], re[5]); w.w = pk2(re[6], re[7]); ((v4u*)d0)[0] = w;
        w.x = pk2(re[8], re[9]); w.y = pk2(re[10], re[11]); w.z = pk2(re[12], re[13]); w.w = pk2(re[14], re[15]); ((v4u*)d0)[1] = w;
        w.x = pk2(im[0], im[1]); w.y = pk2(im[2], im[3]); w.z = pk2(im[4], im[5]); w.w = pk2(im[6], im[7]); ((v4u*)d1)[0] = w;
        w.x = pk2(im[8], im[9]); w.y = pk2(im[10], im[11]); w.z = pk2(im[12], im[13]); w.w = pk2(im[14], im[15]); ((v4u*)d1)[1] = w;
    }
}
__device__ __forceinline__ void p4_qt_kc(Frame& F, int bi, int nb) {
    const int gt = bi * (NWAVES * 64) + F.tid, NT = nb * NWAVES * 64;
    bf16* QT = (bf16*)(F.ws + WS_QT); bf16* KC = (bf16*)(F.ws + WS_KC);
    const float* POW = (const float*)(F.ws + WS_POW); const float* COEF = (const float*)(F.ws + WS_COEF);
    for (int it = gt; it < 65536; it += NT) {
        const int p = it & 63, t = (it >> 6) & 31, g = it >> 11, gp = g * 64 + p;
        const float wr = POW[2 * (gp * 33 + t + 1)], wi = POW[2 * (gp * 33 + t + 1) + 1];
        unsigned* d = (unsigned*)(QT + (size_t)g * 65536 + (size_t)(16 * t) * 128 + 2 * p);
#pragma unroll
        for (int ho = 0; ho < 16; ++ho) { const float cr = F.in[I_CRE][(g * 16 + ho) * 64 + p], ci = F.in[I_CIM][(g * 16 + ho) * 64 + p];
            d[ho * 64] = pk2(cr * wr - ci * wi, -(cr * wi + ci * wr)); }
    }
    LAS float* Cr = (LAS float*)F.lds; LAS float* Ci = Cr + 16 * 65; LAS float* Br = Ci + 16 * 65; LAS float* Bi = Br + 1024; LAS float* Er = Bi + 1024; LAS float* Ei = Er + 256;
    for (int task = bi; task < 256; task += nb) {
        const int g = task >> 3, tau0 = 4 * (task & 7);
        __syncthreads();
        for (int e = F.tid; e < 1024; e += NWAVES * 64) { const int ho = e >> 6, p = e & 63; Cr[ho * 65 + p] = F.in[I_CRE][g * 1024 + e]; Ci[ho * 65 + p] = F.in[I_CIM][g * 1024 + e];
            Br[e] = F.in[I_BRE][g * 1024 + e]; Bi[e] = F.in[I_BIM][g * 1024 + e]; }
        if (F.tid < 256) { const int tl = F.tid >> 6, p = F.tid & 63, gp = g * 64 + p; const float wr = POW[2 * (gp * 33 + tau0 + tl)], wi = POW[2 * (gp * 33 + tau0 + tl) + 1], cr = COEF[2 * gp], ci = COEF[2 * gp + 1];
            Er[F.tid] = wr * cr - wi * ci; Ei[F.tid] = wr * ci + wi * cr; }
        __syncthreads();
#pragma unroll 1
        for (int o = F.tid; o < 1024; o += NWAVES * 64) { const int tl = o >> 8, ho = (o >> 4) & 15, hi = o & 15; float acc = 0.f;
#pragma unroll 8
            for (int p = 0; p < 64; ++p) { const float cr = Cr[ho * 65 + p], ci = Ci[ho * 65 + p], br = Br[p * 16 + hi], bi_ = Bi[p * 16 + hi], er = Er[tl * 64 + p], ei = Ei[tl * 64 + p];
                acc += cr * (er * br - ei * bi_) - ci * (er * bi_ + ei * br); }
            if (tau0 + tl == 0 && ho == hi) acc += F.in[I_DD][g * 16 + ho];
            KC[(size_t)g * KC_PER_G + (tau0 + tl + 1) * 256 + (o & 255)] = (bf16)f2bf(acc); }
        if (tau0 == 0 && F.tid < 256) KC[(size_t)g * KC_PER_G + F.tid] = (bf16)0;
    }
    __syncthreads();
}
__device__ __forceinline__ void stage_rows(LAS unsigned char* dst, const unsigned char* src, int nrows, int cshift, int dst_stride, int tid) {
    const int total = nrows << cshift;
#pragma unroll 1
    for (int c0 = tid; c0 < total; c0 += 8 * NWAVES * 64) {
        v4u v[8];
#pragma unroll
        for (int u = 0; u < 8; ++u) { const int c = c0 + u * NWAVES * 64; if (c < total) v[u] = *(const v4u*)(src + ((size_t)c << 4)); }
#pragma unroll
        for (int u = 0; u < 8; ++u) { const int c = c0 + u * NWAVES * 64; if (c < total) { const int row = c >> cshift, col = c & ((1 << cshift) - 1); *(LAS v4u*)(dst + row * dst_stride + col * 16) = v[u]; } }
    }
}
#define MFMA16(a, b, c) __builtin_amdgcn_mfma_f32_16x16x32_bf16((a), (b), (c), 0, 0, 0)
constexpr int VT_STRIDE = 1040, QT_STRIDE = 272, LDS_KC_OFF = 512 * QT_STRIDE;
static_assert(LDS_KC_OFF + KC_PER_G * 2 <= LDSCTL_OFF && 128 * VT_STRIDE <= LDSCTL_OFF, "SSM LDS images");
__device__ __forceinline__ void s1_hloc(Frame& F) {
    const bf16* P = (const bf16*)(F.ws + WS_P); const bf16* VT = (const bf16*)(F.ws + WS_VT); float* HL = (float*)(F.ws + WS_HL);
    const int lane = F.lane;
    for (int bt = F.vcu; bt < 256; bt += F.G) {
        const int g = bt >> 3, sub = bt & 7;
        __syncthreads();
        stage_rows(F.lds, (const unsigned char*)(VT + (size_t)g * 65536), 128, 6, VT_STRIDE, F.tid);
        __syncthreads();
        const int ntile = 4 * sub + (F.wave >> 1), half = F.wave & 1;
        const int n = ntile * 16 + (lane & 15), b = n >> 7, c = n & 127, row0 = b * 4096 + 32 * c;
        const bf16* up = P + (size_t)(row0 + (lane >> 5)) * DIN + 768 + g * 16 + 8 * ((lane >> 4) & 1);
        bf16x8 U[16];
#pragma unroll
        for (int ks = 0; ks < 16; ++ks) U[ks] = *(const bf16x8*)(up + (size_t)(2 * ks) * DIN);
#pragma unroll
        for (int mi = 0; mi < 4; ++mi) {
            const int mf = 4 * half + mi;
            const LAS unsigned char* ap = F.lds + (16 * mf + (lane & 15)) * VT_STRIDE + 16 * (lane >> 4);
            f32x4 acc = (f32x4){0.f, 0.f, 0.f, 0.f};
#pragma unroll
            for (int ks = 0; ks < 16; ++ks) acc = MFMA16(*(const LAS bf16x8*)(ap + 64 * ks), U[ks], acc);
            *(f32x4*)(HL + ((size_t)n * 32 + g) * 128 + 16 * mf + 4 * (lane >> 4)) = acc;
        }
    }
}
__device__ __forceinline__ void s1_small_seqs(Frame& F) {
    LAS float* hs = (LAS float*)(F.lds + 133120 + F.wave * 512);
    const int gw = F.vcu * NWAVES + F.wave, NGW = F.G * NWAVES, lane = F.lane;
    const bf16* P = (const bf16*)(F.ws + WS_P); bf16* Z = (bf16*)(F.ws + WS_Z); float* HM = (float*)(F.ws + WS_HM);
    const float* abr = (const float*)(F.ws + WS_ABR); const float* abi = (const float*)(F.ws + WS_ABI); const float* bbr = (const float*)(F.ws + WS_BBR); const float* bbi = (const float*)(F.ws + WS_BBI);
#pragma unroll 1
    for (int task = gw; task < 32 + 128 * 32; task += NGW) {
        const bool meta = task < 32; const int g = meta ? task : ((task - 32) & 31), db = meta ? 0 : ((task - 32) >> 5), gp = g * 64 + lane;
        const float are = abr[gp], aim = abi[gp];
        float br[16], bi[16];
#pragma unroll
        for (int h = 0; h < 16; ++h) { br[h] = bbr[gp * 16 + h]; bi[h] = bbi[gp * 16 + h]; }
        const int ho = lane & 15, qq = lane >> 4;
        float cr[16], ci[16];
#pragma unroll
        for (int j = 0; j < 16; ++j) { cr[j] = F.in[I_CRE][(g * 16 + ho) * 64 + qq * 16 + j]; ci[j] = F.in[I_CIM][(g * 16 + ho) * 64 + qq * 16 + j]; }
        const float dd = F.in[I_DD][g * 16 + ho];
        float hr = 0.f, hi = 0.f;
        if (!meta) { hr = F.in[I_SRE][(db * 32 + g) * 64 + lane]; hi = F.in[I_SIM][(db * 32 + g) * 64 + lane]; }
        const int nbatch = meta ? 4 : 1;
#pragma unroll 1
        for (int sb = 0; sb < nbatch; ++sb) {
            const int rowb = meta ? MR + 4 * sb : MP + db * 4;
            v4u uu[4][2];
#pragma unroll
            for (int st = 0; st < 4; ++st) { const v4u* up = (const v4u*)(P + (size_t)(rowb + st) * DIN + 768 + g * 16); uu[st][0] = up[0]; uu[st][1] = up[1]; }
#pragma unroll
            for (int st = 0; st < 4; ++st) {
                const int row = rowb + st;
                const v4u u0 = uu[st][0], u1 = uu[st][1];
                float u[16];
                u[0] = bflo(u0.x); u[1] = bfhi(u0.x); u[2] = bflo(u0.y); u[3] = bfhi(u0.y); u[4] = bflo(u0.z); u[5] = bfhi(u0.z); u[6] = bflo(u0.w); u[7] = bfhi(u0.w);
                u[8] = bflo(u1.x); u[9] = bfhi(u1.x); u[10] = bflo(u1.y); u[11] = bfhi(u1.y); u[12] = bflo(u1.z); u[13] = bfhi(u1.z); u[14] = bflo(u1.w); u[15] = bfhi(u1.w);
                float bur = 0.f, bui = 0.f;
#pragma unroll
                for (int h = 0; h < 16; ++h) { bur += br[h] * u[h]; bui += bi[h] * u[h]; }
                const float nhr = are * hr - aim * hi + bur, nhi = are * hi + aim * hr + bui;
                hr = nhr; hi = nhi;
                if (!meta) {
                    hs[lane] = hr; hs[64 + lane] = hi;
                    LDS_WAIT(); asm volatile("" ::: "memory");
                    float y = 0.f;
#pragma unroll
                    for (int j = 0; j < 16; ++j) y += cr[j] * hs[qq * 16 + j] - ci[j] * hs[64 + qq * 16 + j];
                    y += __shfl_xor(y, 16); y += __shfl_xor(y, 32);
                    float uo = u[0];
#pragma unroll
                    for (int h = 1; h < 16; ++h) uo = (ho == h) ? u[h] : uo;
                    y += dd * uo;
                    const float z = gelu_tanh(y);
                    if (lane < 16) Z[(size_t)row * SW + g * 16 + ho] = (bf16)f2bf(z);
                    LDS_WAIT(); asm volatile("" ::: "memory");
                }
            }
        }
        if (meta) { HM[g * 128 + 2 * lane] = hr; HM[g * 128 + 2 * lane + 1] = hi; }
        else { F.out[O_SRS + (db * 32 + g) * 64 + lane] = hr; F.out[O_SIS + (db * 32 + g) * 64 + lane] = hi; }
    }
}
__device__ __forceinline__ void s2_scan(Frame& F) {
    const int gt = F.vcu * (NWAVES * 64) + F.tid;
    if (gt < 8192) {
        const int b = gt >> 11, gp = gt & 2047, g = gp >> 6, p = gp & 63;
        const float* A32 = (const float*)(F.ws + WS_A32); const float* HM = (const float*)(F.ws + WS_HM);
        const float ar = A32[2 * gp], ai = A32[2 * gp + 1];
        float hr = HM[g * 128 + 2 * p], hi = HM[g * 128 + 2 * p + 1];
        const float* hl = (const float*)(F.ws + WS_HL) + ((size_t)(b * 128) * 32 + g) * 128 + 2 * p;
        unsigned* hin = (unsigned*)((bf16*)(F.ws + WS_HIN) + ((size_t)(b * 128) * 32 + g) * 128 + 2 * p);
#pragma unroll 1
        for (int c0 = 0; c0 < 128; c0 += 16) {
            float vr[16], vi[16];
#pragma unroll
            for (int j = 0; j < 16; ++j) { const float* q = hl + (size_t)(c0 + j) * 4096; vr[j] = q[0]; vi[j] = q[1]; }
#pragma unroll
            for (int j = 0; j < 16; ++j) { hin[(size_t)(c0 + j) * 2048] = pk2(hr, hi);
                const float nr = ar * hr - ai * hi + vr[j], ni = ar * hi + ai * hr + vi[j]; hr = nr; hi = ni; }
        }
        F.out[O_SRP + (b * 32 + g) * 64 + p] = hr; F.out[O_SIP + (b * 32 + g) * 64 + p] = hi;
    }
}
__device__ __forceinline__ void s3_y(Frame& F) {
    const bf16* P = (const bf16*)(F.ws + WS_P); const bf16* QT = (const bf16*)(F.ws + WS_QT); const bf16* KC = (const bf16*)(F.ws + WS_KC); const bf16* HIN = (const bf16*)(F.ws + WS_HIN); bf16* Z = (bf16*)(F.ws + WS_Z);
    const int lane = F.lane;
    for (int bt = F.vcu; bt < 256; bt += F.G) {
        const int g = bt >> 3, sub = bt & 7;
        __syncthreads();
        stage_rows(F.lds, (const unsigned char*)(QT + (size_t)g * 65536), 512, 4, QT_STRIDE, F.tid);
        stage_rows(F.lds + LDS_KC_OFF, (const unsigned char*)(KC + (size_t)g * KC_PER_G), 33, 5, 512, F.tid);
        __syncthreads();
        const int ntile = 4 * sub + (F.wave >> 1), half = F.wave & 1;
        const int n = ntile * 16 + (lane & 15), b = n >> 7, c = n & 127, row0 = b * 4096 + 32 * c;
        const bf16* up = P + (size_t)(row0 + (lane >> 5)) * DIN + 768 + g * 16 + 8 * ((lane >> 4) & 1);
        bf16x8 U[16], H[4];
#pragma unroll
        for (int ks = 0; ks < 16; ++ks) U[ks] = *(const bf16x8*)(up + (size_t)(2 * ks) * DIN);
        const bf16* hp = HIN + ((size_t)n * 32 + g) * 128 + 8 * (lane >> 4);
#pragma unroll
        for (int kk = 0; kk < 4; ++kk) H[kk] = *(const bf16x8*)(hp + 32 * kk);
        const LAS unsigned char* qp = F.lds + (16 * half + (lane & 15)) * QT_STRIDE + 16 * (lane >> 4);
        const LAS unsigned char* kp = F.lds + LDS_KC_OFF + (half - (lane >> 5) + 1) * 512 + (lane & 15) * 32 + 16 * ((lane >> 4) & 1);
        bf16* zp = Z + (size_t)(row0 + half) * SW + g * 16 + 4 * (lane >> 4);
#pragma unroll
        for (int i = 0; i < 16; ++i) {
            f32x4 acc = (f32x4){0.f, 0.f, 0.f, 0.f};
#pragma unroll
            for (int kk = 0; kk < 4; ++kk) acc = MFMA16(*(const LAS bf16x8*)(qp + i * 32 * QT_STRIDE + kk * 64), H[kk], acc);
#pragma unroll
            for (int ks = 0; ks < 16; ++ks) if (ks <= i) acc = MFMA16(*(const LAS bf16x8*)(kp + (2 * i - 2 * ks) * 512), U[ks], acc);
            v2u w; w.x = pk2(gelu_tanh(acc[0]), gelu_tanh(acc[1])); w.y = pk2(gelu_tanh(acc[2]), gelu_tanh(acc[3]));
            *(v2u*)(zp + (size_t)(2 * i) * SW) = w;
        }
    }
}
typedef float f32x16 __attribute__((ext_vector_type(16)));
#define MFMA32(a, b, c) __builtin_amdgcn_mfma_f32_32x32x16_bf16((a), (b), (c), 0, 0, 0)
__device__ __forceinline__ int crow(int r, int hl) { return (r & 3) + 8 * (r >> 2) + 4 * hl; }
constexpr float LOG2E = 1.4426950408889634f, QK_C2 = 0.125f * 1.4426950408889634f;
constexpr int AK_STRIDE = 144;
template <class MaskF>
__device__ __forceinline__ void attn_qblock(const LAS unsigned char* Kl, const LAS unsigned char* Vl, int vstride, const bf16x8 (&qf)[4], int kb0, float sink2, const MaskF& valid, LAS float* wsf, f32x16 (&O)[2], int lane) {
    const int i = lane & 31, hl = lane >> 5;
    f32x16 S[5];
#pragma unroll
    for (int kbi = 0; kbi < 5; ++kbi) {
        const LAS unsigned char* kp = Kl + (32 * (kb0 + kbi) + i) * AK_STRIDE + 16 * hl;
        f32x16 acc = (f32x16){0.f, 0.f, 0.f, 0.f, 0.f, 0.f, 0.f, 0.f, 0.f, 0.f, 0.f, 0.f, 0.f, 0.f, 0.f, 0.f};
#pragma unroll
        for (int kd = 0; kd < 4; ++kd) acc = MFMA32(*(const LAS bf16x8*)(kp + 32 * kd), qf[kd], acc);
        S[kbi] = acc;
    }
    float m = -1e30f;
#pragma unroll
    for (int kbi = 0; kbi < 5; ++kbi)
#pragma unroll
        for (int r = 0; r < 16; ++r) { const int kk = 32 * (kb0 + kbi) + crow(r, hl); const float t = valid(kk, i) ? S[kbi][r] * QK_C2 : -1e30f; S[kbi][r] = t; m = fmaxf(m, t); }
    m = fmaxf(m, __shfl_xor(m, 32)); m = fmaxf(m, sink2);
    float sum = 0.f;
#pragma unroll
    for (int kbi = 0; kbi < 5; ++kbi)
#pragma unroll
        for (int r = 0; r < 16; ++r) { const float p = __builtin_amdgcn_exp2f(S[kbi][r] - m); S[kbi][r] = p; sum += p; }
    sum += __shfl_xor(sum, 32); sum += __builtin_amdgcn_exp2f(sink2 - m);
    wsf[i] = 1.0f / sum;
    O[0] = (f32x16){0.f, 0.f, 0.f, 0.f, 0.f, 0.f, 0.f, 0.f, 0.f, 0.f, 0.f, 0.f, 0.f, 0.f, 0.f, 0.f}; O[1] = O[0];
#pragma unroll
    for (int kbi = 0; kbi < 5; ++kbi)
#pragma unroll
        for (int s = 0; s < 2; ++s) {
            v4u pw; pw.x = pg8::cvt_pk_bf16(S[kbi][8 * s + 0], S[kbi][8 * s + 1]); pw.y = pg8::cvt_pk_bf16(S[kbi][8 * s + 2], S[kbi][8 * s + 3]); pw.z = pg8::cvt_pk_bf16(S[kbi][8 * s + 4], S[kbi][8 * s + 5]); pw.w = pg8::cvt_pk_bf16(S[kbi][8 * s + 6], S[kbi][8 * s + 7]);
            const bf16x8 pf = __builtin_bit_cast(bf16x8, pw);
#pragma unroll
            for (int dt = 0; dt < 2; ++dt) {
                const LAS unsigned char* vp = Vl + (32 * dt + i) * vstride + (32 * (kb0 + kbi) + 16 * s + 4 * hl) * 2;
                const v2u lo = *(const LAS v2u*)vp, hi = *(const LAS v2u*)(vp + 16);
                v4u vw; vw.x = lo.x; vw.y = lo.y; vw.z = hi.x; vw.w = hi.y;
                O[dt] = MFMA32(pf, __builtin_bit_cast(bf16x8, vw), O[dt]);
            }
        }
    LDS_WAIT(); asm volatile("" ::: "memory");
}
__device__ __forceinline__ v4u rope8(const v4u v, const v4u pv, int which, const float* c8, const float* s8) {
    float a[8], b[8], o[8]; unpack8(v, a); unpack8(pv, b);
    const f32x4 c0 = *(const f32x4*)c8, c1 = *(const f32x4*)(c8 + 4), s0 = *(const f32x4*)s8, s1 = *(const f32x4*)(s8 + 4);
    const float cc[8] = {c0.x, c0.y, c0.z, c0.w, c1.x, c1.y, c1.z, c1.w}, ss[8] = {s0.x, s0.y, s0.z, s0.w, s1.x, s1.y, s1.z, s1.w};
#pragma unroll
    for (int e = 0; e < 8; ++e) o[e] = which ? (a[e] * cc[e] + b[e] * ss[e]) : (a[e] * cc[e] - b[e] * ss[e]);
    return pack8(o);
}
__device__ __forceinline__ v4u shfl_xor4(const v4u v, int m) { v4u r; r.x = __shfl_xor(v.x, m); r.y = __shfl_xor(v.y, m); r.z = __shfl_xor(v.z, m); r.w = __shfl_xor(v.w, m); return r; }
__device__ __forceinline__ bf16x8 rope_q(const bf16x8 q0, int hl, int pidx, const float* ropeC, const float* ropeS) {
    const v4u v = __builtin_bit_cast(v4u, q0); const v4u pv = shfl_xor4(v, 32);
    return __builtin_bit_cast(bf16x8, rope8(v, pv, hl, ropeC + pidx * 8, ropeS + pidx * 8));
}
constexpr int AP_KEYS = 192, AP_VSTRIDE = 392, AP_LDS_V = 2 * AP_KEYS * AK_STRIDE, AP_LDS_W = AP_LDS_V + 2 * 64 * AP_VSTRIDE, AP_LDS_T = AP_LDS_W + 8 * 128, AT_STRIDE = 144;
static_assert(AP_LDS_T + 8 * 32 * AT_STRIDE <= LDSCTL_OFF, "attention LDS");
template <class RowF>
__device__ __forceinline__ void attn_store(const f32x16 (&O)[2], const LAS float* wsf, LAS unsigned char* tile, bf16* CAT, float* SS, const RowF& rowf, int nrows, int lane) {
    const int i = lane & 31, hl = lane >> 5;
#pragma unroll
    for (int r = 0; r < 16; ++r) { const int q = crow(r, hl); const float inv = wsf[q];
        *(LAS bf16*)(tile + q * AT_STRIDE + i * 2) = (bf16)f2bf(O[0][r] * inv); *(LAS bf16*)(tile + q * AT_STRIDE + 64 + i * 2) = (bf16)f2bf(O[1][r] * inv); }
    LDS_WAIT(); asm volatile("" ::: "memory");
    const int q = lane >> 1, hf = lane & 1;
    v4u w[4]; float ss = 0.f;
#pragma unroll
    for (int jj = 0; jj < 4; ++jj) { w[jj] = *(const LAS v4u*)(tile + q * AT_STRIDE + hf * 64 + jj * 16); float f[8]; unpack8(w[jj], f);
#pragma unroll
        for (int e = 0; e < 8; ++e) ss += f[e] * f[e]; }
    ss += __shfl_xor(ss, 1);
    if (q < nrows) { int row, h; rowf(q, row, h);
        bf16* op = CAT + (size_t)row * D + h * 64 + hf * 32;
#pragma unroll
        for (int jj = 0; jj < 4; ++jj) *(v4u*)(op + jj * 8) = w[jj];
        if (hf == 0) SS[(size_t)row * 32 + 16 + h] = ss; }
    LDS_WAIT(); asm volatile("" ::: "memory");
}
struct MaskPrompt { int lo0, hi0, kvmin; __device__ __forceinline__ bool operator()(int kk, int i) const { return kk >= lo0 + i && kk <= hi0 + i && kk >= kvmin; } };
__device__ __forceinline__ float half_sum(float v) { v += __shfl_xor(v, 1); v += __shfl_xor(v, 2); v += __shfl_xor(v, 4); v += __shfl_xor(v, 8); v += __shfl_xor(v, 16); return v; }
__device__ __forceinline__ void attn_prompt(Frame& F) {
    const bf16* P = (const bf16*)(F.ws + WS_P); bf16* CAT = (bf16*)(F.ws + WS_CAT);
    const float* ropeC = (const float*)(F.ws + WS_ROPEC); const float* ropeS = (const float*)(F.ws + WS_ROPES);
    const int lane = F.lane, i = lane & 31, hl = lane >> 5;
    LAS float* wsf = (LAS float*)(F.lds + AP_LDS_W + F.wave * 128);
    float* SS = (float*)(F.ws + WS_SS);
    for (int u = F.vcu; u < 256; u += F.G) {
        const int b = u >> 6, j = u & 63, s0 = 64 * j - 128;
        __syncthreads();
        { v4u vv[12];
          const int cc = F.tid & 31;
#pragma unroll
          for (int uu = 0; uu < 12; ++uu) { const int key = (F.tid >> 5) + 16 * uu, sk = s0 + key;
              const int row = sk >= 0 ? b * 4096 + sk : (sk >= -16 ? MR + 16 + sk : MR);
              vv[uu] = *(const v4u*)(P + (size_t)row * DIN + 512 + cc * 8); }
          if (cc < 16 && (cc & 7) < 2) {
#pragma unroll
              for (int uu = 0; uu < 12; ++uu) { const int key = (F.tid >> 5) + 16 * uu, sk = s0 + key, pidx = sk >= -16 ? sk + 16 : 0;
                  const v4u pv = shfl_xor4(vv[uu], 1); vv[uu] = rope8(vv[uu], pv, cc & 1, ropeC + pidx * 8, ropeS + pidx * 8); } }
#pragma unroll
          for (int uu = 0; uu < 12; ++uu) { const int key = (F.tid >> 5) + 16 * uu; const v4u v = vv[uu];
            if (cc < 16) { *(LAS v4u*)(F.lds + ((cc >> 3) * AP_KEYS + key) * AK_STRIDE + (cc & 7) * 16) = v; }
            else { const int c2 = cc - 16; LAS bf16* vt = (LAS bf16*)(F.lds + AP_LDS_V + ((c2 >> 3) * 64 + (c2 & 7) * 8) * AP_VSTRIDE + key * 2);
                vt[0 * (AP_VSTRIDE / 2)] = (bf16)(v.x & 0xffffu); vt[1 * (AP_VSTRIDE / 2)] = (bf16)(v.x >> 16); vt[2 * (AP_VSTRIDE / 2)] = (bf16)(v.y & 0xffffu); vt[3 * (AP_VSTRIDE / 2)] = (bf16)(v.y >> 16);
                vt[4 * (AP_VSTRIDE / 2)] = (bf16)(v.z & 0xffffu); vt[5 * (AP_VSTRIDE / 2)] = (bf16)(v.z >> 16); vt[6 * (AP_VSTRIDE / 2)] = (bf16)(v.w & 0xffffu); vt[7 * (AP_VSTRIDE / 2)] = (bf16)(v.w >> 16); } } }
        __syncthreads();
        const int h = F.wave, kvh = h >> 2;
        const float sink2 = F.in[I_SINK][h] * LOG2E;
        const LAS unsigned char* Kl = F.lds + kvh * AP_KEYS * AK_STRIDE; const LAS unsigned char* Vl = F.lds + AP_LDS_V + kvh * 64 * AP_VSTRIDE;
#pragma unroll 1
        for (int qh = 0; qh < 2; ++qh) {
            const int qs0 = 64 * j + 32 * qh, qrow0 = b * 4096 + qs0;
            const bf16* qp = P + (size_t)(qrow0 + i) * DIN + h * 64 + 8 * hl;
            bf16x8 qf[4];
#pragma unroll
            for (int kd = 0; kd < 4; ++kd) qf[kd] = *(const bf16x8*)(qp + 16 * kd);
            qf[0] = rope_q(qf[0], hl, qs0 + i + 16, ropeC, ropeS);
            const MaskPrompt mk{32 * qh + 1, 128 + 32 * qh, 112 - 64 * j};
            f32x16 O[2];
            attn_qblock(Kl, Vl, AP_VSTRIDE, qf, qh, sink2, mk, wsf, O, lane);
            struct RowP { int qrow0, h; __device__ __forceinline__ void operator()(int q, int& row, int& hh) const { row = qrow0 + q; hh = h; } };
            attn_store(O, wsf, F.lds + AP_LDS_T + F.wave * 32 * AT_STRIDE, CAT, SS, RowP{qrow0, h}, 32, lane);
        }
    }
    __syncthreads();
}
constexpr int AS_KEYS = 160, AS_VSTRIDE = 328, AS_LDS_V = 2 * AS_KEYS * AK_STRIDE, AS_LDS_W = AS_LDS_V + 2 * 64 * AS_VSTRIDE, AS_LDS_T = AS_LDS_W + 8 * 128;
struct MaskSample { __device__ __forceinline__ bool operator()(int kk, int i) const { const int t = i & 3; return kk < 128 ? kk >= t + 1 : (kk < 132 && kk - 128 <= t); } };
__device__ __forceinline__ void attn_sample(Frame& F) {
    const bf16* P = (const bf16*)(F.ws + WS_P); bf16* CAT = (bf16*)(F.ws + WS_CAT);
    const float* ropeC = (const float*)(F.ws + WS_ROPEC); const float* ropeS = (const float*)(F.ws + WS_ROPES);
    const int lane = F.lane, i = lane & 31, hl = lane >> 5;
    LAS float* wsf = (LAS float*)(F.lds + AS_LDS_W + F.wave * 128);
    float* SS = (float*)(F.ws + WS_SS);
    for (int db = F.vcu; db < 128; db += F.G) {
        __syncthreads();
        for (int c = F.tid; c < AS_KEYS * 32; c += NWAVES * 64) {
            const int key = c >> 5, cc = c & 31, c2 = cc & 15, kvh = c2 >> 3, d0 = (c2 & 7) * 8;
            v4u w;
            if (key < 128) { const float* src = (cc < 16 ? F.in[I_CK] : F.in[I_CV]) + ((size_t)(db * 128 + key) * 2 + kvh) * 64 + d0;
                const f32x4 a = *(const f32x4*)src, bq = *(const f32x4*)(src + 4); const float f[8] = {a.x, a.y, a.z, a.w, bq.x, bq.y, bq.z, bq.w}; w = pack8(f); }
            else if (key < 132) {
                w = *(const v4u*)(P + (size_t)(MP + db * 4 + key - 128) * DIN + (cc < 16 ? 512 : 640) + kvh * 64 + d0);
                const v4u pv = shfl_xor4(w, 1);
                if (cc < 16 && (cc & 7) < 2) { const int pidx = 4112 + key - 128; w = rope8(w, pv, cc & 1, ropeC + pidx * 8, ropeS + pidx * 8); } }
            else { w = (v4u){0u, 0u, 0u, 0u}; }
            if (cc < 16) { *(LAS v4u*)(F.lds + (kvh * AS_KEYS + key) * AK_STRIDE + d0 * 2) = w; }
            else { LAS bf16* vt = (LAS bf16*)(F.lds + AS_LDS_V + (kvh * 64 + d0) * AS_VSTRIDE + key * 2);
                vt[0 * (AS_VSTRIDE / 2)] = (bf16)(w.x & 0xffffu); vt[1 * (AS_VSTRIDE / 2)] = (bf16)(w.x >> 16); vt[2 * (AS_VSTRIDE / 2)] = (bf16)(w.y & 0xffffu); vt[3 * (AS_VSTRIDE / 2)] = (bf16)(w.y >> 16);
                vt[4 * (AS_VSTRIDE / 2)] = (bf16)(w.z & 0xffffu); vt[5 * (AS_VSTRIDE / 2)] = (bf16)(w.z >> 16); vt[6 * (AS_VSTRIDE / 2)] = (bf16)(w.w & 0xffffu); vt[7 * (AS_VSTRIDE / 2)] = (bf16)(w.w >> 16); }
        }
        __syncthreads();
        if (F.wave < 2) {
            const int kvh = F.wave, t = i & 3, gq = (i >> 2) & 3, h = kvh * 4 + gq;
            const float sink2 = F.in[I_SINK][h] * LOG2E;
            const bf16* qp = P + (size_t)(MP + db * 4 + t) * DIN + h * 64 + 8 * hl;
            bf16x8 qf[4];
#pragma unroll
            for (int kd = 0; kd < 4; ++kd) qf[kd] = *(const bf16x8*)(qp + 16 * kd);
            qf[0] = rope_q(qf[0], hl, 4112 + t, ropeC, ropeS);
            const MaskSample mk{};
            f32x16 O[2];
            attn_qblock(F.lds + kvh * AS_KEYS * AK_STRIDE, F.lds + AS_LDS_V + kvh * 64 * AS_VSTRIDE, AS_VSTRIDE, qf, 0, sink2, mk, wsf, O, lane);
            struct RowS { int r0, h0; __device__ __forceinline__ void operator()(int q, int& row, int& hh) const { row = r0 + (q & 3); hh = h0 + (q >> 2); } };
            attn_store(O, wsf, F.lds + AS_LDS_T + F.wave * 32 * AT_STRIDE, CAT, SS, RowS{MP + db * 4, kvh * 4}, 16, lane);
        }
    }
    __syncthreads();
}
constexpr int SG_STAGE = 40960, SG_B_OFF = 8192;
__device__ __forceinline__ void small_unit_acc(Frame& F, const bf16* A, int lda, const bf16* Bt, int ldb, int m0, int n0, int k0, int klen, f32x4 (&acc)[4][2]) {
    const int lane = F.lane, w = F.wave;
    const int srow = 8 * w + (lane >> 3), sch = (lane & 7) ^ ((lane >> 3) & 7);
    const bf16* ag = A + (size_t)(m0 + srow) * lda + k0 + sch * 8;
    const bf16* bg = Bt + (size_t)(n0 + srow) * ldb + k0 + sch * 8;
    const unsigned lbase = (unsigned)w * 1024u;
#define SG_ISSUE(t_, st_) do { const unsigned so_ = (unsigned)(st_) * SG_STAGE + lbase; \
        __builtin_amdgcn_global_load_lds((const unsigned*)(ag + (size_t)(t_) * 64), (LAS unsigned*)(F.lds + so_), 16, 0, 0); \
        _Pragma("unroll") for (int q_ = 0; q_ < 4; ++q_) __builtin_amdgcn_global_load_lds((const unsigned*)(bg + (size_t)(64 * q_) * ldb + (size_t)(t_) * 64), (LAS unsigned*)(F.lds + so_ + SG_B_OFF + q_ * 8192), 16, 0, 0); } while (0)
    const int nk = klen >> 6, fr = lane & 15, fq = lane >> 4;
    asm volatile("s_waitcnt vmcnt(0) lgkmcnt(0)" ::: "memory"); __builtin_amdgcn_s_barrier(); asm volatile("" ::: "memory");
    SG_ISSUE(0, 0);
    if (nk > 1) SG_ISSUE(1, 1);
#pragma unroll
    for (int m = 0; m < 4; ++m)
#pragma unroll
        for (int n = 0; n < 2; ++n) acc[m][n] = (f32x4){0.f, 0.f, 0.f, 0.f};
    int st = 0;
#pragma unroll 1
    for (int t = 0; t < nk; ++t) {
        if (t + 1 < nk) asm volatile("s_waitcnt vmcnt(5)" ::: "memory"); else asm volatile("s_waitcnt vmcnt(0)" ::: "memory");
        __builtin_amdgcn_s_barrier(); asm volatile("" ::: "memory");
        if (t + 2 < nk) { const int st2 = st == 0 ? 2 : st - 1; SG_ISSUE(t + 2, st2); }
        const LAS unsigned char* sa = F.lds + st * SG_STAGE; const LAS unsigned char* sb = sa + SG_B_OFF;
#pragma unroll
        for (int ks = 0; ks < 2; ++ks) {
            bf16x8 af[4], bfr[2];
#pragma unroll
            for (int m = 0; m < 4; ++m) { const int row = 16 * m + fr; af[m] = *(const LAS bf16x8*)(sa + row * 128 + (((4 * ks + fq) ^ (row & 7)) << 4)); }
#pragma unroll
            for (int n = 0; n < 2; ++n) { const int row = 32 * w + 16 * n + fr; bfr[n] = *(const LAS bf16x8*)(sb + row * 128 + (((4 * ks + fq) ^ (row & 7)) << 4)); }
#pragma unroll
            for (int m = 0; m < 4; ++m)
#pragma unroll
                for (int n = 0; n < 2; ++n) acc[m][n] = MFMA16(bfr[n], af[m], acc[m][n]);
        }
        asm volatile("s_waitcnt lgkmcnt(0)" ::: "memory");
        st = st == 2 ? 0 : st + 1;
    }
#undef SG_ISSUE
}
template <class Epi>
__device__ __forceinline__ void small_unit(Frame& F, const bf16* A, int lda, const bf16* Bt, int ldb, int m0, int n0, int k0, int klen, const Epi& E) {
    f32x4 acc[4][2];
    small_unit_acc(F, A, lda, Bt, ldb, m0, n0, k0, klen, acc);
    E(acc, m0, n0 + 32 * F.wave, F.lane & 15, F.lane >> 4);
}
template <int ACT> struct SEpiBf16 { bf16* O; int ldc;
    __device__ __forceinline__ void operator()(const f32x4 (&acc)[4][2], int m0, int c0, int fr, int fq) const {
#pragma unroll
        for (int m = 0; m < 4; ++m)
#pragma unroll
            for (int n = 0; n < 2; ++n) { f32x4 v = acc[m][n];
                if (ACT == 2) {
#pragma unroll
                    for (int e = 0; e < 4; ++e) { const float a = fmaxf(v[e], 0.f); v[e] = a * a; } }
                v2u wv; wv.x = pg8::cvt_pk_bf16(v[0], v[1]); wv.y = pg8::cvt_pk_bf16(v[2], v[3]);
                *(v2u*)(O + (size_t)(m0 + 16 * m + fr) * ldc + c0 + 16 * n + 4 * fq) = wv; }
    } };
struct SEpiF32 { float* O; int ldc;
    int row_off;
    __device__ __forceinline__ void operator()(const f32x4 (&acc)[4][2], int m0, int c0, int fr, int fq) const {
#pragma unroll
        for (int m = 0; m < 4; ++m)
#pragma unroll
            for (int n = 0; n < 2; ++n) *(f32x4*)(O + (size_t)(m0 - row_off + 16 * m + fr) * ldc + c0 + 16 * n + 4 * fq) = acc[m][n];
    } };
template <int ACT>
__device__ __forceinline__ void small_phase(Frame& F, const bf16* A, int lda, const bf16* Bt, int K, int ncol0, int N, int row0, int nmt, bf16* O, int ldc, int shift) {
    const int nnt = N >> 8, nsu = nmt * nnt;
    const SEpiBf16<ACT> E{O, ldc};
    for (int su = ((int)blockIdx.x - shift + 2 * F.G) % F.G; su < nsu; su += F.G) { const int mt = su / nnt, nt = su - mt * nnt;
        small_unit(F, A, lda, Bt, K, row0 + 64 * mt, ncol0 + 256 * nt, 0, K, E); }
}

struct SEpiGlu { const bf16* Z; bf16* CAT; float* SS;
    __device__ __forceinline__ void operator()(const f32x4 (&acc)[4][2], int m0, int c0, int fr, int fq) const {
#pragma unroll
        for (int m = 0; m < 4; ++m) { const int row = m0 + 16 * m + fr; float ss = 0.f;
#pragma unroll
            for (int n = 0; n < 2; ++n) { const int c = c0 + 16 * n + 4 * fq; const v2u zw = *(const v2u*)(Z + (size_t)row * SW + c);
                const float z[4] = {bflo(zw.x), bfhi(zw.x), bflo(zw.y), bfhi(zw.y)}; float o[4];
#pragma unroll
                for (int e = 0; e < 4; ++e) { o[e] = z[e] * sigmoidf_(acc[m][n][e]); ss += o[e] * o[e]; }
                v2u wv; wv.x = pg8::cvt_pk_bf16(o[0], o[1]); wv.y = pg8::cvt_pk_bf16(o[2], o[3]);
                *(v2u*)(CAT + (size_t)row * D + 512 + c) = wv; }
            ss += __shfl_xor(ss, 16); ss += __shfl_xor(ss, 32);
            if (fq == 0) SS[(size_t)row * 32 + (c0 >> 5)] = ss; }
    } };
__device__ __forceinline__ void out_sample_units(Frame& F) {
    const bf16* CAT = (const bf16*)(F.ws + WS_CAT); const bf16* W = (const bf16*)(F.ws + WS_WOUT); bf16* O1 = (bf16*)(F.ws + WS_O); const float* SS = (const float*)(F.ws + WS_SS);
    LAS float* sc = (LAS float*)(F.lds + 3 * SG_STAGE);
    const int lane = F.lane, fr = lane & 15, fq = lane >> 4;
    for (int su = (int)blockIdx.x; su < 32; su += F.G) { const int mt = su >> 2, nt = su & 3, m0 = MP + 64 * mt;
        f32x4 a1[4][2], a2[4][2];
        small_unit_acc(F, CAT, D, W, D, m0, 256 * nt, 0, 512, a1);
        small_unit_acc(F, CAT, D, W, D, m0, 256 * nt, 512, 512, a2);
        if (F.tid < 64) { const float* p = SS + (size_t)(m0 + F.tid) * 32; float sa = 0.f, sb = 0.f;
#pragma unroll
            for (int e = 0; e < 16; ++e) sb += p[e];
#pragma unroll
            for (int e = 16; e < 24; ++e) sa += p[e];
            sc[F.tid] = 1.0f / sqrtf(sa * (1.f / 512.f) + EPS); sc[64 + F.tid] = 1.0f / sqrtf(sb * (1.f / 512.f) + EPS); }
        __syncthreads();
#pragma unroll
        for (int m = 0; m < 4; ++m) { const float sa = sc[16 * m + fr], sb = sc[64 + 16 * m + fr];
#pragma unroll
            for (int n = 0; n < 2; ++n) { const f32x4 v = a1[m][n] * sa + a2[m][n] * sb;
                v2u wv; wv.x = pg8::cvt_pk_bf16(v[0], v[1]); wv.y = pg8::cvt_pk_bf16(v[2], v[3]);
                *(v2u*)(O1 + (size_t)(m0 + 16 * m + fr) * D + 256 * nt + 32 * F.wave + 16 * n + 4 * fq) = wv; } }
        __syncthreads();
    }
}
__device__ __forceinline__ void out_scale_tables(Frame& F, int pm) {
    const float* SS = (const float*)(F.ws + WS_SS); LAS float* tb = (LAS float*)(F.lds + RING_BYTES);
    if (F.tid < 256) { const float* p = SS + (size_t)(256 * pm + F.tid) * 32; float sa = 0.f, sb = 0.f;
#pragma unroll
        for (int e = 0; e < 8; ++e) sb += p[e];
#pragma unroll
        for (int e = 16; e < 24; ++e) sa += p[e];
        const float ra = 1.0f / sqrtf(sa * (1.f / 512.f) + EPS), rb = 1.0f / sqrtf(sb * (1.f / 512.f) + EPS);
        tb[F.tid] = ra / rb; tb[256 + F.tid] = rb; }
    __syncthreads();
}
#ifndef MK_N_LAUNCHES
#define MK_N_LAUNCHES 1
#endif
constexpr int N_PHASES = 11;
#define PROBE_SUB 0
#define PROBE_MASK 0
struct Args { const float* in[27]; float* out; unsigned char* ws; int ph_lo, ph_hi; };
__global__ void __launch_bounds__(NWAVES * 64, 2) hymba_fwd(Args args) {
    extern __shared__ __attribute__((aligned(16))) unsigned char lds[];
    Frame F;
    F.lds = (LAS unsigned char*)lds;
    F.MISC = (volatile LAS unsigned*)(F.lds + MISC_OFF);
    F.tid = threadIdx.x; F.lane = F.tid & 63; F.wave = __builtin_amdgcn_readfirstlane(F.tid >> 6);
    F.G = gridDim.x; { const int bx = blockIdx.x; F.vcu = (F.G % 8 == 0) ? (bx % 8) * (F.G / 8) + bx / 8 : bx; }
#pragma unroll
    for (int i = 0; i < 27; ++i) F.in[i] = args.in[i];
    F.out = args.out; F.ws = args.ws; F.ctl = (gu32*)(args.ws + WS_CTL);
    for (int u = F.tid; u < (LDS_BYTES - LDSCTL_OFF) / 4; u += NWAVES * 64) ((LAS unsigned*)(F.lds + LDSCTL_OFF))[u] = 0u;
    __syncthreads();
    const int lo = args.ph_lo, hi = args.ph_hi;
    const bool one = (hi - lo) > 1;
    XcdBarrier bar; bar.bar = (unsigned*)(F.ctl + CW_BAR); bar.x = 0; bar.st = nullptr;
    if (one) bar = xcd_barrier_post((unsigned*)(F.ctl + CW_BAR), F.MISC + 8);
#define IN(k) (lo <= (k) && (k) < hi)
#define SEAM(k) do { if (IN(k) && IN((k) + 1)) xcd_barrier(bar); } while (0)
#define NREP(k) (((PROBE_MASK >> (k)) & 1) ? 2 : 1)
#define PH(k, ...) do { if (IN(k)) { { __VA_ARGS__ } if (NREP(k) == 2) { xcd_barrier(bar); { __VA_ARGS__ } } } SEAM(k); } while (0)
    bf16* const XN = (bf16*)(F.ws + WS_XN); bf16* const OB = (bf16*)(F.ws + WS_O); bf16* const PB = (bf16*)(F.ws + WS_P);
    PH(0, p0_prologue(F); p0_ssm_pow(F););
    PH(1, pg8::Gemm g{XN, (const bf16*)(F.ws + WS_WIN), MP, 1024, D}; pg8::StaticOrder S; S.init(MP, 1024, F.G, (int)blockIdx.x);
        pg8::EpiBf16<0> E{PB, DIN}; pg8::gemm_phase<pg8::EpiBf16<0>, pg8::StaticOrder, true, true>(F.lds, g, S, E);
        if (PROBE_SUB & 32) pg8::gemm_phase<pg8::EpiBf16<0>, pg8::StaticOrder, true, true>(F.lds, g, S, E);
        small_phase<0>(F, XN, D, (const bf16*)(F.ws + WS_WIN), D, 1024, 256, 0, 256, PB, DIN, 0);
        if (PROBE_SUB & 64) small_phase<0>(F, XN, D, (const bf16*)(F.ws + WS_WIN), D, 1024, 256, 0, 256, PB, DIN, 0);
        small_phase<0>(F, XN, D, (const bf16*)(F.ws + WS_WIN), D, 0, DIN, MP, 9, PB, DIN, 0);
        if (PROBE_SUB & 128) small_phase<0>(F, XN, D, (const bf16*)(F.ws + WS_WIN), D, 0, DIN, MP, 9, PB, DIN, 0);
        if (F.G == 256 && (int)blockIdx.x >= 48) p1_vt(F, (int)blockIdx.x - 48, 208); else if (F.G != 256) p1_vt(F, (int)blockIdx.x, F.G););
    PH(2, s1_hloc(F); __syncthreads(); if (PROBE_SUB & 1) { s1_hloc(F); __syncthreads(); } s1_small_seqs(F); if (PROBE_SUB & 2) s1_small_seqs(F); attn_prompt(F); if (PROBE_SUB & 4) attn_prompt(F); attn_sample(F); if (PROBE_SUB & 8) attn_sample(F); p3_windows(F); if (PROBE_SUB & 16) p3_windows(F););
    PH(3, s2_scan(F); if (F.vcu >= 16) { p4_late_weights(F, (F.vcu - 16) * NWAVES + F.wave, (F.G - 16) * NWAVES); __syncthreads(); p4_qt_kc(F, F.vcu - 16, F.G - 16); });
    PH(4, s3_y(F););
    PH(5, pg8::Gemm g{(const bf16*)(F.ws + WS_Z), (const bf16*)(F.ws + WS_WGLU), MP, SW, SW}; pg8::StaticOrder S; S.init(MP, SW, F.G, (int)blockIdx.x);
        pg8::EpiGlu E{(const bf16*)(F.ws + WS_Z), SW, (bf16*)(F.ws + WS_CAT) + 512, D, (float*)(F.ws + WS_SS)}; pg8::gemm_phase<pg8::EpiGlu, pg8::StaticOrder, true, true>(F.lds, g, S, E);
        { const SEpiGlu E2{(const bf16*)(F.ws + WS_Z), (bf16*)(F.ws + WS_CAT), (float*)(F.ws + WS_SS)};
          for (int su = ((int)blockIdx.x + F.G - 128) % F.G; su < 16; su += F.G) small_unit(F, (const bf16*)(F.ws + WS_Z), SW, (const bf16*)(F.ws + WS_WGLU), SW, MP + 64 * (su >> 1), 256 * (su & 1), 0, SW, E2); });
    PH(6, pg8::Gemm g{(const bf16*)(F.ws + WS_CAT), (const bf16*)(F.ws + WS_WOUT), MP, D, D}; pg8::StaticOrder S; S.init(MP, D, F.G, (int)blockIdx.x);
        { pg8::Unit u0; if (S.next(0, u0)) out_scale_tables(F, u0.pm); }
        pg8::EpiBf16Fin E{OB, D, (const LAS float*)(F.lds + RING_BYTES + 1024)}; pg8::gemm_phase<pg8::EpiBf16Fin, pg8::StaticOrder, true, true, true>(F.lds, g, S, E);
        out_sample_units(F););
    PH(7, p7_mid(F););
    PH(8, pg8::Gemm g{XN, (const bf16*)(F.ws + WS_WUP), MP, DFF, D}; pg8::StaticOrder S; S.init(MP, DFF, F.G, (int)blockIdx.x);
        pg8::EpiBf16<2> E{(bf16*)(F.ws + WS_H), DFF}; pg8::gemm_phase<pg8::EpiBf16<2>, pg8::StaticOrder, true, true>(F.lds, g, S, E);
        small_phase<2>(F, XN, D, (const bf16*)(F.ws + WS_WUP), D, 0, DFF, MP, 8, (bf16*)(F.ws + WS_H), DFF, 0););
    PH(9, pg8::Gemm g{(const bf16*)(F.ws + WS_H), (const bf16*)(F.ws + WS_WDN), MP, D, DFF}; pg8::StaticOrder S; S.init(MP, D, F.G, (int)blockIdx.x);
        pg8::EpiBf16<0> E{OB, D}; pg8::gemm_phase<pg8::EpiBf16<0>, pg8::StaticOrder, true, true>(F.lds, g, S, E);
        for (int su = (int)blockIdx.x; su < 256; su += F.G) { const int kq = su & 7, nt = (su >> 3) & 3, mt = su >> 5;
            const SEpiF32 E2{(float*)(F.ws + WS_XN) + (size_t)kq * MS * D, D, MP};
            small_unit(F, (const bf16*)(F.ws + WS_H), DFF, (const bf16*)(F.ws + WS_WDN), DFF, MP + 64 * mt, 256 * nt, 512 * kq, 512, E2); });
    if (IN(10)) { p10_final(F); }
#undef IN
#undef SEAM
}

extern "C" void kernel_launch(void* const* d_in, const int* in_sizes, int n_in, void* d_out, int out_size, void* d_ws, size_t ws_size, hipStream_t stream) {
    static int grid = 0;
    if (grid == 0) {
        if (n_in != 27 || ws_size < WS_TOP) { fprintf(stderr, "kernel_launch: unexpected n_in %d / ws %zu\n", n_in, ws_size); grid = -1; return; }
        int dev = 0, cus = 0, per_cu = 0;
        if (hipGetDevice(&dev) != hipSuccess || hipDeviceGetAttribute(&cus, hipDeviceAttributeMultiprocessorCount, dev) != hipSuccess) { grid = -1; return; }
        if (hipFuncSetAttribute((const void*)hymba_fwd, hipFuncAttributeMaxDynamicSharedMemorySize, LDS_BYTES) != hipSuccess) { fprintf(stderr, "kernel_launch: hipFuncSetAttribute failed\n"); grid = -1; return; }
        if (hipOccupancyMaxActiveBlocksPerMultiprocessor(&per_cu, (const void*)hymba_fwd, NWAVES * 64, LDS_BYTES) != hipSuccess || per_cu < 1) { fprintf(stderr, "kernel_launch: occupancy query says %d\n", per_cu); per_cu = 1; }
        (void)hipGetLastError();
        grid = cus;
    }
    if (grid < 0) return;
    (void)hipMemsetAsync((char*)d_ws + WS_CTL, 0, CTL_ZERO_BYTES, stream);
    Args a{};
    for (int i = 0; i < 27; ++i) a.in[i] = (const float*)d_in[i];
    a.out = (float*)d_out; a.ws = (unsigned char*)d_ws;
#if MK_N_LAUNCHES == 1
    a.ph_lo = 0; a.ph_hi = N_PHASES;
    void* kargs[] = {&a};
    hipError_t e = hipLaunchCooperativeKernel((const void*)hymba_fwd, dim3(grid), dim3(NWAVES * 64), kargs, LDS_BYTES, stream);
    if (e != hipSuccess) fprintf(stderr, "kernel_launch: cooperative launch failed: %s (grid %d)\n", hipGetErrorString(e), grid);
#else
    for (int p = 0; p < N_PHASES; ++p) { a.ph_lo = p; a.ph_hi = p + 1; hipLaunchKernelGGL(hymba_fwd, dim3(grid), dim3(NWAVES * 64), LDS_BYTES, stream, a); }
#endif
}
```

```cpp
#include <hip/hip_runtime.h>
#include <cstdio>
#include <cstdint>
namespace pg8 {
#define PG8_LAS __attribute__((address_space(3)))
typedef unsigned short bf16_t;
typedef short bf16x8 __attribute__((ext_vector_type(8)));
typedef float f32x4 __attribute__((ext_vector_type(4)));
typedef unsigned u32x4 __attribute__((ext_vector_type(4)));
constexpr int BM = 256, BK = 64, HALF = 128, HTB = HALF * BK * 2  , STAGE_BYTES = 8 * HTB, NXCD = 8, WGM = 8;

__host__ __device__ __forceinline__ int lds_byte(int r, int c) { const int st = (r >> 4) * 2 + (c >> 5), rr = r & 15, cc = c & 31, ob = rr * 64 + cc * 2; return st * 1024 + (ob ^ (((ob >> 9) & 1) << 5)); }
__host__ __device__ __forceinline__ void stage_rc(int b, int& R, int& C) { const int st = b / 1024, sb = b % 1024, swz = sb ^ (((sb >> 9) & 1) << 5); R = (st >> 1) * 16 + swz / 64; C = (st & 1) * 32 + (swz % 64) / 2; }
__host__ __device__ __forceinline__ int perm32(int rho) { const int n = rho >> 4, i = rho & 15; return 8 * (i >> 2) + 4 * n + (i & 3); }

struct Unit { int pm, pn; };
struct Gemm { const bf16_t* A; const bf16_t* Bt; int M, N, K; };

struct StaticOrder {
    int nM, nN, nwg, G, c;
    __host__ __device__ void init(int M, int N, int G_, int c_) { nM = M / BM; nN = N / BM; nwg = nM * nN; G = G_; c = c_; }
    __host__ __device__ bool next(int i, Unit& u) const {
        const long L = (long)i * G + c; if (L >= nwg) return false;
        int wgid = (int)L; { const int q = nwg / NXCD, r = nwg % NXCD, xcd = wgid % NXCD, off = wgid / NXCD; wgid = (xcd < r ? xcd * (q + 1) : r * (q + 1) + (xcd - r) * q) + off; }
        const int nig = WGM * nN, gid = wgid / nig, fm = gid * WGM, gsz = (nM - fm) < WGM ? (nM - fm) : WGM;
        u.pm = fm + ((wgid % nig) % gsz); u.pn = (wgid % nig) / gsz; return true;
    }
    __device__ __forceinline__ void a_ready(const Unit&) const {}
    __device__ __forceinline__ void done(const Unit&) const {}
};
__device__ __forceinline__ unsigned cvt_pk_bf16(float lo, float hi) { unsigned r; asm volatile("v_cvt_pk_bf16_f32 %0, %1, %2" : "=v"(r) : "v"(lo), "v"(hi)); return r; }
template <int ACT> struct EpiBf16 {
    static constexpr bool PERM = true, AFTER_DRAIN = false;
    bf16_t* O; int ldc;
    __device__ __forceinline__ void operator()(const f32x4 (&acc)[2][2][4][2], const Unit& u, int wr, int wc, int fr, int fq) const {
        const int row0 = u.pm * BM + wr * 64 + fr; const int col0 = u.pn * BM + wc * 32 + 8 * fq;
#pragma unroll
        for (int ai = 0; ai < 2; ++ai)
#pragma unroll
            for (int m = 0; m < 4; ++m) { bf16_t* rowp = O + (size_t)(row0 + ai * HALF + m * 16) * ldc + col0;
#pragma unroll
                for (int bj = 0; bj < 2; ++bj) { f32x4 v0 = acc[ai][bj][m][0], v1 = acc[ai][bj][m][1];
                    if (ACT == 2) {
#pragma unroll
                        for (int e = 0; e < 4; ++e) { const float a = fmaxf(v0[e], 0.f), b = fmaxf(v1[e], 0.f); v0[e] = a * a; v1[e] = b * b; } }
                    u32x4 w; w.x = cvt_pk_bf16(v0[0], v0[1]); w.y = cvt_pk_bf16(v0[2], v0[3]); w.z = cvt_pk_bf16(v1[0], v1[1]); w.w = cvt_pk_bf16(v1[2], v1[3]);
                    *(u32x4*)(rowp + bj * HALF) = w; } }
    }
};
struct EpiBf16Fin {
    static constexpr bool PERM = true, AFTER_DRAIN = false;
    bf16_t* O; int ldc; const PG8_LAS float* fin;
    __device__ __forceinline__ void operator()(const f32x4 (&acc)[2][2][4][2], const Unit& u, int wr, int wc, int fr, int fq) const {
        const int row0 = u.pm * BM + wr * 64 + fr; const int col0 = u.pn * BM + wc * 32 + 8 * fq;
#pragma unroll
        for (int ai = 0; ai < 2; ++ai)
#pragma unroll
            for (int m = 0; m < 4; ++m) { bf16_t* rowp = O + (size_t)(row0 + ai * HALF + m * 16) * ldc + col0; const float f = fin[ai * HALF + wr * 64 + m * 16 + fr];
#pragma unroll
                for (int bj = 0; bj < 2; ++bj) { const f32x4 v0 = acc[ai][bj][m][0] * f, v1 = acc[ai][bj][m][1] * f;
                    u32x4 w; w.x = cvt_pk_bf16(v0[0], v0[1]); w.y = cvt_pk_bf16(v0[2], v0[3]); w.z = cvt_pk_bf16(v1[0], v1[1]); w.w = cvt_pk_bf16(v1[2], v1[3]);
                    *(u32x4*)(rowp + bj * HALF) = w; } }
    }
};
struct EpiGlu {
    static constexpr bool PERM = true, AFTER_DRAIN = false;
    const bf16_t* Z; int ldz; bf16_t* O; int ldc; float* SS;
    __device__ __forceinline__ void operator()(const f32x4 (&acc)[2][2][4][2], const Unit& u, int wr, int wc, int fr, int fq) const {
        const int row0 = u.pm * BM + wr * 64 + fr; const int col0 = u.pn * BM + wc * 32 + 8 * fq;
#pragma unroll
        for (int ai = 0; ai < 2; ++ai)
#pragma unroll
            for (int m = 0; m < 4; ++m) { const int row = row0 + ai * HALF + m * 16; float ss = 0.f;
#pragma unroll
                for (int bj = 0; bj < 2; ++bj) { const u32x4 zw = *(const u32x4*)(Z + (size_t)row * ldz + col0 + bj * HALF);
                    const float z[8] = {__uint_as_float(zw.x << 16), __uint_as_float(zw.x & 0xffff0000u), __uint_as_float(zw.y << 16), __uint_as_float(zw.y & 0xffff0000u),
                                        __uint_as_float(zw.z << 16), __uint_as_float(zw.z & 0xffff0000u), __uint_as_float(zw.w << 16), __uint_as_float(zw.w & 0xffff0000u)};
                    float o[8];
#pragma unroll
                    for (int e = 0; e < 4; ++e) { o[e] = z[e] / (1.0f + __expf(-acc[ai][bj][m][0][e])); o[4 + e] = z[4 + e] / (1.0f + __expf(-acc[ai][bj][m][1][e])); }
#pragma unroll
                    for (int e = 0; e < 8; ++e) ss += o[e] * o[e];
                    u32x4 w; w.x = cvt_pk_bf16(o[0], o[1]); w.y = cvt_pk_bf16(o[2], o[3]); w.z = cvt_pk_bf16(o[4], o[5]); w.w = cvt_pk_bf16(o[6], o[7]);
                    *(u32x4*)(O + (size_t)row * ldc + col0 + bj * HALF) = w; }
                ss += __shfl_xor(ss, 16); ss += __shfl_xor(ss, 32);
                if (fq == 0) SS[(size_t)row * 32 + u.pn * 4 + wc] = ss; }
    }
};
template <class Epi, class Sched, bool ALIGN_EPI = false, bool SP2 = false, bool MID = false>
__device__ __forceinline__ void gemm_phase(PG8_LAS unsigned char* lds, const Gemm g, const Sched& S, const Epi& E) {
    const int tid = threadIdx.x, wid = __builtin_amdgcn_readfirstlane(tid >> 6), lane = tid & 63, wr = wid >> 2, wc = wid & 3, fr = lane & 15, fq = lane >> 4;
    const int K = g.K, nt = K / BK;
    unsigned voffA[2], voffB[2];
#pragma unroll
    for (int i = 0; i < 2; ++i) { int R, C; stage_rc(tid * 16 + i * 8192, R, C); const int Rb = Epi::PERM ? ((R & ~31) + perm32(R & 31)) : R;
        voffA[i] = (unsigned)(R * K + C) * 2u; voffB[i] = (unsigned)(Rb * K + C) * 2u; }
    const size_t kstep = (size_t)(BK * 2);
    const size_t hstep = (size_t)HALF * K * 2;
    const size_t tstep = 2 * hstep;
    const unsigned ldsw = (unsigned)wid * 1024u;
    const int aoff = lds_byte(wr * 64 + fr, fq * 8), boff = lds_byte(wc * 32 + fr, fq * 8);
#define PG8_SA(b, h) (((b) * 2 + (h)) * HTB)
#define PG8_SB(b, h) ((4 + (b) * 2 + (h)) * HTB)
#define PG8_STAGE(bufoff, gbase, voff) do { _Pragma("unroll") for (int _i = 0; _i < 2; ++_i) \
        __builtin_amdgcn_global_load_lds((const unsigned*)((const char*)(gbase) + (voff)[_i]), (PG8_LAS unsigned*)(lds + (bufoff) + ldsw + _i * 8192), 16, 0, 0); } while (0)
#define PG8_LDA(dst, b, h) do { _Pragma("unroll") for (int m = 0; m < 4; ++m) _Pragma("unroll") for (int k = 0; k < 2; ++k) dst[m][k] = *(const PG8_LAS bf16x8*)(lds + PG8_SA(b, h) + aoff + m * 2048 + k * 1024); } while (0)
#define PG8_LDB(dst, b, h) do { _Pragma("unroll") for (int n = 0; n < 2; ++n) _Pragma("unroll") for (int k = 0; k < 2; ++k) dst[n][k] = *(const PG8_LAS bf16x8*)(lds + PG8_SB(b, h) + boff + n * 2048 + k * 1024); } while (0)
#define PG8_MMA(ai, bj, At, Bt) do { __builtin_amdgcn_s_setprio(1); _Pragma("unroll") for (int m = 0; m < 4; ++m) _Pragma("unroll") for (int n = 0; n < 2; ++n) _Pragma("unroll") for (int k = 0; k < 2; ++k) \
        acc[ai][bj][m][n] = __builtin_amdgcn_mfma_f32_16x16x32_bf16(Bt[n][k], At[m][k], acc[ai][bj][m][n], 0, 0, 0); __builtin_amdgcn_s_setprio(0); } while (0)
#define PG8_WAIT_V(n) asm volatile("s_waitcnt vmcnt(" #n ")" ::: "memory")
#define PG8_WAIT_L(n) asm volatile("s_waitcnt lgkmcnt(" #n ")" ::: "memory")
#define PG8_BAR __builtin_amdgcn_s_barrier()
#define PG8_SCHED __builtin_amdgcn_sched_barrier(0)
    Unit cur, nxt; int ui = 0;
    if (!S.next(0, cur)) return;
    f32x4 acc[2][2][4][2];
#pragma unroll
    for (int a = 0; a < 2; ++a)
#pragma unroll
        for (int b = 0; b < 2; ++b)
#pragma unroll
            for (int m = 0; m < 4; ++m)
#pragma unroll
                for (int n = 0; n < 2; ++n) acc[a][b][m][n] = (f32x4){0.f, 0.f, 0.f, 0.f};
    bf16x8 At[4][2], B0[2][2], B1[2][2];
    const char* cA = (const char*)g.A + (size_t)cur.pm * tstep; const char* cB = (const char*)g.Bt + (size_t)cur.pn * tstep;
    S.a_ready(cur);
    if constexpr (SP2) {
        PG8_STAGE(PG8_SB(0, 0), cB, voffB); PG8_STAGE(PG8_SB(0, 1), cB + hstep, voffB); PG8_STAGE(PG8_SA(0, 0), cA, voffA); PG8_STAGE(PG8_SA(0, 1), cA + hstep, voffA);
        if (wr == 1) PG8_BAR;
        PG8_WAIT_V(2); PG8_BAR;
        PG8_STAGE(PG8_SB(1, 0), cB + kstep, voffB); PG8_STAGE(PG8_SA(1, 0), cA + kstep, voffA); PG8_STAGE(PG8_SB(1, 1), cB + hstep + kstep, voffB);
        PG8_WAIT_V(6); PG8_BAR;
    } else {
        PG8_STAGE(PG8_SB(0, 0), cB, voffB); PG8_STAGE(PG8_SA(0, 0), cA, voffA); PG8_STAGE(PG8_SB(0, 1), cB + hstep, voffB); PG8_STAGE(PG8_SA(0, 1), cA + hstep, voffA);
        if (wr == 1) PG8_BAR;
        PG8_WAIT_V(4); PG8_BAR;
        PG8_STAGE(PG8_SB(1, 0), cB + kstep, voffB); PG8_STAGE(PG8_SA(1, 0), cA + kstep, voffA); PG8_STAGE(PG8_SB(1, 1), cB + hstep + kstep, voffB);
        PG8_WAIT_V(6); PG8_BAR;
    }
    for (;;) {
        const bool has_next = S.next(ui + 1, nxt);
        const char* nA = has_next ? (const char*)g.A + (size_t)nxt.pm * tstep : cA; const char* nB = has_next ? (const char*)g.Bt + (size_t)nxt.pn * tstep : cB;
        for (int t = 0; t < nt; t += 2) {
            if constexpr (MID) { if (t == (nt >> 1)) {
                float rr[2][4];
#pragma unroll
                for (int ai = 0; ai < 2; ++ai)
#pragma unroll
                    for (int m = 0; m < 4; ++m) rr[ai][m] = *(const PG8_LAS float*)(lds + STAGE_BYTES + (ai * HALF + wr * 64 + m * 16 + fr) * 4);
                asm volatile("s_waitcnt lgkmcnt(0)" ::: "memory");
#pragma unroll
                for (int ai = 0; ai < 2; ++ai)
#pragma unroll
                    for (int bj = 0; bj < 2; ++bj)
#pragma unroll
                        for (int m = 0; m < 4; ++m)
#pragma unroll
                            for (int n = 0; n < 2; ++n) acc[ai][bj][m][n] *= rr[ai][m];
            } }
            const bool last = (t == nt - 2);
            const char* a1 = cA + (size_t)(t + 1) * kstep;
            const char* a2 = last ? nA : cA + (size_t)(t + 2) * kstep; const char* b2 = last ? nB : cB + (size_t)(t + 2) * kstep;
            const char* a3 = a2 + kstep; const char* b3 = b2 + kstep;
            if (last && has_next) S.a_ready(nxt);
            if constexpr (SP2) {
            PG8_LDB(B0, 0, 0); PG8_LDB(B1, 0, 1); PG8_SCHED; PG8_LDA(At, 0, 0); PG8_STAGE(PG8_SA(1, 1), a1 + hstep, voffA);
            PG8_WAIT_V(8); PG8_WAIT_L(0); PG8_BAR; PG8_MMA(0, 0, At, B0); PG8_MMA(0, 1, At, B1); PG8_BAR; PG8_SCHED;
            PG8_LDA(At, 0, 1); PG8_STAGE(PG8_SB(0, 0), b2, voffB); PG8_STAGE(PG8_SB(0, 1), b2 + hstep, voffB); PG8_STAGE(PG8_SA(0, 0), a2, voffA);
            PG8_WAIT_V(8); PG8_WAIT_L(0); PG8_BAR; PG8_MMA(1, 0, At, B0); PG8_MMA(1, 1, At, B1); PG8_BAR; PG8_SCHED;
            PG8_LDB(B0, 1, 0); PG8_LDB(B1, 1, 1); PG8_SCHED; PG8_LDA(At, 1, 0); PG8_STAGE(PG8_SA(0, 1), a2 + hstep, voffA);
            PG8_WAIT_V(8); PG8_WAIT_L(0); PG8_BAR; PG8_MMA(0, 0, At, B0); PG8_MMA(0, 1, At, B1); PG8_BAR; PG8_SCHED;
            PG8_LDA(At, 1, 1); PG8_STAGE(PG8_SB(1, 0), b3, voffB); PG8_STAGE(PG8_SB(1, 1), b3 + hstep, voffB); PG8_STAGE(PG8_SA(1, 0), a3, voffA);
            PG8_WAIT_V(8); PG8_WAIT_L(0); PG8_BAR; PG8_MMA(1, 0, At, B0); PG8_MMA(1, 1, At, B1); PG8_BAR; PG8_SCHED;
            } else {
            PG8_LDB(B0, 0, 0); PG8_SCHED; PG8_LDA(At, 0, 0); PG8_STAGE(PG8_SA(1, 1), a1 + hstep, voffA);
            PG8_WAIT_L(8); PG8_BAR; PG8_WAIT_L(0); PG8_MMA(0, 0, At, B0); PG8_BAR; PG8_SCHED;
            PG8_LDB(B1, 0, 1); PG8_STAGE(PG8_SB(0, 0), b2, voffB);
            PG8_BAR; PG8_WAIT_L(0); PG8_MMA(0, 1, At, B1); PG8_BAR;
            PG8_LDA(At, 0, 1); PG8_STAGE(PG8_SA(0, 0), a2, voffA);
            PG8_BAR; PG8_WAIT_L(0); PG8_MMA(1, 0, At, B0); PG8_BAR; PG8_SCHED;
            PG8_STAGE(PG8_SB(0, 1), b2 + hstep, voffB);
            PG8_WAIT_V(6); PG8_BAR; PG8_MMA(1, 1, At, B1); PG8_BAR;
            PG8_LDB(B0, 1, 0); PG8_SCHED; PG8_LDA(At, 1, 0); PG8_STAGE(PG8_SA(0, 1), a2 + hstep, voffA);
            PG8_WAIT_L(8); PG8_BAR; PG8_WAIT_L(0); PG8_MMA(0, 0, At, B0); PG8_BAR; PG8_SCHED;
            PG8_LDB(B1, 1, 1); PG8_STAGE(PG8_SB(1, 0), b3, voffB);
            PG8_BAR; PG8_WAIT_L(0); PG8_MMA(0, 1, At, B1); PG8_BAR;
            PG8_LDA(At, 1, 1); PG8_STAGE(PG8_SA(1, 0), a3, voffA);
            PG8_BAR; PG8_WAIT_L(0); PG8_MMA(1, 0, At, B0); PG8_BAR; PG8_SCHED;
            PG8_STAGE(PG8_SB(1, 1), b3 + hstep, voffB);
            PG8_WAIT_V(6); PG8_BAR; PG8_MMA(1, 1, At, B1); PG8_BAR;
            }
        }
        if constexpr (ALIGN_EPI) { if (wr == 0) PG8_BAR; }
        if constexpr (!Epi::AFTER_DRAIN) { E(acc, cur, wr, wc, fr, fq); S.done(cur); }
        if (!has_next) break;
#pragma unroll
        for (int a = 0; a < 2; ++a)
#pragma unroll
            for (int b = 0; b < 2; ++b)
#pragma unroll
                for (int m = 0; m < 4; ++m)
#pragma unroll
                    for (int n = 0; n < 2; ++n) acc[a][b][m][n] = (f32x4){0.f, 0.f, 0.f, 0.f};
        cur = nxt; cA = nA; cB = nB; ++ui;
        if constexpr (ALIGN_EPI) { if (wr == 1) PG8_BAR; }
    }
    PG8_WAIT_V(0);
    if constexpr (!ALIGN_EPI) { if (wr == 0) PG8_BAR; }
    PG8_BAR;
    if constexpr (Epi::AFTER_DRAIN) { E.fused(acc, cur, wr, wc, fr, fq, lds, wid, lane); S.done(cur); }
#undef PG8_SA
#undef PG8_SB
#undef PG8_STAGE
#undef PG8_LDA
#undef PG8_LDB
#undef PG8_MMA
#undef PG8_WAIT_V
#undef PG8_WAIT_L
#undef PG8_BAR
#undef PG8_SCHED
}
}

constexpr int NWAVES = 8;
constexpr int D = 1024, DIN = 1280, DFF = 4096, AW = 512, SW = 512;
constexpr int MP = 16384, MS = 512, MR = MP + MS;
constexpr int MMETA = MR, NMETA = 16, MIN_ROWS = 17152;
constexpr int NPOS = 4112 + 4;
constexpr float EPS = 1e-6f;
constexpr size_t O_YP = 0, O_YS = 16777216, O_KP = 17301504, O_VP = 17367040, O_SRP = 17432576, O_SIP = 17440768, O_KS = 17448960, O_VS = 19546112, O_SRS = 21643264, O_SIS = 21905408;
constexpr size_t MiB = 1u << 20;
constexpr size_t WS_CTL = 0, CTL_ZERO_BYTES = 1 * MiB;
constexpr size_t WS_ROPEC = 1 * MiB, WS_ROPES = WS_ROPEC + 160 * 1024, WS_ABR = WS_ROPES + 160 * 1024, WS_ABI = WS_ABR + 8192, WS_BBR = WS_ABI + 8192, WS_BBI = WS_BBR + 131072;
static_assert(WS_BBI + 131072 <= 2 * MiB && NPOS * 8 * 4 <= 160 * 1024, "tables");
constexpr size_t WS_WIN = 2 * MiB, WS_WGLU = 5 * MiB, WS_WOUT = 6 * MiB, WS_WUP = 8 * MiB, WS_WDN = 16 * MiB;
constexpr size_t WS_XN = 24 * MiB, WS_O = 58 * MiB, WS_P = 92 * MiB, WS_ATT = 134 * MiB, WS_Z = 151 * MiB, WS_GL = 168 * MiB, WS_CAT = 185 * MiB, WS_H = 92 * MiB, WS_END = 224 * MiB;
constexpr size_t WS_VT = 224 * MiB, WS_QT = 228 * MiB, WS_KC = 232 * MiB, WS_HL = 233 * MiB, WS_HIN = 241 * MiB, WS_HM = 245 * MiB, WS_A32 = WS_HM + 16384, WS_COEF = WS_A32 + 16384, WS_POW = WS_COEF + 16384, WS_SS = 246 * MiB, WS_TOP = 249 * MiB;
static_assert(WS_XN + (size_t)MIN_ROWS * D * 2 <= WS_O && WS_O + (size_t)MR * D * 2 <= WS_P && WS_P + (size_t)MIN_ROWS * DIN * 2 <= WS_ATT && WS_ATT + (size_t)MR * AW * 2 <= WS_Z && WS_Z + (size_t)MR * SW * 2 <= WS_GL &&
              WS_GL + (size_t)MR * SW * 2 <= WS_CAT && WS_CAT + (size_t)MR * D * 2 <= WS_END && WS_H + (size_t)MR * DFF * 2 <= WS_END, "d_ws map");
constexpr int CW_BAR = 4096;
constexpr int RING_BYTES = 131072, LDS_BYTES = 163840, LDSCTL_OFF = LDS_BYTES - 512, MISC_OFF = LDSCTL_OFF + 320;

#define GAS __attribute__((address_space(1)))
#define LAS __attribute__((address_space(3)))
typedef unsigned short bf16;
typedef unsigned v4u __attribute__((ext_vector_type(4)));
typedef unsigned v2u __attribute__((ext_vector_type(2)));
typedef float f32x4 __attribute__((ext_vector_type(4)));
typedef GAS unsigned gu32;
#define RLX_AGENT __ATOMIC_RELAXED, __HIP_MEMORY_SCOPE_AGENT
#define LDS_WAIT() asm volatile("s_waitcnt lgkmcnt(0)" ::: "memory")
#define VM_WAIT() asm volatile("s_waitcnt vmcnt(0)" ::: "memory")
__device__ __forceinline__ unsigned f2bf(float f) { unsigned u = __builtin_bit_cast(unsigned, f); return (u + 0x7fffu + ((u >> 16) & 1u)) >> 16; }
__device__ __forceinline__ unsigned pk2(float lo, float hi) { return f2bf(lo) | (f2bf(hi) << 16); }
__device__ __forceinline__ float bflo(unsigned w) { return __uint_as_float(w << 16); }
__device__ __forceinline__ float bfhi(unsigned w) { return __uint_as_float(w & 0xffff0000u); }
__device__ __forceinline__ float bf1(bf16 b) { return __uint_as_float((unsigned)b << 16); }

#define XB_TMO      128
#define XB_XCNT(j)  (256  + 64 * (j))
#define XB_XSUB(j)  (1280 + 64 * (j))
#define XB_XGEN(j)  (2304 + 64 * (j))
#define XB_TOP      3328
#define XB_TOPGEN   3392
#define XCD_BAR_WORDS 3456
#define XB_SPIN_CAP (1u << 18)
__device__ __forceinline__ unsigned xb_ld(unsigned* p)              { return __hip_atomic_load(p, __ATOMIC_RELAXED, __HIP_MEMORY_SCOPE_AGENT); }
__device__ __forceinline__ unsigned xb_add(unsigned* p, unsigned v) { return __hip_atomic_fetch_add(p, v, __ATOMIC_RELAXED, __HIP_MEMORY_SCOPE_AGENT); }
__device__ __forceinline__ unsigned xb_xcc_id() { return (unsigned)__builtin_amdgcn_s_getreg((3 << 11) | 20) & 0xFu; }
#define XB_SPIN(cond, bar) do { unsigned _sp = 0; while (cond) { __builtin_amdgcn_s_sleep(1); \
    if ((++_sp & 255u) == 0u) { if (xb_ld(&(bar)[XB_TMO])) break; if (_sp > XB_SPIN_CAP) { atomicAdd(&(bar)[XB_TMO], 1u); break; } } } } while (0)
struct XcdBarrier { unsigned* bar; unsigned x; volatile LAS unsigned* st; };
__device__ __forceinline__ XcdBarrier xcd_barrier_post(unsigned* bar, volatile LAS unsigned* st) {
    XcdBarrier b; b.bar = bar; b.x = xb_xcc_id(); b.st = st;
    if (threadIdx.x == 0) (void)xb_add(&bar[XB_XCNT(b.x)], 1u);
    return b;
}
__device__ __forceinline__ void xcd_barrier_complete(unsigned* bar, unsigned x, unsigned& nloc, unsigned& nx) {
    const unsigned G = gridDim.x * gridDim.y * gridDim.z;
    unsigned sum, cnt, mine, sp = 0u;
    for (;;) {
        sum = 0u; cnt = 0u; mine = 0u;
#pragma unroll
        for (unsigned j = 0; j < 16; ++j) { const unsigned c = xb_ld(&bar[XB_XCNT(j)]); sum += c; cnt += (c > 0u) ? 1u : 0u; mine = (j == x) ? c : mine; }
        if (sum == G) break;
        __builtin_amdgcn_s_sleep(1);
        if ((++sp & 255u) == 0u) { if (xb_ld(&bar[XB_TMO])) break; if (sp > XB_SPIN_CAP) { atomicAdd(&bar[XB_TMO], 1u); break; } }
    }
    nloc = mine > 0u ? mine : 1u; nx = cnt > 0u ? cnt : 1u;
}
__device__ __forceinline__ void xcd_barrier(const XcdBarrier& b) {
    asm volatile("s_waitcnt vmcnt(0)" ::: "memory");
    __syncthreads();
    if (threadIdx.x == 0) {
        unsigned* bar = b.bar;
        __builtin_amdgcn_s_waitcnt(0);
        unsigned nloc = b.st[0], nx = b.st[1];
        if (nloc == 0u) { xcd_barrier_complete(bar, b.x, nloc, nx); b.st[0] = nloc; b.st[1] = nx; }
        const unsigned old = xb_add(&bar[XB_XSUB(b.x)], 1u);
        const unsigned gen = old / nloc;
        if (old + 1u == (gen + 1u) * nloc) {
            __builtin_amdgcn_fence(__ATOMIC_RELEASE, "agent");
            asm volatile("s_waitcnt vmcnt(0)" ::: "memory");
            const unsigned og = xb_add(&bar[XB_TOP], 1u);
            const unsigned tg = og / nx;
            if (og + 1u == (tg + 1u) * nx) xb_add(&bar[XB_TOPGEN], 1u);
            else XB_SPIN(xb_ld(&bar[XB_TOPGEN]) == tg, bar);
            __builtin_amdgcn_fence(__ATOMIC_ACQUIRE, "agent");
            xb_add(&bar[XB_XGEN(b.x)], 1u);
            asm volatile("s_waitcnt vmcnt(0)" ::: "memory");
        } else {
            XB_SPIN(xb_ld(&bar[XB_XGEN(b.x)]) == gen, bar);
            __builtin_amdgcn_fence(__ATOMIC_ACQUIRE, "agent");
            asm volatile("s_waitcnt vmcnt(0)" ::: "memory");
        }
    }
    __syncthreads();
}

struct Frame {
    LAS unsigned char* lds;
    volatile LAS unsigned* MISC;
    gu32* ctl;
    int tid, lane, wave;
    int vcu, G;
    const float* in[27]; float* out; unsigned char* ws;
};
enum { I_XP = 0, I_XS, I_CK, I_CV, I_SRE, I_SIM, I_META, I_GPRE, I_WIN, I_SINK, I_ARE, I_AIM, I_LDT, I_BRE, I_BIM, I_CRE, I_CIM, I_DD, I_WGLU, I_GATT, I_GSSM, I_WOUT, I_GPOST, I_GMLP, I_WUP, I_WDN, I_GMLPP };

__device__ __forceinline__ float wave_sum(float v) {
#pragma unroll
    for (int o = 1; o < 64; o <<= 1) v += __shfl_xor(v, o);
    return v;
}
__device__ __forceinline__ float wave_max(float v) {
#pragma unroll
    for (int o = 1; o < 64; o <<= 1) v = fmaxf(v, __shfl_xor(v, o));
    return v;
}
__device__ __forceinline__ void sincos_d(double a, double& s, double& c) {
    const double k = __builtin_rint(a * 0.63661977236758134308);
    double r = __builtin_fma(-k, 1.57079632679489655800e+00, a);
    r = __builtin_fma(-k, 6.12323399573676603587e-17, r);
    const double r2 = r * r;
    double sp = 1.0 / 6227020800.0; sp = sp * r2 - 1.0 / 39916800.0; sp = sp * r2 + 1.0 / 362880.0; sp = sp * r2 - 1.0 / 5040.0; sp = sp * r2 + 1.0 / 120.0; sp = sp * r2 - 1.0 / 6.0; sp = sp * r2 + 1.0; sp = sp * r;
    double cp = -1.0 / 87178291200.0; cp = cp * r2 + 1.0 / 479001600.0; cp = cp * r2 - 1.0 / 3628800.0; cp = cp * r2 + 1.0 / 40320.0; cp = cp * r2 - 1.0 / 720.0; cp = cp * r2 + 1.0 / 24.0; cp = cp * r2 - 0.5; cp = cp * r2 + 1.0;
    const int q = ((int)k) & 3;
    s = (q == 0) ? sp : (q == 1) ? cp : (q == 2) ? -sp : -cp;
    c = (q == 0) ? cp : (q == 1) ? -sp : (q == 2) ? -cp : sp;
}
__device__ __forceinline__ double exp_d(double x) {
    const double k = __builtin_rint(x * 1.44269504088896340736);
    double r = __builtin_fma(-k, 6.93147180369123816490e-01, x); r = __builtin_fma(-k, 1.90821492927058770002e-10, r);
    double p = 1.0 / 6227020800.0; p = p * r + 1.0 / 479001600.0; p = p * r + 1.0 / 39916800.0; p = p * r + 1.0 / 3628800.0; p = p * r + 1.0 / 362880.0; p = p * r + 1.0 / 40320.0; p = p * r + 1.0 / 5040.0;
    p = p * r + 1.0 / 720.0; p = p * r + 1.0 / 120.0; p = p * r + 1.0 / 24.0; p = p * r + 1.0 / 6.0; p = p * r + 0.5; p = p * r + 1.0; p = p * r + 1.0;
    const long long bits = ((long long)(1023 + (int)k)) << 52;
    return p * __builtin_bit_cast(double, bits);
}
__device__ __forceinline__ float gelu_tanh(float x) {
    const float a = 0.7978845608028654f * (x + 0.044715f * x * x * x);
    const float e = __expf(2.0f * a);
    const float t = 1.0f - 2.0f / (e + 1.0f);
    return 0.5f * x * (1.0f + t);
}
__device__ __forceinline__ float sigmoidf_(float x) { return 1.0f / (1.0f + __expf(-x)); }

__device__ __forceinline__ void p0_transpose_item(const float* W, int K, int N, bf16* WT, LAS float* scr, int item, int lane, const float* kgain = nullptr) {
    const int nblk = N / 32, kb = item / nblk, nb = item % nblk, k0 = 64 * kb, n0 = 32 * nb;
#pragma unroll 8
    for (int i = 0; i < 32; ++i) { const int kk = 2 * i + (lane >> 5); const float gk = kgain ? kgain[k0 + kk] : 1.0f; scr[kk * 33 + (lane & 31)] = W[(size_t)(k0 + kk) * N + n0 + (lane & 31)] * gk; }
    LDS_WAIT(); asm volatile("" ::: "memory");
    const int c = lane & 7;
#pragma unroll
    for (int j = 0; j < 4; ++j) { const int n = (lane >> 3) + 8 * j; const LAS float* s = scr + (8 * c) * 33 + n;
        v4u o; o.x = pk2(s[0 * 33], s[1 * 33]); o.y = pk2(s[2 * 33], s[3 * 33]); o.z = pk2(s[4 * 33], s[5 * 33]); o.w = pk2(s[6 * 33], s[7 * 33]);
        *(GAS v4u*)(WT + (size_t)(n0 + n) * K + k0 + 8 * c) = o; }
    LDS_WAIT(); asm volatile("" ::: "memory");
}
__device__ __forceinline__ void rms_row_to_bf16(const float* xrow, const float* g, bf16* orow, int lane) {
    const GAS f32x4* xr = (const GAS f32x4*)xrow + lane;
    f32x4 v[4]; float s = 0.f;
#pragma unroll
    for (int j = 0; j < 4; ++j) { v[j] = xr[64 * j]; s += (v[j].x * v[j].x + v[j].y * v[j].y) + (v[j].z * v[j].z + v[j].w * v[j].w); }
    const float rs = 1.0f / sqrtf(wave_sum(s) * (1.f / 1024.f) + EPS);
    GAS unsigned long long* o8 = (GAS unsigned long long*)orow + lane;
#pragma unroll
    for (int j = 0; j < 4; ++j) { const f32x4 gg = ((const GAS f32x4*)g)[lane + 64 * j];
        o8[64 * j] = (unsigned long long)pk2(v[j].x * rs * gg.x, v[j].y * rs * gg.y) | ((unsigned long long)pk2(v[j].z * rs * gg.z, v[j].w * rs * gg.w) << 32); }
}
__device__ __forceinline__ const float* x_row_ptr(const Frame& F, int r) {
    return r < MP ? F.in[I_XP] + (size_t)r * D : (r < MR ? F.in[I_XS] + (size_t)(r - MP) * D : F.in[I_META] + (size_t)(r - MR) * D);
}
__device__ __forceinline__ void rms_rows4_to_bf16(const Frame& F, int m0, const float* g, bf16* XN, int lane) {
    f32x4 v[4][4]; float s[4];
#pragma unroll
    for (int q = 0; q < 4; ++q) { const GAS f32x4* xr = (const GAS f32x4*)x_row_ptr(F, m0 + q) + lane;
#pragma unroll
        for (int j = 0; j < 4; ++j) v[q][j] = xr[64 * j]; }
#pragma unroll
    for (int q = 0; q < 4; ++q) { float a = 0.f;
#pragma unroll
        for (int j = 0; j < 4; ++j) a += (v[q][j].x * v[q][j].x + v[q][j].y * v[q][j].y) + (v[q][j].z * v[q][j].z + v[q][j].w * v[q][j].w);
        s[q] = a; }
#pragma unroll
    for (int o = 1; o < 64; o <<= 1) {
#pragma unroll
        for (int q = 0; q < 4; ++q) s[q] += __shfl_xor(s[q], o); }
#pragma unroll
    for (int j = 0; j < 4; ++j) { const f32x4 gg = ((const GAS f32x4*)g)[lane + 64 * j];
#pragma unroll
        for (int q = 0; q < 4; ++q) { const float rs = 1.0f / sqrtf(s[q] * (1.f / 1024.f) + EPS);
            GAS unsigned long long* o8 = (GAS unsigned long long*)(XN + (size_t)(m0 + q) * D) + lane;
            o8[64 * j] = (unsigned long long)pk2(v[q][j].x * rs * gg.x, v[q][j].y * rs * gg.y) | ((unsigned long long)pk2(v[q][j].z * rs * gg.z, v[q][j].w * rs * gg.w) << 32); } }
}
constexpr int I_IN = (D / 64) * (DIN / 32), I_GL = (SW / 64) * (SW / 32), I_OU = (D / 64) * (D / 32), I_UP = (D / 64) * (DFF / 32), I_DN = (DFF / 64) * (D / 32);
__device__ __forceinline__ void p0_prologue(Frame& F) {
    LAS float* scr = (LAS float*)(F.lds + F.wave * 16384);
    const int gw = F.vcu * NWAVES + F.wave, NGW = F.G * NWAVES;
    bf16* XN = (bf16*)(F.ws + WS_XN);
    for (int it = NGW - 1 - gw; it < I_IN; it += NGW) p0_transpose_item(F.in[I_WIN], D, DIN, (bf16*)(F.ws + WS_WIN), scr, it, F.lane);
    for (int m4 = gw; m4 < MIN_ROWS / 4; m4 += NGW) {
        const int m = 4 * m4;
        if (m < MR + NMETA) rms_rows4_to_bf16(F, m, F.in[I_GPRE], XN, F.lane);
        else { for (int q = 0; q < 4; ++q) { GAS unsigned long long* o8 = (GAS unsigned long long*)(XN + (size_t)(m + q) * D) + F.lane;
#pragma unroll
            for (int j = 0; j < 4; ++j) o8[64 * j] = 0ull; } }
    }
    const int gt = F.vcu * (NWAVES * 64) + F.tid, NT = F.G * NWAVES * 64;
    float* ropeC = (float*)(F.ws + WS_ROPEC); float* ropeS = (float*)(F.ws + WS_ROPES);
    for (int i = gt; i < NPOS * 8; i += NT) {
        const int idx = i >> 3, fi = i & 7; const int pos = idx < 4112 ? idx : 8192 + (idx - 4112);
        const float inv = (float)exp_d(-(double)fi * 1.640295422175541);
        const float ang = (float)pos * inv;
        double s, c; sincos_d((double)ang, s, c);
        ropeC[i] = (float)c; ropeS[i] = (float)s;
    }
    float* abr = (float*)(F.ws + WS_ABR); float* abi = (float*)(F.ws + WS_ABI); float* bbr = (float*)(F.ws + WS_BBR); float* bbi = (float*)(F.ws + WS_BBI);
    for (int i = gt; i < 2048; i += NT) {
        const int g = i >> 6;
        const double dt = exp_d((double)F.in[I_LDT][g]); const double ar = (double)F.in[I_ARE][i], ai = (double)F.in[I_AIM][i];
        const double mag = exp_d(ar * dt); double s, c; sincos_d(ai * dt, s, c);
        const double are = mag * c, aim = mag * s;
        const double nr = are - 1.0, ni = aim, den = ar * ar + ai * ai;
        const double cr = (nr * ar + ni * ai) / den, ci = (ni * ar - nr * ai) / den;
        abr[i] = (float)are; abi[i] = (float)aim;
        f32x4 vb[4], wb[4];
#pragma unroll
        for (int q = 0; q < 4; ++q) { vb[q] = ((const f32x4*)(F.in[I_BRE] + i * 16))[q]; wb[q] = ((const f32x4*)(F.in[I_BIM] + i * 16))[q]; }
        const float crf = (float)cr, cif = (float)ci;
#pragma unroll
        for (int q = 0; q < 4; ++q) { ((f32x4*)(bbr + i * 16))[q] = vb[q] * crf - wb[q] * cif; ((f32x4*)(bbi + i * 16))[q] = wb[q] * crf + vb[q] * cif; }
    }
}
__device__ __forceinline__ void p4_late_weights(Frame& F, int wi, int nw, int first, int last) {
    LAS float* scr = (LAS float*)(F.lds + F.wave * 16384);
    for (int it = first + wi; it < last; it += nw) {
        int r = it;
        if (r < I_GL) { p0_transpose_item(F.in[I_WGLU], SW, SW, (bf16*)(F.ws + WS_WGLU), scr, r, F.lane); continue; } r -= I_GL;
        if (r < I_OU) { const int kb = r / (D / 32);
            p0_transpose_item(F.in[I_WOUT], D, D, (bf16*)(F.ws + WS_WOUT), scr, r, F.lane, kb < 8 ? F.in[I_GATT] : F.in[I_GSSM] - 512); continue; } r -= I_OU;
        if (r < I_UP) { p0_transpose_item(F.in[I_WUP], D, DFF, (bf16*)(F.ws + WS_WUP), scr, r, F.lane); continue; } r -= I_UP;
        p0_transpose_item(F.in[I_WDN], DFF, D, (bf16*)(F.ws + WS_WDN), scr, r, F.lane);
    }
}
__device__ __forceinline__ int pos_index(int r) { return r < MP ? (r & 4095) + 16 : (r < MR ? 4112 + ((r - MP) & 3) : r - MR); }
__device__ __forceinline__ void p2_rope(Frame& F) {
    const int gt = F.vcu * (NWAVES * 64) + F.tid, NT = F.G * NWAVES * 64;
    bf16* P = (bf16*)(F.ws + WS_P); const float* ropeC = (const float*)(F.ws + WS_ROPEC); const float* ropeS = (const float*)(F.ws + WS_ROPES);
    for (int it = gt; it < (MR + NMETA) * 80; it += NT) {
        const int r = it / 80, rem = it - r * 80, hh = rem >> 3, fi = rem & 7;
        bf16* p = P + (size_t)r * DIN + hh * 64 + fi;
        const float x1 = bf1(p[0]), x2 = bf1(p[8]);
        const int pi = pos_index(r) * 8 + fi; const float c = ropeC[pi], s = ropeS[pi];
        p[0] = (bf16)f2bf(x1 * c - x2 * s); p[8] = (bf16)f2bf(x2 * c + x1 * s);
    }
}
__device__ __forceinline__ void p3_ssm_naive(Frame& F) {
    LAS float* hs = (LAS float*)(F.lds + F.wave * 16384);
    const int gw = F.vcu * NWAVES + F.wave, NGW = F.G * NWAVES, lane = F.lane;
    const bf16* P = (const bf16*)(F.ws + WS_P); bf16* Z = (bf16*)(F.ws + WS_Z);
    const float* abr = (const float*)(F.ws + WS_ABR); const float* abi = (const float*)(F.ws + WS_ABI); const float* bbr = (const float*)(F.ws + WS_BBR); const float* bbi = (const float*)(F.ws + WS_BBI);
    for (int task = gw; task < (4 + 128) * 32; task += NGW) {
        const int seq = task >> 5, g = task & 31, gp = g * 64 + lane;
        const float are = abr[gp], aim = abi[gp];
        float br[16], bi[16];
#pragma unroll
        for (int h = 0; h < 16; ++h) { br[h] = bbr[gp * 16 + h]; bi[h] = bbi[gp * 16 + h]; }
        const int ho = lane & 15, qq = lane >> 4;
        float cr[16], ci[16];
#pragma unroll
        for (int j = 0; j < 16; ++j) { cr[j] = F.in[I_CRE][(g * 16 + ho) * 64 + qq * 16 + j]; ci[j] = F.in[I_CIM][(g * 16 + ho) * 64 + qq * 16 + j]; }
        const float dd = F.in[I_DD][g * 16 + ho];
        float hr, hi; int nsteps;
        if (seq < 4) { hr = 0.f; hi = 0.f; nsteps = 4112; }
        else { const int db = seq - 4; hr = F.in[I_SRE][(db * 32 + g) * 64 + lane]; hi = F.in[I_SIM][(db * 32 + g) * 64 + lane]; nsteps = 4; }
        for (int st = 0; st < nsteps; ++st) {
            int row; bool wr_out;
            if (seq < 4) { if (st < 16) { row = MR + st; wr_out = false; } else { row = seq * 4096 + st - 16; wr_out = true; } }
            else { row = MP + (seq - 4) * 4 + st; wr_out = true; }
            const v4u* up = (const v4u*)(P + (size_t)row * DIN + 768 + g * 16);
            const v4u u0 = up[0], u1 = up[1];
            float u[16];
            u[0] = bflo(u0.x); u[1] = bfhi(u0.x); u[2] = bflo(u0.y); u[3] = bfhi(u0.y); u[4] = bflo(u0.z); u[5] = bfhi(u0.z); u[6] = bflo(u0.w); u[7] = bfhi(u0.w);
            u[8] = bflo(u1.x); u[9] = bfhi(u1.x); u[10] = bflo(u1.y); u[11] = bfhi(u1.y); u[12] = bflo(u1.z); u[13] = bfhi(u1.z); u[14] = bflo(u1.w); u[15] = bfhi(u1.w);
            float bur = 0.f, bui = 0.f;
#pragma unroll
            for (int h = 0; h < 16; ++h) { bur += br[h] * u[h]; bui += bi[h] * u[h]; }
            const float nhr = are * hr - aim * hi + bur, nhi = are * hi + aim * hr + bui;
            hr = nhr; hi = nhi;
            if (wr_out) {
                hs[lane] = hr; hs[64 + lane] = hi;
                LDS_WAIT(); asm volatile("" ::: "memory");
                float y = 0.f;
#pragma unroll
                for (int j = 0; j < 16; ++j) y += cr[j] * hs[qq * 16 + j] - ci[j] * hs[64 + qq * 16 + j];
                y += __shfl_xor(y, 16); y += __shfl_xor(y, 32);
                float uo = u[0];
#pragma unroll
                for (int h = 1; h < 16; ++h) uo = (ho == h) ? u[h] : uo;
                y += dd * uo;
                const float z = gelu_tanh(y);
                if (lane < 16) Z[(size_t)row * SW + g * 16 + ho] = (bf16)f2bf(z);
                LDS_WAIT(); asm volatile("" ::: "memory");
            }
        }
        if (seq < 4) { F.out[O_SRP + (seq * 32 + g) * 64 + lane] = hr; F.out[O_SIP + (seq * 32 + g) * 64 + lane] = hi; }
        else { F.out[O_SRS + ((seq - 4) * 32 + g) * 64 + lane] = hr; F.out[O_SIS + ((seq - 4) * 32 + g) * 64 + lane] = hi; }
    }
}
__device__ __forceinline__ float dot64_bf16(const LAS float* qf, const bf16* kp) {
    float s = 0.f;
#pragma unroll 2
    for (int i = 0; i < 8; ++i) { const v4u k = ((const v4u*)kp)[i]; const f32x4 a = ((const LAS f32x4*)qf)[2 * i], b = ((const LAS f32x4*)qf)[2 * i + 1];
        s += a.x * bflo(k.x) + a.y * bfhi(k.x) + a.z * bflo(k.y) + a.w * bfhi(k.y) + b.x * bflo(k.z) + b.y * bfhi(k.z) + b.z * bflo(k.w) + b.w * bfhi(k.w); }
    return s;
}
__device__ __forceinline__ float dot64_f32(const LAS float* qf, const float* kp) {
    float s = 0.f;
#pragma unroll 2
    for (int i = 0; i < 16; ++i) { const f32x4 k = ((const f32x4*)kp)[i]; const f32x4 a = ((const LAS f32x4*)qf)[i];
        s += a.x * k.x + a.y * k.y + a.z * k.z + a.w * k.w; }
    return s;
}
__device__ __forceinline__ void p3_attn_naive(Frame& F) {
    LAS float* pw = (LAS float*)(F.lds + F.wave * 16384 + 1024);
    LAS float* qf = (LAS float*)(F.lds + F.wave * 16384 + 2048);
    const int gw = F.vcu * NWAVES + F.wave, NGW = F.G * NWAVES, lane = F.lane;
    const bf16* P = (const bf16*)(F.ws + WS_P); bf16* ATT = (bf16*)(F.ws + WS_ATT);
    const float NEG = -1e30f;
#pragma unroll 1
    for (int task = gw; task < MR * 8; task += NGW) {
        const int r = task >> 3, h = task & 7, kvh = h >> 2;
        qf[lane] = bf1(P[(size_t)r * DIN + h * 64 + lane]);
        LDS_WAIT(); asm volatile("" ::: "memory");
        const float sink = F.in[I_SINK][h];
        float l0, l1, l2 = NEG; bool v0, v1, v2 = false;
        if (r < MP) {
            const int b = r >> 12, s = r & 4095, pos = s + 16;
            const int kp0 = pos - 127 + lane, kp1 = kp0 + 64;
            v0 = kp0 >= 0; v1 = kp1 >= 0;
            const int kr0 = kp0 >= 16 ? b * 4096 + kp0 - 16 : MR + (kp0 < 0 ? 0 : kp0);
            const int kr1 = kp1 >= 16 ? b * 4096 + kp1 - 16 : MR + (kp1 < 0 ? 0 : kp1);
            l0 = dot64_bf16(qf, P + (size_t)kr0 * DIN + 512 + kvh * 64) * 0.125f;
            l1 = dot64_bf16(qf, P + (size_t)kr1 * DIN + 512 + kvh * 64) * 0.125f;
        } else {
            const int db = (r - MP) >> 2, t = (r - MP) & 3;
            v0 = lane >= t + 1; v1 = true;
            l0 = dot64_f32(qf, F.in[I_CK] + ((size_t)(db * 128 + lane) * 2 + kvh) * 64) * 0.125f;
            l1 = dot64_f32(qf, F.in[I_CK] + ((size_t)(db * 128 + lane + 64) * 2 + kvh) * 64) * 0.125f;
            v2 = lane <= t;
            const int tr = lane < 4 ? lane : 0;
            l2 = dot64_bf16(qf, P + (size_t)(MP + db * 4 + tr) * DIN + 512 + kvh * 64) * 0.125f;
        }
        l0 = v0 ? l0 : NEG; l1 = v1 ? l1 : NEG; l2 = v2 ? l2 : NEG;
        float m = wave_max(fmaxf(fmaxf(l0, l1), l2)); m = fmaxf(m, sink);
        const float e0 = v0 ? __expf(l0 - m) : 0.f, e1 = v1 ? __expf(l1 - m) : 0.f, e2 = v2 ? __expf(l2 - m) : 0.f;
        const float den = wave_sum(e0 + e1 + e2) + __expf(sink - m);
        const float inv = 1.0f / den;
        pw[lane] = e0 * inv; pw[64 + lane] = e1 * inv; pw[128 + lane] = e2 * inv;
        LDS_WAIT(); asm volatile("" ::: "memory");
        float o = 0.f;
        if (r < MP) {
            const int b = r >> 12, s = r & 4095, pos = s + 16;
#pragma unroll 1
            for (int j = 0; j < 128; ++j) { const int kp = pos - 127 + j; if (kp < 0) continue;
                const int kr = kp >= 16 ? b * 4096 + kp - 16 : MR + kp;
                o += pw[j] * bf1(P[(size_t)kr * DIN + 640 + kvh * 64 + lane]); }
        } else {
            const int db = (r - MP) >> 2, t = (r - MP) & 3;
#pragma unroll 1
            for (int j = t + 1; j < 128; ++j) o += pw[j] * F.in[I_CV][((size_t)(db * 128 + j) * 2 + kvh) * 64 + lane];
#pragma unroll 1
            for (int j = 0; j <= t; ++j) o += pw[128 + j] * bf1(P[(size_t)(MP + db * 4 + j) * DIN + 640 + kvh * 64 + lane]);
        }
        ATT[(size_t)r * AW + h * 64 + lane] = (bf16)f2bf(o);
        LDS_WAIT(); asm volatile("" ::: "memory");
    }
}
__device__ __forceinline__ void unpack8(const v4u w, float (&f)[8]) { f[0] = bflo(w.x); f[1] = bfhi(w.x); f[2] = bflo(w.y); f[3] = bfhi(w.y); f[4] = bflo(w.z); f[5] = bfhi(w.z); f[6] = bflo(w.w); f[7] = bfhi(w.w); }
__device__ __forceinline__ v4u pack8(const float (&f)[8]) { v4u w; w.x = pk2(f[0], f[1]); w.y = pk2(f[2], f[3]); w.z = pk2(f[4], f[5]); w.w = pk2(f[6], f[7]); return w; }
__device__ __forceinline__ void p3_windows(Frame& F) {
    const int gt = F.vcu * (NWAVES * 64) + F.tid, NT = F.G * NWAVES * 64;
    const bf16* P = (const bf16*)(F.ws + WS_P);
    constexpr int NQ = 128 * 3968;
#pragma unroll 1
    for (int q0 = gt; q0 < 2 * NQ; q0 += 4 * NT) {
        f32x4 v[4];
#pragma unroll
        for (int u = 0; u < 4; ++u) { const int q = q0 + u * NT; if (q < 2 * NQ) { const int t = q >= NQ ? 1 : 0, qq = q - t * NQ, db = qq / 3968, off = qq - db * 3968;
            v[u] = *(const f32x4*)((t ? F.in[I_CV] : F.in[I_CK]) + (size_t)db * 16384 + 512 + off * 4); } }
#pragma unroll
        for (int u = 0; u < 4; ++u) { const int q = q0 + u * NT; if (q < 2 * NQ) { const int t = q >= NQ ? 1 : 0, qq = q - t * NQ, db = qq / 3968, off = qq - db * 3968;
            *(f32x4*)(F.out + (t ? O_VS : O_KS) + (size_t)db * 16384 + off * 4) = v[u]; } }
    }
    for (int c = gt; c < 16384; c += NT) {
        int row; size_t dk, dv; const int ch = c & 15;
        if (c < 8192) { const int b = c >> 11, j = (c >> 4) & 127; row = b * 4096 + 3968 + j; dk = O_KP + (size_t)(b * 128 + j) * 128 + ch * 8; dv = dk + (O_VP - O_KP); }
        else { const int c2 = c - 8192, db = c2 >> 6, t = (c2 >> 4) & 3; row = MP + db * 4 + t; dk = O_KS + (size_t)(db * 128 + 124 + t) * 128 + ch * 8; dv = dk + (O_VS - O_KS); }
        float k[8], v[8];
        { v4u kw = *(const v4u*)(P + (size_t)row * DIN + 512 + ch * 8);
          v4u pw; pw.x = __shfl_xor(kw.x, 1); pw.y = __shfl_xor(kw.y, 1); pw.z = __shfl_xor(kw.z, 1); pw.w = __shfl_xor(kw.w, 1);
          if ((ch & 7) < 2) { const int pidx = pos_index(row); float a[8], bq[8]; unpack8(kw, a); unpack8(pw, bq);
              const float* c8 = (const float*)(F.ws + WS_ROPEC) + pidx * 8; const float* s8 = (const float*)(F.ws + WS_ROPES) + pidx * 8;
#pragma unroll
              for (int e = 0; e < 8; ++e) k[e] = (ch & 1) ? (a[e] * c8[e] + bq[e] * s8[e]) : (a[e] * c8[e] - bq[e] * s8[e]); }
          else unpack8(kw, k); }
        unpack8(*(const v4u*)(P + (size_t)row * DIN + 640 + ch * 8), v);
        *(f32x4*)(F.out + dk) = (f32x4){k[0], k[1], k[2], k[3]}; *(f32x4*)(F.out + dk + 4) = (f32x4){k[4], k[5], k[6], k[7]};
        *(f32x4*)(F.out + dv) = (f32x4){v[0], v[1], v[2], v[3]}; *(f32x4*)(F.out + dv + 4) = (f32x4){v[4], v[5], v[6], v[7]};
    }
}
__device__ __forceinline__ void p5_mixnorm(Frame& F) {
    const int gw = F.vcu * NWAVES + F.wave, NGW = F.G * NWAVES, lane = F.lane;
    const bf16* ATT = (const bf16*)(F.ws + WS_ATT); const bf16* Z = (const bf16*)(F.ws + WS_Z); const bf16* GL = (const bf16*)(F.ws + WS_GL); bf16* CAT = (bf16*)(F.ws + WS_CAT);
    for (int r = gw; r < MR; r += NGW) {
        float a[8], z[8], gt[8], o[8];
        unpack8(*(const v4u*)(ATT + (size_t)r * AW + lane * 8), a); unpack8(*(const v4u*)(Z + (size_t)r * SW + lane * 8), z); unpack8(*(const v4u*)(GL + (size_t)r * SW + lane * 8), gt);
        float sa = 0.f, so = 0.f;
#pragma unroll
        for (int i = 0; i < 8; ++i) { o[i] = z[i] * sigmoidf_(gt[i]); sa += a[i] * a[i]; so += o[i] * o[i]; }
        const float ra = 1.0f / sqrtf(wave_sum(sa) * (1.f / 512.f) + EPS), ro = 1.0f / sqrtf(wave_sum(so) * (1.f / 512.f) + EPS);
#pragma unroll
        for (int i = 0; i < 8; ++i) { a[i] = a[i] * ra * F.in[I_GATT][lane * 8 + i]; o[i] = o[i] * ro * F.in[I_GSSM][lane * 8 + i]; }
        *(v4u*)(CAT + (size_t)r * D + lane * 8) = pack8(a); *(v4u*)(CAT + (size_t)r * D + 512 + lane * 8) = pack8(o);
    }
}
__device__ __forceinline__ void p7_mid(Frame& F) {
    const int gw = F.vcu * NWAVES + F.wave, NGW = F.G * NWAVES, lane = F.lane;
    const bf16* O1 = (const bf16*)(F.ws + WS_O); bf16* XN2 = (bf16*)(F.ws + WS_XN);
    float gp[16], gm[16];
#pragma unroll
    for (int hf = 0; hf < 2; ++hf) { const f32x4 a = *(const f32x4*)(F.in[I_GPOST] + hf * 512 + lane * 8), b = *(const f32x4*)(F.in[I_GPOST] + hf * 512 + lane * 8 + 4);
        const f32x4 c = *(const f32x4*)(F.in[I_GMLP] + hf * 512 + lane * 8), d = *(const f32x4*)(F.in[I_GMLP] + hf * 512 + lane * 8 + 4);
        gp[hf * 8 + 0] = a.x; gp[hf * 8 + 1] = a.y; gp[hf * 8 + 2] = a.z; gp[hf * 8 + 3] = a.w; gp[hf * 8 + 4] = b.x; gp[hf * 8 + 5] = b.y; gp[hf * 8 + 6] = b.z; gp[hf * 8 + 7] = b.w;
        gm[hf * 8 + 0] = c.x; gm[hf * 8 + 1] = c.y; gm[hf * 8 + 2] = c.z; gm[hf * 8 + 3] = c.w; gm[hf * 8 + 4] = d.x; gm[hf * 8 + 5] = d.y; gm[hf * 8 + 6] = d.z; gm[hf * 8 + 7] = d.w; }
    constexpr int NR = 3;
#pragma unroll 1
    for (int r0 = NR * gw; r0 < MR; r0 += NR * NGW) {
        v4u ow[NR][2]; f32x4 xw[NR][4];
#pragma unroll
        for (int q = 0; q < NR; ++q) { const int r = r0 + q; ow[q][0] = *(const v4u*)(O1 + (size_t)r * D + lane * 8); ow[q][1] = *(const v4u*)(O1 + (size_t)r * D + 512 + lane * 8);
            const float* xr = x_row_ptr(F, r);
            xw[q][0] = *(const f32x4*)(xr + lane * 8); xw[q][1] = *(const f32x4*)(xr + lane * 8 + 4); xw[q][2] = *(const f32x4*)(xr + 512 + lane * 8); xw[q][3] = *(const f32x4*)(xr + 512 + lane * 8 + 4); }
#pragma unroll
        for (int q = 0; q < NR; ++q) { const int r = r0 + q;
            float o[16], x[16];
            { float t[8]; unpack8(ow[q][0], t);
#pragma unroll
              for (int i = 0; i < 8; ++i) o[i] = t[i];
              unpack8(ow[q][1], t);
#pragma unroll
              for (int i = 0; i < 8; ++i) o[8 + i] = t[i]; }
#pragma unroll
            for (int hf = 0; hf < 2; ++hf) { const f32x4 a = xw[q][2 * hf], b = xw[q][2 * hf + 1];
                x[hf * 8 + 0] = a.x; x[hf * 8 + 1] = a.y; x[hf * 8 + 2] = a.z; x[hf * 8 + 3] = a.w; x[hf * 8 + 4] = b.x; x[hf * 8 + 5] = b.y; x[hf * 8 + 6] = b.z; x[hf * 8 + 7] = b.w; }
            float ss = 0.f;
#pragma unroll
            for (int i = 0; i < 16; ++i) ss += o[i] * o[i];
            const float r1 = 1.0f / sqrtf(wave_sum(ss) * (1.f / 1024.f) + EPS);
            float s2 = 0.f;
#pragma unroll
            for (int i = 0; i < 16; ++i) { x[i] = x[i] + o[i] * r1 * gp[i]; s2 += x[i] * x[i]; }
            const float r2 = 1.0f / sqrtf(wave_sum(s2) * (1.f / 1024.f) + EPS);
            float* yo = F.out + (size_t)r * D;
#pragma unroll
            for (int hf = 0; hf < 2; ++hf) {
                { float hb[8];
#pragma unroll
                  for (int i = 0; i < 8; ++i) hb[i] = x[hf * 8 + i];
                  *(v4u*)((bf16*)yo + hf * 512 + lane * 8) = pack8(hb); }
                float n[8];
#pragma unroll
                for (int i = 0; i < 8; ++i) n[i] = x[hf * 8 + i] * r2 * gm[hf * 8 + i];
                *(v4u*)(XN2 + (size_t)r * D + hf * 512 + lane * 8) = pack8(n);
            }
        }
    }
}
__device__ __forceinline__ void final_row(const float (&o)[16], const float (&hp)[16], const float (&g)[16], float* yo, int lane) {
    float ss = 0.f;
#pragma unroll
    for (int i = 0; i < 16; ++i) ss += o[i] * o[i];
    const float r1 = 1.0f / sqrtf(wave_sum(ss) * (1.f / 1024.f) + EPS);
#pragma unroll
    for (int hf = 0; hf < 2; ++hf) {
        f32x4 a, b;
        a.x = hp[hf * 8 + 0] + o[hf * 8 + 0] * r1 * g[hf * 8 + 0]; a.y = hp[hf * 8 + 1] + o[hf * 8 + 1] * r1 * g[hf * 8 + 1]; a.z = hp[hf * 8 + 2] + o[hf * 8 + 2] * r1 * g[hf * 8 + 2]; a.w = hp[hf * 8 + 3] + o[hf * 8 + 3] * r1 * g[hf * 8 + 3];
        b.x = hp[hf * 8 + 4] + o[hf * 8 + 4] * r1 * g[hf * 8 + 4]; b.y = hp[hf * 8 + 5] + o[hf * 8 + 5] * r1 * g[hf * 8 + 5]; b.z = hp[hf * 8 + 6] + o[hf * 8 + 6] * r1 * g[hf * 8 + 6]; b.w = hp[hf * 8 + 7] + o[hf * 8 + 7] * r1 * g[hf * 8 + 7];
        *(f32x4*)(yo + hf * 512 + lane * 8) = a; *(f32x4*)(yo + hf * 512 + lane * 8 + 4) = b;
    }
}
__device__ __forceinline__ void p10_final(Frame& F) {
    const int gw = F.vcu * NWAVES + F.wave, NGW = F.G * NWAVES, lane = F.lane;
    const bf16* O2 = (const bf16*)(F.ws + WS_O);
    float g[16];
#pragma unroll
    for (int hf = 0; hf < 2; ++hf) { const f32x4 a = *(const f32x4*)(F.in[I_GMLPP] + hf * 512 + lane * 8), b = *(const f32x4*)(F.in[I_GMLPP] + hf * 512 + lane * 8 + 4);
        g[hf * 8 + 0] = a.x; g[hf * 8 + 1] = a.y; g[hf * 8 + 2] = a.z; g[hf * 8 + 3] = a.w; g[hf * 8 + 4] = b.x; g[hf * 8 + 5] = b.y; g[hf * 8 + 6] = b.z; g[hf * 8 + 7] = b.w; }
    constexpr int NR = 4;
#pragma unroll 1
    for (int r0 = NR * gw; r0 < MP; r0 += NR * NGW) {
        v4u ow[NR][2], hw[NR][2];
#pragma unroll
        for (int q = 0; q < NR; ++q) { const int r = r0 + q; ow[q][0] = *(const v4u*)(O2 + (size_t)r * D + lane * 8); ow[q][1] = *(const v4u*)(O2 + (size_t)r * D + 512 + lane * 8);
            const bf16* hb = (const bf16*)(F.out + (size_t)r * D); hw[q][0] = *(const v4u*)(hb + lane * 8); hw[q][1] = *(const v4u*)(hb + 512 + lane * 8); }
        asm volatile("s_waitcnt vmcnt(0)" ::: "memory");
#pragma unroll
        for (int q = 0; q < NR; ++q) { float o[16], hp[16], t[8];
            unpack8(ow[q][0], t);
#pragma unroll
            for (int i = 0; i < 8; ++i) o[i] = t[i];
            unpack8(ow[q][1], t);
#pragma unroll
            for (int i = 0; i < 8; ++i) o[8 + i] = t[i];
            unpack8(hw[q][0], t);
#pragma unroll
            for (int i = 0; i < 8; ++i) hp[i] = t[i];
            unpack8(hw[q][1], t);
#pragma unroll
            for (int i = 0; i < 8; ++i) hp[8 + i] = t[i];
            final_row(o, hp, g, F.out + (size_t)(r0 + q) * D, lane); }
    }
    for (int r = MP + gw; r < MR; r += NGW) {
        float o[16], hp[16];
        const float* sl = (const float*)(F.ws + WS_XN) + (size_t)(r - MP) * D + lane * 8;
        f32x4 sv[8][4];
#pragma unroll
        for (int kq = 0; kq < 8; ++kq) { sv[kq][0] = *(const f32x4*)(sl + (size_t)kq * MS * D); sv[kq][1] = *(const f32x4*)(sl + (size_t)kq * MS * D + 4); sv[kq][2] = *(const f32x4*)(sl + (size_t)kq * MS * D + 512); sv[kq][3] = *(const f32x4*)(sl + (size_t)kq * MS * D + 516); }
        float* yo = F.out + (size_t)r * D;
        { float t[8]; unpack8(*(const v4u*)((const bf16*)yo + lane * 8), t);
#pragma unroll
          for (int i = 0; i < 8; ++i) hp[i] = t[i];
          unpack8(*(const v4u*)((const bf16*)yo + 512 + lane * 8), t);
#pragma unroll
          for (int i = 0; i < 8; ++i) hp[8 + i] = t[i]; }
        asm volatile("s_waitcnt vmcnt(0)" ::: "memory");
#pragma unroll
        for (int i = 0; i < 16; ++i) o[i] = 0.f;
#pragma unroll
        for (int kq = 0; kq < 8; ++kq)
#pragma unroll
            for (int hf = 0; hf < 2; ++hf) { const f32x4 a = sv[kq][2 * hf], b = sv[kq][2 * hf + 1];
                o[hf * 8 + 0] += a.x; o[hf * 8 + 1] += a.y; o[hf * 8 + 2] += a.z; o[hf * 8 + 3] += a.w; o[hf * 8 + 4] += b.x; o[hf * 8 + 5] += b.y; o[hf * 8 + 6] += b.z; o[hf * 8 + 7] += b.w; }
        final_row(o, hp, g, yo, lane);
    }
}
typedef short bf16x8 __attribute__((ext_vector_type(8)));
constexpr int KC_PER_G = 33 * 256;
struct ZohD { double adt_r, adt_i, cr, ci; };
__device__ __forceinline__ ZohD zoh_d(const Frame& F, int gp) {
    const int g = gp >> 6;
    const double dt = exp_d((double)F.in[I_LDT][g]); const double ar = (double)F.in[I_ARE][gp], ai = (double)F.in[I_AIM][gp];
    ZohD z; z.adt_r = ar * dt; z.adt_i = ai * dt;
    const double mag = exp_d(z.adt_r); double s, c; sincos_d(z.adt_i, s, c);
    const double nr = mag * c - 1.0, ni = mag * s, den = ar * ar + ai * ai;
    z.cr = (nr * ar + ni * ai) / den; z.ci = (ni * ar - nr * ai) / den; return z;
}
__device__ __forceinline__ void abar_pow(const ZohD& z, int m, double& wr, double& wi) { const double mag = exp_d(z.adt_r * (double)m); double s, c; sincos_d(z.adt_i * (double)m, s, c); wr = mag * c; wi = mag * s; }

__device__ __forceinline__ void p0_ssm_pow(Frame& F) {
    const int gt = F.vcu * (NWAVES * 64) + F.tid, NT = F.G * NWAVES * 64;
    float* POW = (float*)(F.ws + WS_POW); float* COEF = (float*)(F.ws + WS_COEF); float* A32 = (float*)(F.ws + WS_A32);
    for (int it = gt; it < 2048 * 33; it += NT) { const int gp = it / 33, tau = it - gp * 33;
        const ZohD z = zoh_d(F, gp); double wr, wi; abar_pow(z, tau, wr, wi);
        POW[2 * it] = (float)wr; POW[2 * it + 1] = (float)wi;
        if (tau == 32) { A32[2 * gp] = (float)wr; A32[2 * gp + 1] = (float)wi; }
        if (tau == 0) { COEF[2 * gp] = (float)z.cr; COEF[2 * gp + 1] = (float)z.ci; } }
}
__device__ __forceinline__ void p1_vt(Frame& F, int bi, int nb) {
    const int gt = bi * (NWAVES * 64) + F.tid, NT = nb * NWAVES * 64;
    bf16* VT = (bf16*)(F.ws + WS_VT); bf16* QT = (bf16*)(F.ws + WS_QT); bf16* KC = (bf16*)(F.ws + WS_KC);
    const float* POW = (const float*)(F.ws + WS_POW); const float* COEF = (const float*)(F.ws + WS_COEF);
    for (int it = gt; it < 65536; it += NT) {
        const int gp = it >> 5, s = it & 31, g = gp >> 6, p = gp & 63;
        const float wr = POW[2 * (gp * 33 + 31 - s)], wi = POW[2 * (gp * 33 + 31 - s) + 1], cr = COEF[2 * gp], ci = COEF[2 * gp + 1];
        const float er = wr * cr - wi * ci, ei = wr * ci + wi * cr;
        float re[16], im[16];
#pragma unroll
        for (int h = 0; h < 16; ++h) { const float br = F.in[I_BRE][gp * 16 + h], bi_ = F.in[I_BIM][gp * 16 + h]; re[h] = er * br - ei * bi_; im[h] = er * bi_ + ei * br; }
        bf16* d0 = VT + (size_t)g * 65536 + (size_t)(2 * p) * 512 + 16 * s; bf16* d1 = d0 + 512;
        v4u w;
        w.x = pk2(re[0], re[1]); w.y = pk2(re[2], re[3]); w.z = pk2(re[4], re[5]); w.w = pk2(re[6], re[7]); ((v4u*)d0)[0] = w;
        w.x = pk2(re[8], re[9]); w.y = pk2(re[10], re[11]); w.z = pk2(re[12], re[13]); w.w = pk2(re[14], re[15]); ((v4u*)d0)[1] = w;
        w.x = pk2(im[0], im[1]); w.y = pk2(im[2], im[3]); w.z = pk2(im[4], im[5]); w.w = pk2(im[6], im[7]); ((v4u*)d1)[0] = w;
        w.x = pk2(im[8], im[9]); w.y = pk2(im[10], im[11]); w.z = pk2(im[12], im[13]); w.w = pk2(im[14], im[15]); ((v4u*)d1)[1] = w;
    }
}
__device__ __forceinline__ void p4_qt_kc(Frame& F, int bi, int nb) {
    const int gt = bi * (NWAVES * 64) + F.tid, NT = nb * NWAVES * 64;
    bf16* QT = (bf16*)(F.ws + WS_QT); bf16* KC = (bf16*)(F.ws + WS_KC);
    const float* POW = (const float*)(F.ws + WS_POW); const float* COEF = (const float*)(F.ws + WS_COEF);
    for (int it = gt; it < 65536; it += NT) {
        const int p = it & 63, t = (it >> 6) & 31, g = it >> 11, gp = g * 64 + p;
        const float wr = POW[2 * (gp * 33 + t + 1)], wi = POW[2 * (gp * 33 + t + 1) + 1];
        unsigned* d = (unsigned*)(QT + (size_t)g * 65536 + (size_t)(16 * t) * 128 + 2 * p);
#pragma unroll
        for (int ho = 0; ho < 16; ++ho) { const float cr = F.in[I_CRE][(g * 16 + ho) * 64 + p], ci = F.in[I_CIM][(g * 16 + ho) * 64 + p];
            d[ho * 64] = pk2(cr * wr - ci * wi, -(cr * wi + ci * wr)); }
    }
    LAS float* Cr = (LAS float*)F.lds; LAS float* Ci = Cr + 16 * 65; LAS float* Br = Ci + 16 * 65; LAS float* Bi = Br + 1024; LAS float* Er = Bi + 1024; LAS float* Ei = Er + 256;
    for (int task = bi; task < 256; task += nb) {
        const int g = task >> 3, tau0 = 4 * (task & 7);
        __syncthreads();
        for (int e = F.tid; e < 1024; e += NWAVES * 64) { const int ho = e >> 6, p = e & 63; Cr[ho * 65 + p] = F.in[I_CRE][g * 1024 + e]; Ci[ho * 65 + p] = F.in[I_CIM][g * 1024 + e];
            Br[e] = F.in[I_BRE][g * 1024 + e]; Bi[e] = F.in[I_BIM][g * 1024 + e]; }
        if (F.tid < 256) { const int tl = F.tid >> 6, p = F.tid & 63, gp = g * 64 + p; const float wr = POW[2 * (gp * 33 + tau0 + tl)], wi = POW[2 * (gp * 33 + tau0 + tl) + 1], cr = COEF[2 * gp], ci = COEF[2 * gp + 1];
            Er[F.tid] = wr * cr - wi * ci; Ei[F.tid] = wr * ci + wi * cr; }
        __syncthreads();
#pragma unroll 1
        for (int o = F.tid; o < 1024; o += NWAVES * 64) { const int tl = o >> 8, ho = (o >> 4) & 15, hi = o & 15; float acc = 0.f;
#pragma unroll 8
            for (int p = 0; p < 64; ++p) { const float cr = Cr[ho * 65 + p], ci = Ci[ho * 65 + p], br = Br[p * 16 + hi], bi_ = Bi[p * 16 + hi], er = Er[tl * 64 + p], ei = Ei[tl * 64 + p];
                acc += cr * (er * br - ei * bi_) - ci * (er * bi_ + ei * br); }
            if (tau0 + tl == 0 && ho == hi) acc += F.in[I_DD][g * 16 + ho];
            KC[(size_t)g * KC_PER_G + (tau0 + tl + 1) * 256 + (o & 255)] = (bf16)f2bf(acc); }
        if (tau0 == 0 && F.tid < 256) KC[(size_t)g * KC_PER_G + F.tid] = (bf16)0;
    }
    __syncthreads();
}
__device__ __forceinline__ void stage_rows(LAS unsigned char* dst, const unsigned char* src, int nrows, int cshift, int dst_stride, int tid) {
    const int total = nrows << cshift;
#pragma unroll 1
    for (int c0 = tid; c0 < total; c0 += 8 * NWAVES * 64) {
        v4u v[8];
#pragma unroll
        for (int u = 0; u < 8; ++u) { const int c = c0 + u * NWAVES * 64; if (c < total) v[u] = *(const v4u*)(src + ((size_t)c << 4)); }
#pragma unroll
        for (int u = 0; u < 8; ++u) { const int c = c0 + u * NWAVES * 64; if (c < total) { const int row = c >> cshift, col = c & ((1 << cshift) - 1); *(LAS v4u*)(dst + row * dst_stride + col * 16) = v[u]; } }
    }
}
#define MFMA16(a, b, c) __builtin_amdgcn_mfma_f32_16x16x32_bf16((a), (b), (c), 0, 0, 0)
constexpr int VT_STRIDE = 1040, QT_STRIDE = 272, LDS_KC_OFF = 512 * QT_STRIDE;
static_assert(LDS_KC_OFF + KC_PER_G * 2 <= LDSCTL_OFF && 128 * VT_STRIDE <= LDSCTL_OFF, "SSM LDS images");
__device__ __forceinline__ void s1_hloc(Frame& F) {
    const bf16* P = (const bf16*)(F.ws + WS_P); const bf16* VT = (const bf16*)(F.ws + WS_VT); float* HL = (float*)(F.ws + WS_HL);
    const int lane = F.lane;
    for (int bt = F.vcu; bt < 256; bt += F.G) {
        const int g = bt >> 3, sub = bt & 7;
        __syncthreads();
        stage_rows(F.lds, (const unsigned char*)(VT + (size_t)g * 65536), 128, 6, VT_STRIDE, F.tid);
        __syncthreads();
        const int ntile = 4 * sub + (F.wave >> 1), half = F.wave & 1;
        const int n = ntile * 16 + (lane & 15), b = n >> 7, c = n & 127, row0 = b * 4096 + 32 * c;
        const bf16* up = P + (size_t)(row0 + (lane >> 5)) * DIN + 768 + g * 16 + 8 * ((lane >> 4) & 1);
        bf16x8 U[16];
#pragma unroll
        for (int ks = 0; ks < 16; ++ks) U[ks] = *(const bf16x8*)(up + (size_t)(2 * ks) * DIN);
#pragma unroll
        for (int mi = 0; mi < 4; ++mi) {
            const int mf = 4 * half + mi;
            const LAS unsigned char* ap = F.lds + (16 * mf + (lane & 15)) * VT_STRIDE + 16 * (lane >> 4);
            f32x4 acc = (f32x4){0.f, 0.f, 0.f, 0.f};
#pragma unroll
            for (int ks = 0; ks < 16; ++ks) acc = MFMA16(*(const LAS bf16x8*)(ap + 64 * ks), U[ks], acc);
            *(f32x4*)(HL + ((size_t)n * 32 + g) * 128 + 16 * mf + 4 * (lane >> 4)) = acc;
        }
    }
}
__device__ __forceinline__ void s1_small_seqs(Frame& F) {
    LAS float* hs = (LAS float*)(F.lds + 133120 + F.wave * 512);
    const int gw = F.vcu * NWAVES + F.wave, NGW = F.G * NWAVES, lane = F.lane;
    const bf16* P = (const bf16*)(F.ws + WS_P); bf16* Z = (bf16*)(F.ws + WS_Z); float* HM = (float*)(F.ws + WS_HM);
    const float* abr = (const float*)(F.ws + WS_ABR); const float* abi = (const float*)(F.ws + WS_ABI); const float* bbr = (const float*)(F.ws + WS_BBR); const float* bbi = (const float*)(F.ws + WS_BBI);
#pragma unroll 1
    for (int task = gw; task < 32 + 128 * 32; task += NGW) {
        const bool meta = task < 32; const int g = meta ? task : ((task - 32) & 31), db = meta ? 0 : ((task - 32) >> 5), gp = g * 64 + lane;
        const float are = abr[gp], aim = abi[gp];
        float br[16], bi[16];
#pragma unroll
        for (int h = 0; h < 16; ++h) { br[h] = bbr[gp * 16 + h]; bi[h] = bbi[gp * 16 + h]; }
        const int ho = lane & 15, qq = lane >> 4;
        float cr[16], ci[16];
#pragma unroll
        for (int j = 0; j < 16; ++j) { cr[j] = F.in[I_CRE][(g * 16 + ho) * 64 + qq * 16 + j]; ci[j] = F.in[I_CIM][(g * 16 + ho) * 64 + qq * 16 + j]; }
        const float dd = F.in[I_DD][g * 16 + ho];
        float hr = 0.f, hi = 0.f;
        if (!meta) { hr = F.in[I_SRE][(db * 32 + g) * 64 + lane]; hi = F.in[I_SIM][(db * 32 + g) * 64 + lane]; }
        const int nbatch = meta ? 4 : 1;
#pragma unroll 1
        for (int sb = 0; sb < nbatch; ++sb) {
            const int rowb = meta ? MR + 4 * sb : MP + db * 4;
            v4u uu[4][2];
#pragma unroll
            for (int st = 0; st < 4; ++st) { const v4u* up = (const v4u*)(P + (size_t)(rowb + st) * DIN + 768 + g * 16); uu[st][0] = up[0]; uu[st][1] = up[1]; }
#pragma unroll
            for (int st = 0; st < 4; ++st) {
                const int row = rowb + st;
                const v4u u0 = uu[st][0], u1 = uu[st][1];
                float u[16];
                u[0] = bflo(u0.x); u[1] = bfhi(u0.x); u[2] = bflo(u0.y); u[3] = bfhi(u0.y); u[4] = bflo(u0.z); u[5] = bfhi(u0.z); u[6] = bflo(u0.w); u[7] = bfhi(u0.w);
                u[8] = bflo(u1.x); u[9] = bfhi(u1.x); u[10] = bflo(u1.y); u[11] = bfhi(u1.y); u[12] = bflo(u1.z); u[13] = bfhi(u1.z); u[14] = bflo(u1.w); u[15] = bfhi(u1.w);
                float bur = 0.f, bui = 0.f;
#pragma unroll
                for (int h = 0; h < 16; ++h) { bur += br[h] * u[h]; bui += bi[h] * u[h]; }
                const float nhr = are * hr - aim * hi + bur, nhi = are * hi + aim * hr + bui;
                hr = nhr; hi = nhi;
                if (!meta) {
                    hs[lane] = hr; hs[64 + lane] = hi;
                    LDS_WAIT(); asm volatile("" ::: "memory");
                    float y = 0.f;
#pragma unroll
                    for (int j = 0; j < 16; ++j) y += cr[j] * hs[qq * 16 + j] - ci[j] * hs[64 + qq * 16 + j];
                    y += __shfl_xor(y, 16); y += __shfl_xor(y, 32);
                    float uo = u[0];
#pragma unroll
                    for (int h = 1; h < 16; ++h) uo = (ho == h) ? u[h] : uo;
                    y += dd * uo;
                    const float z = gelu_tanh(y);
                    if (lane < 16) Z[(size_t)row * SW + g * 16 + ho] = (bf16)f2bf(z);
                    LDS_WAIT(); asm volatile("" ::: "memory");
                }
            }
        }
        if (meta) { HM[g * 128 + 2 * lane] = hr; HM[g * 128 + 2 * lane + 1] = hi; }
        else { F.out[O_SRS + (db * 32 + g) * 64 + lane] = hr; F.out[O_SIS + (db * 32 + g) * 64 + lane] = hi; }
    }
}
__device__ __forceinline__ void s2_scan(Frame& F) {
    const int gt = F.vcu * (NWAVES * 64) + F.tid;
    if (gt < 65536) {
        const int j = gt & 7, ch = gt >> 3, b = ch >> 11, gp = ch & 2047, g = gp >> 6, p = gp & 63;
        const float* A32 = (const float*)(F.ws + WS_A32); const float* HM = (const float*)(F.ws + WS_HM);
        const float mr = A32[2 * gp], mi = A32[2 * gp + 1];
        const float* hl = (const float*)(F.ws + WS_HL) + ((size_t)(b * 128 + 16 * j) * 32 + g) * 128 + 2 * p;
        float vr[16], vi[16];
#pragma unroll
        for (int k = 0; k < 16; ++k) { const float* q = hl + (size_t)k * 4096; vr[k] = q[0]; vi[k] = q[1]; }
#pragma unroll
        for (int k = 1; k < 16; ++k) { const float nr = mr * vr[k - 1] - mi * vi[k - 1] + vr[k], ni = mr * vi[k - 1] + mi * vr[k - 1] + vi[k]; vr[k] = nr; vi[k] = ni; }
        float sr = mr, si = mi;
#pragma unroll
        for (int q = 0; q < 4; ++q) { const float nr = sr * sr - si * si, ni = 2.f * sr * si; sr = nr; si = ni; }
        float cr = HM[g * 128 + 2 * p], ci = HM[g * 128 + 2 * p + 1];
        const int base = F.lane & ~7;
#pragma unroll
        for (int q = 0; q < 7; ++q) { const float tr = __shfl(vr[15], base + q), ti = __shfl(vi[15], base + q);
            const float nr = sr * cr - si * ci + tr, ni = sr * ci + si * cr + ti;
            if (j > q) { cr = nr; ci = ni; } }
        unsigned* hin = (unsigned*)((bf16*)(F.ws + WS_HIN) + ((size_t)(b * 128 + 16 * j) * 32 + g) * 128 + 2 * p);
        float pr = cr, pi = ci;
        hin[0] = pk2(pr, pi);
#pragma unroll
        for (int k = 1; k < 16; ++k) { const float nr = mr * pr - mi * pi, ni = mr * pi + mi * pr; pr = nr; pi = ni; hin[(size_t)k * 2048] = pk2(pr + vr[k - 1], pi + vi[k - 1]); }
        if (j == 7) { const float nr = mr * pr - mi * pi + vr[15], ni = mr * pi + mi * pr + vi[15];
            F.out[O_SRP + (b * 32 + g) * 64 + p] = nr; F.out[O_SIP + (b * 32 + g) * 64 + p] = ni; }
    }
}
__device__ __forceinline__ void s3_y(Frame& F) {
    const bf16* P = (const bf16*)(F.ws + WS_P); const bf16* QT = (const bf16*)(F.ws + WS_QT); const bf16* KC = (const bf16*)(F.ws + WS_KC); bf16* Z = (bf16*)(F.ws + WS_Z);
    const int lane = F.lane;
    for (int bt = F.vcu; bt < 256; bt += F.G) {
        const int g = bt >> 3, sub = bt & 7;
        __syncthreads();
        { const int p = F.tid >> 3, j = F.tid & 7, bb = sub >> 1, gp = g * 64 + p;
          const float* A32 = (const float*)(F.ws + WS_A32); const float* HM = (const float*)(F.ws + WS_HM);
          const float mr = A32[2 * gp], mi = A32[2 * gp + 1];
          const float* hl = (const float*)(F.ws + WS_HL) + ((size_t)(bb * 128 + 16 * j) * 32 + g) * 128 + 2 * p;
          float vr[16], vi[16];
#pragma unroll
          for (int k = 0; k < 16; ++k) { const float* q = hl + (size_t)k * 4096; vr[k] = q[0]; vi[k] = q[1]; }
#pragma unroll
          for (int k = 1; k < 16; ++k) { const float nr = mr * vr[k - 1] - mi * vi[k - 1] + vr[k], ni = mr * vi[k - 1] + mi * vr[k - 1] + vi[k]; vr[k] = nr; vi[k] = ni; }
          float sr = mr, si = mi;
#pragma unroll
          for (int q = 0; q < 4; ++q) { const float nr = sr * sr - si * si, ni = 2.f * sr * si; sr = nr; si = ni; }
          float cr = HM[g * 128 + 2 * p], ci = HM[g * 128 + 2 * p + 1];
          const int base = lane & ~7;
#pragma unroll
          for (int q = 0; q < 7; ++q) { const float tr = __shfl(vr[15], base + q), ti = __shfl(vi[15], base + q);
              const float nr = sr * cr - si * ci + tr, ni = sr * ci + si * cr + ti;
              if (j > q) { cr = nr; ci = ni; } }
          const int jl = j - 4 * (sub & 1);
          LAS unsigned* hw = (LAS unsigned*)(F.lds) + (16 * jl) * 64 + p;
          float pr = cr, pi = ci;
          if (jl >= 0 && jl < 4) hw[0] = pk2(pr, pi);
#pragma unroll
          for (int k = 1; k < 16; ++k) { const float nr = mr * pr - mi * pi, ni = mr * pi + mi * pr; pr = nr; pi = ni; if (jl >= 0 && jl < 4) hw[k * 64] = pk2(pr + vr[k - 1], pi + vi[k - 1]); }
          if (j == 7 && (sub & 1)) { const float nr = mr * pr - mi * pi + vr[15], ni = mr * pi + mi * pr + vi[15];
              F.out[O_SRP + (bb * 32 + g) * 64 + p] = nr; F.out[O_SIP + (bb * 32 + g) * 64 + p] = ni; } }
        __syncthreads();
        const int ntile = 4 * sub + (F.wave >> 1), half = F.wave & 1;
        const int n = ntile * 16 + (lane & 15), b = n >> 7, c = n & 127, row0 = b * 4096 + 32 * c;
        const bf16* up = P + (size_t)(row0 + (lane >> 5)) * DIN + 768 + g * 16 + 8 * ((lane >> 4) & 1);
        bf16x8 U[16], H[4];
#pragma unroll
        for (int ks = 0; ks < 16; ++ks) U[ks] = *(const bf16x8*)(up + (size_t)(2 * ks) * DIN);
#pragma unroll
        for (int kk = 0; kk < 4; ++kk) H[kk] = *(const LAS bf16x8*)(F.lds + (16 * (F.wave >> 1) + (lane & 15)) * 256 + (8 * (lane >> 4) + 32 * kk) * 2);
        LDS_WAIT(); asm volatile("" ::: "memory");
        __syncthreads();
        stage_rows(F.lds, (const unsigned char*)(QT + (size_t)g * 65536), 512, 4, QT_STRIDE, F.tid);
        stage_rows(F.lds + LDS_KC_OFF, (const unsigned char*)(KC + (size_t)g * KC_PER_G), 33, 5, 512, F.tid);
        __syncthreads();
        const LAS unsigned char* qp = F.lds + (16 * half + (lane & 15)) * QT_STRIDE + 16 * (lane >> 4);
        const LAS unsigned char* kp = F.lds + LDS_KC_OFF + (half - (lane >> 5) + 1) * 512 + (lane & 15) * 32 + 16 * ((lane >> 4) & 1);
        bf16* zp = Z + (size_t)(row0 + half) * SW + g * 16 + 4 * (lane >> 4);
#pragma unroll
        for (int i = 0; i < 16; ++i) {
            f32x4 acc = (f32x4){0.f, 0.f, 0.f, 0.f};
#pragma unroll
            for (int kk = 0; kk < 4; ++kk) acc = MFMA16(*(const LAS bf16x8*)(qp + i * 32 * QT_STRIDE + kk * 64), H[kk], acc);
#pragma unroll
            for (int ks = 0; ks < 16; ++ks) if (ks <= i) acc = MFMA16(*(const LAS bf16x8*)(kp + (2 * i - 2 * ks) * 512), U[ks], acc);
            v2u w; w.x = pk2(gelu_tanh(acc[0]), gelu_tanh(acc[1])); w.y = pk2(gelu_tanh(acc[2]), gelu_tanh(acc[3]));
            *(v2u*)(zp + (size_t)(2 * i) * SW) = w;
        }
    }
}
typedef float f32x16 __attribute__((ext_vector_type(16)));
#define MFMA32(a, b, c) __builtin_amdgcn_mfma_f32_32x32x16_bf16((a), (b), (c), 0, 0, 0)
__device__ __forceinline__ int crow(int r, int hl) { return (r & 3) + 8 * (r >> 2) + 4 * hl; }
constexpr float LOG2E = 1.4426950408889634f, QK_C2 = 0.125f * 1.4426950408889634f;
constexpr int AK_STRIDE = 144;
template <class MaskF>
__device__ __forceinline__ void attn_qblock(const LAS unsigned char* Kl, const LAS unsigned char* Vl, int vstride, const bf16x8 (&qf)[4], int kb0, float sink2, const MaskF& valid, LAS float* wsf, f32x16 (&O)[2], int lane) {
    const int i = lane & 31, hl = lane >> 5;
    f32x16 S[5];
#pragma unroll
    for (int kbi = 0; kbi < 5; ++kbi) {
        const LAS unsigned char* kp = Kl + (32 * (kb0 + kbi) + i) * AK_STRIDE + 16 * hl;
        f32x16 acc = (f32x16){0.f, 0.f, 0.f, 0.f, 0.f, 0.f, 0.f, 0.f, 0.f, 0.f, 0.f, 0.f, 0.f, 0.f, 0.f, 0.f};
#pragma unroll
        for (int kd = 0; kd < 4; ++kd) acc = MFMA32(*(const LAS bf16x8*)(kp + 32 * kd), qf[kd], acc);
        S[kbi] = acc;
    }
    float m = -1e30f;
#pragma unroll
    for (int kbi = 0; kbi < 5; ++kbi)
#pragma unroll
        for (int r = 0; r < 16; ++r) { const int kk = 32 * (kb0 + kbi) + crow(r, hl); const float t = valid(kk, i) ? S[kbi][r] * QK_C2 : -1e30f; S[kbi][r] = t; m = fmaxf(m, t); }
    m = fmaxf(m, __shfl_xor(m, 32)); m = fmaxf(m, sink2);
    float sum = 0.f;
#pragma unroll
    for (int kbi = 0; kbi < 5; ++kbi)
#pragma unroll
        for (int r = 0; r < 16; ++r) { const float p = __builtin_amdgcn_exp2f(S[kbi][r] - m); S[kbi][r] = p; sum += p; }
    sum += __shfl_xor(sum, 32); sum += __builtin_amdgcn_exp2f(sink2 - m);
    wsf[i] = 1.0f / sum;
    O[0] = (f32x16){0.f, 0.f, 0.f, 0.f, 0.f, 0.f, 0.f, 0.f, 0.f, 0.f, 0.f, 0.f, 0.f, 0.f, 0.f, 0.f}; O[1] = O[0];
#pragma unroll
    for (int kbi = 0; kbi < 5; ++kbi)
#pragma unroll
        for (int s = 0; s < 2; ++s) {
            v4u pw; pw.x = pg8::cvt_pk_bf16(S[kbi][8 * s + 0], S[kbi][8 * s + 1]); pw.y = pg8::cvt_pk_bf16(S[kbi][8 * s + 2], S[kbi][8 * s + 3]); pw.z = pg8::cvt_pk_bf16(S[kbi][8 * s + 4], S[kbi][8 * s + 5]); pw.w = pg8::cvt_pk_bf16(S[kbi][8 * s + 6], S[kbi][8 * s + 7]);
            const bf16x8 pf = __builtin_bit_cast(bf16x8, pw);
#pragma unroll
            for (int dt = 0; dt < 2; ++dt) {
                const LAS unsigned char* vp = Vl + (32 * dt + i) * vstride + (32 * (kb0 + kbi) + 16 * s + 4 * hl) * 2;
                const v2u lo = *(const LAS v2u*)vp, hi = *(const LAS v2u*)(vp + 16);
                v4u vw; vw.x = lo.x; vw.y = lo.y; vw.z = hi.x; vw.w = hi.y;
                O[dt] = MFMA32(pf, __builtin_bit_cast(bf16x8, vw), O[dt]);
            }
        }
    LDS_WAIT(); asm volatile("" ::: "memory");
}
__device__ __forceinline__ v4u rope8(const v4u v, const v4u pv, int which, const float* c8, const float* s8) {
    float a[8], b[8], o[8]; unpack8(v, a); unpack8(pv, b);
    const f32x4 c0 = *(const f32x4*)c8, c1 = *(const f32x4*)(c8 + 4), s0 = *(const f32x4*)s8, s1 = *(const f32x4*)(s8 + 4);
    const float cc[8] = {c0.x, c0.y, c0.z, c0.w, c1.x, c1.y, c1.z, c1.w}, ss[8] = {s0.x, s0.y, s0.z, s0.w, s1.x, s1.y, s1.z, s1.w};
#pragma unroll
    for (int e = 0; e < 8; ++e) o[e] = which ? (a[e] * cc[e] + b[e] * ss[e]) : (a[e] * cc[e] - b[e] * ss[e]);
    return pack8(o);
}
__device__ __forceinline__ v4u shfl_xor4(const v4u v, int m) { v4u r; r.x = __shfl_xor(v.x, m); r.y = __shfl_xor(v.y, m); r.z = __shfl_xor(v.z, m); r.w = __shfl_xor(v.w, m); return r; }
__device__ __forceinline__ bf16x8 rope_q(const bf16x8 q0, int hl, int pidx, const float* ropeC, const float* ropeS) {
    const v4u v = __builtin_bit_cast(v4u, q0); const v4u pv = shfl_xor4(v, 32);
    return __builtin_bit_cast(bf16x8, rope8(v, pv, hl, ropeC + pidx * 8, ropeS + pidx * 8));
}
constexpr int AP_KEYS = 192, AP_VSTRIDE = 392, AP_LDS_V = 2 * AP_KEYS * AK_STRIDE, AP_LDS_W = AP_LDS_V + 2 * 64 * AP_VSTRIDE, AP_LDS_T = AP_LDS_W + 8 * 128, AT_STRIDE = 144;
static_assert(AP_LDS_T + 8 * 32 * AT_STRIDE <= LDSCTL_OFF, "attention LDS");
template <class RowF>
__device__ __forceinline__ void attn_store(const f32x16 (&O)[2], const LAS float* wsf, LAS unsigned char* tile, bf16* CAT, float* SS, const RowF& rowf, int nrows, int lane) {
    const int i = lane & 31, hl = lane >> 5;
#pragma unroll
    for (int r = 0; r < 16; ++r) { const int q = crow(r, hl); const float inv = wsf[q];
        *(LAS bf16*)(tile + q * AT_STRIDE + i * 2) = (bf16)f2bf(O[0][r] * inv); *(LAS bf16*)(tile + q * AT_STRIDE + 64 + i * 2) = (bf16)f2bf(O[1][r] * inv); }
    LDS_WAIT(); asm volatile("" ::: "memory");
    const int q = lane >> 1, hf = lane & 1;
    v4u w[4]; float ss = 0.f;
#pragma unroll
    for (int jj = 0; jj < 4; ++jj) { w[jj] = *(const LAS v4u*)(tile + q * AT_STRIDE + hf * 64 + jj * 16); float f[8]; unpack8(w[jj], f);
#pragma unroll
        for (int e = 0; e < 8; ++e) ss += f[e] * f[e]; }
    ss += __shfl_xor(ss, 1);
    if (q < nrows) { int row, h; rowf(q, row, h);
        bf16* op = CAT + (size_t)row * D + h * 64 + hf * 32;
#pragma unroll
        for (int jj = 0; jj < 4; ++jj) *(v4u*)(op + jj * 8) = w[jj];
        if (hf == 0) SS[(size_t)row * 32 + 16 + h] = ss; }
    LDS_WAIT(); asm volatile("" ::: "memory");
}
struct MaskPrompt { int lo0, hi0, kvmin; __device__ __forceinline__ bool operator()(int kk, int i) const { return kk >= lo0 + i && kk <= hi0 + i && kk >= kvmin; } };
__device__ __forceinline__ float half_sum(float v) { v += __shfl_xor(v, 1); v += __shfl_xor(v, 2); v += __shfl_xor(v, 4); v += __shfl_xor(v, 8); v += __shfl_xor(v, 16); return v; }
__device__ __forceinline__ void attn_prompt(Frame& F) {
    const bf16* P = (const bf16*)(F.ws + WS_P); bf16* CAT = (bf16*)(F.ws + WS_CAT);
    const float* ropeC = (const float*)(F.ws + WS_ROPEC); const float* ropeS = (const float*)(F.ws + WS_ROPES);
    const int lane = F.lane, i = lane & 31, hl = lane >> 5;
    LAS float* wsf = (LAS float*)(F.lds + AP_LDS_W + F.wave * 128);
    float* SS = (float*)(F.ws + WS_SS);
    for (int u = F.vcu; u < 256; u += F.G) {
        const int b = u >> 6, j = u & 63, s0 = 64 * j - 128;
        __syncthreads();
        { v4u vv[12];
          const int cc = F.tid & 31;
#pragma unroll
          for (int uu = 0; uu < 12; ++uu) { const int key = (F.tid >> 5) + 16 * uu, sk = s0 + key;
              const int row = sk >= 0 ? b * 4096 + sk : (sk >= -16 ? MR + 16 + sk : MR);
              vv[uu] = *(const v4u*)(P + (size_t)row * DIN + 512 + cc * 8); }
          if (cc < 16 && (cc & 7) < 2) {
#pragma unroll
              for (int uu = 0; uu < 12; ++uu) { const int key = (F.tid >> 5) + 16 * uu, sk = s0 + key, pidx = sk >= -16 ? sk + 16 : 0;
                  const v4u pv = shfl_xor4(vv[uu], 1); vv[uu] = rope8(vv[uu], pv, cc & 1, ropeC + pidx * 8, ropeS + pidx * 8); } }
#pragma unroll
          for (int uu = 0; uu < 12; ++uu) { const int key = (F.tid >> 5) + 16 * uu; const v4u v = vv[uu];
            if (cc < 16) { *(LAS v4u*)(F.lds + ((cc >> 3) * AP_KEYS + key) * AK_STRIDE + (cc & 7) * 16) = v; }
            else { const int c2 = cc - 16; LAS bf16* vt = (LAS bf16*)(F.lds + AP_LDS_V + ((c2 >> 3) * 64 + (c2 & 7) * 8) * AP_VSTRIDE + key * 2);
                vt[0 * (AP_VSTRIDE / 2)] = (bf16)(v.x & 0xffffu); vt[1 * (AP_VSTRIDE / 2)] = (bf16)(v.x >> 16); vt[2 * (AP_VSTRIDE / 2)] = (bf16)(v.y & 0xffffu); vt[3 * (AP_VSTRIDE / 2)] = (bf16)(v.y >> 16);
                vt[4 * (AP_VSTRIDE / 2)] = (bf16)(v.z & 0xffffu); vt[5 * (AP_VSTRIDE / 2)] = (bf16)(v.z >> 16); vt[6 * (AP_VSTRIDE / 2)] = (bf16)(v.w & 0xffffu); vt[7 * (AP_VSTRIDE / 2)] = (bf16)(v.w >> 16); } } }
        __syncthreads();
        const int h = F.wave, kvh = h >> 2;
        const float sink2 = F.in[I_SINK][h] * LOG2E;
        const LAS unsigned char* Kl = F.lds + kvh * AP_KEYS * AK_STRIDE; const LAS unsigned char* Vl = F.lds + AP_LDS_V + kvh * 64 * AP_VSTRIDE;
#pragma unroll 1
        for (int qh = 0; qh < 2; ++qh) {
            const int qs0 = 64 * j + 32 * qh, qrow0 = b * 4096 + qs0;
            const bf16* qp = P + (size_t)(qrow0 + i) * DIN + h * 64 + 8 * hl;
            bf16x8 qf[4];
#pragma unroll
            for (int kd = 0; kd < 4; ++kd) qf[kd] = *(const bf16x8*)(qp + 16 * kd);
            qf[0] = rope_q(qf[0], hl, qs0 + i + 16, ropeC, ropeS);
            const MaskPrompt mk{32 * qh + 1, 128 + 32 * qh, 112 - 64 * j};
            f32x16 O[2];
            attn_qblock(Kl, Vl, AP_VSTRIDE, qf, qh, sink2, mk, wsf, O, lane);
            struct RowP { int qrow0, h; __device__ __forceinline__ void operator()(int q, int& row, int& hh) const { row = qrow0 + q; hh = h; } };
            attn_store(O, wsf, F.lds + AP_LDS_T + F.wave * 32 * AT_STRIDE, CAT, SS, RowP{qrow0, h}, 32, lane);
        }
    }
    __syncthreads();
}
constexpr int AS_KEYS = 160, AS_VSTRIDE = 328, AS_LDS_V = 2 * AS_KEYS * AK_STRIDE, AS_LDS_W = AS_LDS_V + 2 * 64 * AS_VSTRIDE, AS_LDS_T = AS_LDS_W + 8 * 128;
struct MaskSample { __device__ __forceinline__ bool operator()(int kk, int i) const { const int t = i & 3; return kk < 128 ? kk >= t + 1 : (kk < 132 && kk - 128 <= t); } };
__device__ __forceinline__ void attn_sample(Frame& F) {
    const bf16* P = (const bf16*)(F.ws + WS_P); bf16* CAT = (bf16*)(F.ws + WS_CAT);
    const float* ropeC = (const float*)(F.ws + WS_ROPEC); const float* ropeS = (const float*)(F.ws + WS_ROPES);
    const int lane = F.lane, i = lane & 31, hl = lane >> 5;
    LAS float* wsf = (LAS float*)(F.lds + AS_LDS_W + F.wave * 128);
    float* SS = (float*)(F.ws + WS_SS);
    for (int db = F.vcu; db < 128; db += F.G) {
        __syncthreads();
        { const int cc = F.tid & 31, c2 = cc & 15, kvh = c2 >> 3, d0 = (c2 & 7) * 8, k0 = F.tid >> 5;
          f32x4 ca[8][2]; v4u wn = (v4u){0u, 0u, 0u, 0u};
          const float* src = (cc < 16 ? F.in[I_CK] : F.in[I_CV]) + ((size_t)(db * 128 + k0) * 2 + kvh) * 64 + d0;
#pragma unroll
          for (int u = 0; u < 8; ++u) { ca[u][0] = *(const f32x4*)(src + (size_t)u * 16 * 128); ca[u][1] = *(const f32x4*)(src + (size_t)u * 16 * 128 + 4); }
          if (k0 < 4) wn = *(const v4u*)(P + (size_t)(MP + db * 4 + k0) * DIN + (cc < 16 ? 512 : 640) + kvh * 64 + d0);
#pragma unroll
          for (int u = 0; u < 10; ++u) { const int key = k0 + 16 * u; v4u w;
            if (u < 8) { const float f[8] = {ca[u][0].x, ca[u][0].y, ca[u][0].z, ca[u][0].w, ca[u][1].x, ca[u][1].y, ca[u][1].z, ca[u][1].w}; w = pack8(f); }
            else if (u == 8) { w = wn;
                if (F.wave < 2) { const v4u pv = shfl_xor4(w, 1);
                    if (cc < 16 && (cc & 7) < 2) { const int pidx = 4112 + k0; w = rope8(w, pv, cc & 1, ropeC + pidx * 8, ropeS + pidx * 8); } } }
            else w = (v4u){0u, 0u, 0u, 0u};
            if (cc < 16) { *(LAS v4u*)(F.lds + (kvh * AS_KEYS + key) * AK_STRIDE + d0 * 2) = w; }
            else { LAS bf16* vt = (LAS bf16*)(F.lds + AS_LDS_V + (kvh * 64 + d0) * AS_VSTRIDE + key * 2);
                vt[0 * (AS_VSTRIDE / 2)] = (bf16)(w.x & 0xffffu); vt[1 * (AS_VSTRIDE / 2)] = (bf16)(w.x >> 16); vt[2 * (AS_VSTRIDE / 2)] = (bf16)(w.y & 0xffffu); vt[3 * (AS_VSTRIDE / 2)] = (bf16)(w.y >> 16);
                vt[4 * (AS_VSTRIDE / 2)] = (bf16)(w.z & 0xffffu); vt[5 * (AS_VSTRIDE / 2)] = (bf16)(w.z >> 16); vt[6 * (AS_VSTRIDE / 2)] = (bf16)(w.w & 0xffffu); vt[7 * (AS_VSTRIDE / 2)] = (bf16)(w.w >> 16); } } }
        __syncthreads();
        if (F.wave < 2) {
            const int kvh = F.wave, t = i & 3, gq = (i >> 2) & 3, h = kvh * 4 + gq;
            const float sink2 = F.in[I_SINK][h] * LOG2E;
            const bf16* qp = P + (size_t)(MP + db * 4 + t) * DIN + h * 64 + 8 * hl;
            bf16x8 qf[4];
#pragma unroll
            for (int kd = 0; kd < 4; ++kd) qf[kd] = *(const bf16x8*)(qp + 16 * kd);
            qf[0] = rope_q(qf[0], hl, 4112 + t, ropeC, ropeS);
            const MaskSample mk{};
            f32x16 O[2];
            attn_qblock(F.lds + kvh * AS_KEYS * AK_STRIDE, F.lds + AS_LDS_V + kvh * 64 * AS_VSTRIDE, AS_VSTRIDE, qf, 0, sink2, mk, wsf, O, lane);
            struct RowS { int r0, h0; __device__ __forceinline__ void operator()(int q, int& row, int& hh) const { row = r0 + (q & 3); hh = h0 + (q >> 2); } };
            attn_store(O, wsf, F.lds + AS_LDS_T + F.wave * 32 * AT_STRIDE, CAT, SS, RowS{MP + db * 4, kvh * 4}, 16, lane);
        }
    }
    __syncthreads();
}
constexpr int SG_STAGE = 40960, SG_B_OFF = 8192;
__device__ __forceinline__ void small_unit_acc(Frame& F, const bf16* A, int lda, const bf16* Bt, int ldb, int m0, int n0, int k0, int klen, f32x4 (&acc)[4][2]) {
    const int lane = F.lane, w = F.wave;
    const int srow = 8 * w + (lane >> 3), sch = (lane & 7) ^ ((lane >> 3) & 7);
    const bf16* ag = A + (size_t)(m0 + srow) * lda + k0 + sch * 8;
    const bf16* bg = Bt + (size_t)(n0 + srow) * ldb + k0 + sch * 8;
    const unsigned lbase = (unsigned)w * 1024u;
#define SG_ISSUE(t_, st_) do { const unsigned so_ = (unsigned)(st_) * SG_STAGE + lbase; \
        __builtin_amdgcn_global_load_lds((const unsigned*)(ag + (size_t)(t_) * 64), (LAS unsigned*)(F.lds + so_), 16, 0, 0); \
        _Pragma("unroll") for (int q_ = 0; q_ < 4; ++q_) __builtin_amdgcn_global_load_lds((const unsigned*)(bg + (size_t)(64 * q_) * ldb + (size_t)(t_) * 64), (LAS unsigned*)(F.lds + so_ + SG_B_OFF + q_ * 8192), 16, 0, 0); } while (0)
    const int nk = klen >> 6, fr = lane & 15, fq = lane >> 4;
    asm volatile("s_waitcnt vmcnt(0) lgkmcnt(0)" ::: "memory"); __builtin_amdgcn_s_barrier(); asm volatile("" ::: "memory");
    SG_ISSUE(0, 0);
    if (nk > 1) SG_ISSUE(1, 1);
#pragma unroll
    for (int m = 0; m < 4; ++m)
#pragma unroll
        for (int n = 0; n < 2; ++n) acc[m][n] = (f32x4){0.f, 0.f, 0.f, 0.f};
    int st = 0;
#pragma unroll 1
    for (int t = 0; t < nk; ++t) {
        if (t + 1 < nk) asm volatile("s_waitcnt vmcnt(5)" ::: "memory"); else asm volatile("s_waitcnt vmcnt(0)" ::: "memory");
        __builtin_amdgcn_s_barrier(); asm volatile("" ::: "memory");
        if (t + 2 < nk) { const int st2 = st == 0 ? 2 : st - 1; SG_ISSUE(t + 2, st2); }
        const LAS unsigned char* sa = F.lds + st * SG_STAGE; const LAS unsigned char* sb = sa + SG_B_OFF;
#pragma unroll
        for (int ks = 0; ks < 2; ++ks) {
            bf16x8 af[4], bfr[2];
#pragma unroll
            for (int m = 0; m < 4; ++m) { const int row = 16 * m + fr; af[m] = *(const LAS bf16x8*)(sa + row * 128 + (((4 * ks + fq) ^ (row & 7)) << 4)); }
#pragma unroll
            for (int n = 0; n < 2; ++n) { const int row = 32 * w + 16 * n + fr; bfr[n] = *(const LAS bf16x8*)(sb + row * 128 + (((4 * ks + fq) ^ (row & 7)) << 4)); }
#pragma unroll
            for (int m = 0; m < 4; ++m)
#pragma unroll
                for (int n = 0; n < 2; ++n) acc[m][n] = MFMA16(bfr[n], af[m], acc[m][n]);
        }
        asm volatile("s_waitcnt lgkmcnt(0)" ::: "memory");
        st = st == 2 ? 0 : st + 1;
    }
#undef SG_ISSUE
}
template <class Epi>
__device__ __forceinline__ void small_unit(Frame& F, const bf16* A, int lda, const bf16* Bt, int ldb, int m0, int n0, int k0, int klen, const Epi& E) {
    f32x4 acc[4][2];
    small_unit_acc(F, A, lda, Bt, ldb, m0, n0, k0, klen, acc);
    E(acc, m0, n0 + 32 * F.wave, F.lane & 15, F.lane >> 4);
}
template <int ACT> struct SEpiBf16 { bf16* O; int ldc;
    __device__ __forceinline__ void operator()(const f32x4 (&acc)[4][2], int m0, int c0, int fr, int fq) const {
#pragma unroll
        for (int m = 0; m < 4; ++m)
#pragma unroll
            for (int n = 0; n < 2; ++n) { f32x4 v = acc[m][n];
                if (ACT == 2) {
#pragma unroll
                    for (int e = 0; e < 4; ++e) { const float a = fmaxf(v[e], 0.f); v[e] = a * a; } }
                v2u wv; wv.x = pg8::cvt_pk_bf16(v[0], v[1]); wv.y = pg8::cvt_pk_bf16(v[2], v[3]);
                *(v2u*)(O + (size_t)(m0 + 16 * m + fr) * ldc + c0 + 16 * n + 4 * fq) = wv; }
    } };
struct SEpiF32 { float* O; int ldc;
    int row_off;
    __device__ __forceinline__ void operator()(const f32x4 (&acc)[4][2], int m0, int c0, int fr, int fq) const {
#pragma unroll
        for (int m = 0; m < 4; ++m)
#pragma unroll
            for (int n = 0; n < 2; ++n) *(f32x4*)(O + (size_t)(m0 - row_off + 16 * m + fr) * ldc + c0 + 16 * n + 4 * fq) = acc[m][n];
    } };
template <int ACT>
__device__ __forceinline__ void small_phase(Frame& F, const bf16* A, int lda, const bf16* Bt, int K, int ncol0, int N, int row0, int nmt, bf16* O, int ldc, int shift) {
    const int nnt = N >> 8, nsu = nmt * nnt;
    const SEpiBf16<ACT> E{O, ldc};
    for (int su = ((int)blockIdx.x - shift + 2 * F.G) % F.G; su < nsu; su += F.G) { const int mt = su / nnt, nt = su - mt * nnt;
        small_unit(F, A, lda, Bt, K, row0 + 64 * mt, ncol0 + 256 * nt, 0, K, E); }
}

struct SEpiGlu { const bf16* Z; bf16* CAT; float* SS;
    __device__ __forceinline__ void operator()(const f32x4 (&acc)[4][2], int m0, int c0, int fr, int fq) const {
#pragma unroll
        for (int m = 0; m < 4; ++m) { const int row = m0 + 16 * m + fr; float ss = 0.f;
#pragma unroll
            for (int n = 0; n < 2; ++n) { const int c = c0 + 16 * n + 4 * fq; const v2u zw = *(const v2u*)(Z + (size_t)row * SW + c);
                const float z[4] = {bflo(zw.x), bfhi(zw.x), bflo(zw.y), bfhi(zw.y)}; float o[4];
#pragma unroll
                for (int e = 0; e < 4; ++e) { o[e] = z[e] * sigmoidf_(acc[m][n][e]); ss += o[e] * o[e]; }
                v2u wv; wv.x = pg8::cvt_pk_bf16(o[0], o[1]); wv.y = pg8::cvt_pk_bf16(o[2], o[3]);
                *(v2u*)(CAT + (size_t)row * D + 512 + c) = wv; }
            ss += __shfl_xor(ss, 16); ss += __shfl_xor(ss, 32);
            if (fq == 0) SS[(size_t)row * 32 + (c0 >> 5)] = ss; }
    } };
__device__ __forceinline__ void out_sample_units(Frame& F) {
    const bf16* CAT = (const bf16*)(F.ws + WS_CAT); const bf16* W = (const bf16*)(F.ws + WS_WOUT); bf16* O1 = (bf16*)(F.ws + WS_O); const float* SS = (const float*)(F.ws + WS_SS);
    LAS float* sc = (LAS float*)(F.lds + 3 * SG_STAGE);
    const int lane = F.lane, fr = lane & 15, fq = lane >> 4;
    for (int su = (int)blockIdx.x; su < 32; su += F.G) { const int mt = su >> 2, nt = su & 3, m0 = MP + 64 * mt;
        f32x4 a1[4][2], a2[4][2];
        small_unit_acc(F, CAT, D, W, D, m0, 256 * nt, 0, 512, a1);
        small_unit_acc(F, CAT, D, W, D, m0, 256 * nt, 512, 512, a2);
        if (F.tid < 64) { const float* p = SS + (size_t)(m0 + F.tid) * 32; float sa = 0.f, sb = 0.f;
#pragma unroll
            for (int e = 0; e < 16; ++e) sb += p[e];
#pragma unroll
            for (int e = 16; e < 24; ++e) sa += p[e];
            sc[F.tid] = 1.0f / sqrtf(sa * (1.f / 512.f) + EPS); sc[64 + F.tid] = 1.0f / sqrtf(sb * (1.f / 512.f) + EPS); }
        __syncthreads();
#pragma unroll
        for (int m = 0; m < 4; ++m) { const float sa = sc[16 * m + fr], sb = sc[64 + 16 * m + fr];
#pragma unroll
            for (int n = 0; n < 2; ++n) { const f32x4 v = a1[m][n] * sa + a2[m][n] * sb;
                v2u wv; wv.x = pg8::cvt_pk_bf16(v[0], v[1]); wv.y = pg8::cvt_pk_bf16(v[2], v[3]);
                *(v2u*)(O1 + (size_t)(m0 + 16 * m + fr) * D + 256 * nt + 32 * F.wave + 16 * n + 4 * fq) = wv; } }
        __syncthreads();
    }
}
__device__ __forceinline__ void out_scale_tables(Frame& F, int pm) {
    const float* SS = (const float*)(F.ws + WS_SS); LAS float* tb = (LAS float*)(F.lds + RING_BYTES);
    if (F.tid < 256) { const float* p = SS + (size_t)(256 * pm + F.tid) * 32; float sa = 0.f, sb = 0.f;
#pragma unroll
        for (int e = 0; e < 8; ++e) sb += p[e];
#pragma unroll
        for (int e = 16; e < 24; ++e) sa += p[e];
        const float ra = 1.0f / sqrtf(sa * (1.f / 512.f) + EPS), rb = 1.0f / sqrtf(sb * (1.f / 512.f) + EPS);
        tb[F.tid] = ra / rb; tb[256 + F.tid] = rb; }
    __syncthreads();
}
#ifndef MK_N_LAUNCHES
#define MK_N_LAUNCHES 1
#endif
constexpr int N_PHASES = 10;
#define PROBE_SUB 0
#define PROBE_MASK 0
struct Args { const float* in[27]; float* out; unsigned char* ws; int ph_lo, ph_hi; };
__global__ void __launch_bounds__(NWAVES * 64, 2) hymba_fwd(Args args) {
    extern __shared__ __attribute__((aligned(16))) unsigned char lds[];
    Frame F;
    F.lds = (LAS unsigned char*)lds;
    F.MISC = (volatile LAS unsigned*)(F.lds + MISC_OFF);
    F.tid = threadIdx.x; F.lane = F.tid & 63; F.wave = __builtin_amdgcn_readfirstlane(F.tid >> 6);
    F.G = gridDim.x; { const int bx = blockIdx.x; F.vcu = (F.G % 8 == 0) ? (bx % 8) * (F.G / 8) + bx / 8 : bx; }
#pragma unroll
    for (int i = 0; i < 27; ++i) F.in[i] = args.in[i];
    F.out = args.out; F.ws = args.ws; F.ctl = (gu32*)(args.ws + WS_CTL);
    for (int u = F.tid; u < (LDS_BYTES - LDSCTL_OFF) / 4; u += NWAVES * 64) ((LAS unsigned*)(F.lds + LDSCTL_OFF))[u] = 0u;
    __syncthreads();
    const int lo = args.ph_lo, hi = args.ph_hi;
    const bool one = (hi - lo) > 1;
    XcdBarrier bar; bar.bar = (unsigned*)(F.ctl + CW_BAR); bar.x = 0; bar.st = nullptr;
    if (one) bar = xcd_barrier_post((unsigned*)(F.ctl + CW_BAR), F.MISC + 8);
#define IN(k) (lo <= (k) && (k) < hi)
#define SEAM(k) do { if (IN(k) && IN((k) + 1)) xcd_barrier(bar); } while (0)
#define NREP(k) (((PROBE_MASK >> (k)) & 1) ? 2 : 1)
#define PH(k, ...) do { if (IN(k)) { { __VA_ARGS__ } if (NREP(k) == 2) { xcd_barrier(bar); { __VA_ARGS__ } } } SEAM(k); } while (0)
    bf16* const XN = (bf16*)(F.ws + WS_XN); bf16* const OB = (bf16*)(F.ws + WS_O); bf16* const PB = (bf16*)(F.ws + WS_P);
    PH(0, p0_prologue(F); p0_ssm_pow(F););
    PH(1, pg8::Gemm g{XN, (const bf16*)(F.ws + WS_WIN), MP, 1024, D}; pg8::StaticOrder S; S.init(MP, 1024, F.G, (int)blockIdx.x);
        pg8::EpiBf16<0> E{PB, DIN}; pg8::gemm_phase<pg8::EpiBf16<0>, pg8::StaticOrder, true, true>(F.lds, g, S, E);
        if (PROBE_SUB & 32) pg8::gemm_phase<pg8::EpiBf16<0>, pg8::StaticOrder, true, true>(F.lds, g, S, E);
        small_phase<0>(F, XN, D, (const bf16*)(F.ws + WS_WIN), D, 1024, 256, 0, 256, PB, DIN, 0);
        if (PROBE_SUB & 64) small_phase<0>(F, XN, D, (const bf16*)(F.ws + WS_WIN), D, 1024, 256, 0, 256, PB, DIN, 0);
        small_phase<0>(F, XN, D, (const bf16*)(F.ws + WS_WIN), D, 0, DIN, MP, 9, PB, DIN, 0);
        if (PROBE_SUB & 128) small_phase<0>(F, XN, D, (const bf16*)(F.ws + WS_WIN), D, 0, DIN, MP, 9, PB, DIN, 0);
        if ((int)blockIdx.x >= 48) { const int bi = (int)blockIdx.x - 48, nb = F.G - 48; p1_vt(F, bi, nb); __syncthreads(); p4_late_weights(F, bi * NWAVES + F.wave, nb * NWAVES, 0, I_GL); __syncthreads(); p4_qt_kc(F, bi, nb); });
    PH(2, s1_hloc(F); __syncthreads(); if (PROBE_SUB & 1) { s1_hloc(F); __syncthreads(); } s1_small_seqs(F); if (PROBE_SUB & 2) s1_small_seqs(F); attn_prompt(F); if (PROBE_SUB & 4) attn_prompt(F); attn_sample(F); if (PROBE_SUB & 8) attn_sample(F); p3_windows(F); if (PROBE_SUB & 16) p3_windows(F););
    PH(3, s3_y(F););
    PH(4, pg8::Gemm g{(const bf16*)(F.ws + WS_Z), (const bf16*)(F.ws + WS_WGLU), MP, SW, SW}; pg8::StaticOrder S; S.init(MP, SW, F.G, (int)blockIdx.x);
        pg8::EpiGlu E{(const bf16*)(F.ws + WS_Z), SW, (bf16*)(F.ws + WS_CAT) + 512, D, (float*)(F.ws + WS_SS)}; pg8::gemm_phase<pg8::EpiGlu, pg8::StaticOrder, true, true>(F.lds, g, S, E);
        { const SEpiGlu E2{(const bf16*)(F.ws + WS_Z), (bf16*)(F.ws + WS_CAT), (float*)(F.ws + WS_SS)};
          for (int su = ((int)blockIdx.x + F.G - 128) % F.G; su < 16; su += F.G) small_unit(F, (const bf16*)(F.ws + WS_Z), SW, (const bf16*)(F.ws + WS_WGLU), SW, MP + 64 * (su >> 1), 256 * (su & 1), 0, SW, E2); }
        if ((int)blockIdx.x >= 144) { __syncthreads(); p4_late_weights(F, ((int)blockIdx.x - 144) * NWAVES + F.wave, (F.G - 144) * NWAVES, I_GL, I_GL + I_OU + I_UP + I_DN); });
    PH(5, pg8::Gemm g{(const bf16*)(F.ws + WS_CAT), (const bf16*)(F.ws + WS_WOUT), MP, D, D}; pg8::StaticOrder S; S.init(MP, D, F.G, (int)blockIdx.x);
        { pg8::Unit u0; if (S.next(0, u0)) out_scale_tables(F, u0.pm); }
        pg8::EpiBf16Fin E{OB, D, (const LAS float*)(F.lds + RING_BYTES + 1024)}; pg8::gemm_phase<pg8::EpiBf16Fin, pg8::StaticOrder, true, true, true>(F.lds, g, S, E);
        out_sample_units(F););
    PH(6, p7_mid(F););
    PH(7, pg8::Gemm g{XN, (const bf16*)(F.ws + WS_WUP), MP, DFF, D}; pg8::StaticOrder S; S.init(MP, DFF, F.G, (int)blockIdx.x);
        pg8::EpiBf16<2> E{(bf16*)(F.ws + WS_H), DFF}; pg8::gemm_phase<pg8::EpiBf16<2>, pg8::StaticOrder, true, true>(F.lds, g, S, E);
        small_phase<2>(F, XN, D, (const bf16*)(F.ws + WS_WUP), D, 0, DFF, MP, 8, (bf16*)(F.ws + WS_H), DFF, 0););
    PH(8, pg8::Gemm g{(const bf16*)(F.ws + WS_H), (const bf16*)(F.ws + WS_WDN), MP, D, DFF}; pg8::StaticOrder S; S.init(MP, D, F.G, (int)blockIdx.x);
        pg8::EpiBf16<0> E{OB, D}; pg8::gemm_phase<pg8::EpiBf16<0>, pg8::StaticOrder, true, true>(F.lds, g, S, E);
        for (int su = (int)blockIdx.x; su < 256; su += F.G) { const int kq = su & 7, nt = (su >> 3) & 3, mt = su >> 5;
            const SEpiF32 E2{(float*)(F.ws + WS_XN) + (size_t)kq * MS * D, D, MP};
            small_unit(F, (const bf16*)(F.ws + WS_H), DFF, (const bf16*)(F.ws + WS_WDN), DFF, MP + 64 * mt, 256 * nt, 512 * kq, 512, E2); });
    if (IN(9)) { p10_final(F); }
#undef IN
#undef SEAM
}

extern "C" void kernel_launch(void* const* d_in, const int* in_sizes, int n_in, void* d_out, int out_size, void* d_ws, size_t ws_size, hipStream_t stream) {
    static int grid = 0;
    if (grid == 0) {
        if (n_in != 27 || ws_size < WS_TOP) { fprintf(stderr, "kernel_launch: unexpected n_in %d / ws %zu\n", n_in, ws_size); grid = -1; return; }
        int dev = 0, cus = 0, per_cu = 0;
        if (hipGetDevice(&dev) != hipSuccess || hipDeviceGetAttribute(&cus, hipDeviceAttributeMultiprocessorCount, dev) != hipSuccess) { grid = -1; return; }
        if (hipFuncSetAttribute((const void*)hymba_fwd, hipFuncAttributeMaxDynamicSharedMemorySize, LDS_BYTES) != hipSuccess) { fprintf(stderr, "kernel_launch: hipFuncSetAttribute failed\n"); grid = -1; return; }
        if (hipOccupancyMaxActiveBlocksPerMultiprocessor(&per_cu, (const void*)hymba_fwd, NWAVES * 64, LDS_BYTES) != hipSuccess || per_cu < 1) { fprintf(stderr, "kernel_launch: occupancy query says %d\n", per_cu); per_cu = 1; }
        (void)hipGetLastError();
        grid = cus;
    }
    if (grid < 0) return;
    (void)hipMemsetAsync((char*)d_ws + WS_CTL, 0, CTL_ZERO_BYTES, stream);
    Args a{};
    for (int i = 0; i < 27; ++i) a.in[i] = (const float*)d_in[i];
    a.out = (float*)d_out; a.ws = (unsigned char*)d_ws;
#if MK_N_LAUNCHES == 1
    a.ph_lo = 0; a.ph_hi = N_PHASES;
    void* kargs[] = {&a};
    hipError_t e = hipLaunchCooperativeKernel((const void*)hymba_fwd, dim3(grid), dim3(NWAVES * 64), kargs, LDS_BYTES, stream);
    if (e != hipSuccess) fprintf(stderr, "kernel_launch: cooperative launch failed: %s (grid %d)\n", hipGetErrorString(e), grid);
#else
    for (int p = 0; p < N_PHASES; ++p) { a.ph_lo = p; a.ph_hi = p + 1; hipLaunchKernelGGL(hymba_fwd, dim3(grid), dim3(NWAVES * 64), LDS_BYTES, stream, a); }
#endif
}
```
